# Optimizing an MI355X kernel written in HIP

```python
import jax, jax.numpy as jnp
from jax import lax
import numpy as np

D_MODEL = 1024
BATCH = 4
SEQ = 4096
DEPTH = 2

GRID_W = 64
CTX_LEN = 256
N_MIXERS = 2
D_FF = 2816
NORM_EPS = 1e-6
CONV_W = 4
CONV_LEFT = CONV_W // 2
D_RNN = 1024
LRU_HEADS = 4
LRU_BW = D_RNN // LRU_HEADS
LRU_C = 8.0
DN_HEADS = 8
DN_DK = 128
DN_DV = 128
DN_CHUNK = 64
DN_QK = DN_HEADS * DN_DK
DN_VW = DN_HEADS * DN_DV
DN_QKV = 2 * DN_QK + DN_VW
DN_PROJ = DN_QKV + DN_VW + 4 * DN_HEADS

kernel_name = "hybrid_rglru_gdn_prefix_trunk"

F32 = jnp.float32


def rms_norm(x, g):
    xf = x.astype(F32)
    y = xf * lax.rsqrt(jnp.mean(xf * xf, axis=-1, keepdims=True) + NORM_EPS)
    return (y * g.astype(F32)).astype(x.dtype)


def l2norm(x):
    xf = x.astype(F32)
    return xf * lax.rsqrt(jnp.sum(xf * xf, axis=-1, keepdims=True) + NORM_EPS)


def adaln(x, g, m):
    return rms_norm(x, g) * (1.0 + m[:, 1]) + m[:, 0]


def swiglu(h, w_in, w_out):
    gu = h @ w_in
    return (jax.nn.silu(gu[..., :D_FF]) * gu[..., D_FF:]) @ w_out


def centred_conv(u, w, b=None):
    t = u.shape[1]
    up = jnp.pad(u, ((0, 0), (CONV_LEFT, CONV_W - 1 - CONV_LEFT), (0, 0)))
    out = up[:, 0:t] * w[0]
    for j in range(1, CONV_W):
        out = out + up[:, j:j + t] * w[j]
    if b is not None:
        out = out + b
    return out


def to_col_major(h, rows):
    b, s, d = h.shape
    return h.reshape(b, rows, GRID_W, d).transpose(0, 2, 1, 3).reshape(b, s, d)


def from_col_major(h, rows):
    b, s, d = h.shape
    return h.reshape(b, GRID_W, rows, d).transpose(0, 2, 1, 3).reshape(b, s, d)


def linear_scan(a, b, h0):
    b = b.at[:, 0].add(a[:, 0] * h0)

    def combine(l, r):
        return (l[0] * r[0], r[0] * l[1] + r[1])

    _, h = lax.associative_scan(combine, (a, b), axis=1)
    return h


def lru_dir_gates(u, w_gate, b_gate, lam):
    bsz, t, _ = u.shape
    gates = jnp.einsum('bthi,ghij->gbthj', u.reshape(bsz, t, LRU_HEADS, LRU_BW), w_gate)
    gates = jax.nn.sigmoid((gates.reshape(2, bsz, t, D_RNN) + b_gate[:, None, None, :]).astype(F32))
    log_a = -LRU_C * gates[0] * jax.nn.softplus(-lam.astype(F32))
    a = jnp.exp(log_a)
    bterm = jnp.sqrt(-jnp.expm1(2.0 * log_a)) * gates[1] * u.astype(F32)
    return a, bterm


def lru_bidir(u, w_gate, b_gate, lam, h0_f, h0_b):
    a_f, b_f = lru_dir_gates(u, w_gate[0], b_gate[0], lam[0])
    h_f = linear_scan(a_f, b_f, h0_f)
    a_b, b_b = lru_dir_gates(jnp.flip(u, 1), w_gate[1], b_gate[1], lam[1])
    h_b_rev = linear_scan(a_b, b_b, h0_b)
    return h_f + jnp.flip(h_b_rev, 1), h_f[:, -1], h_b_rev[:, -1]


def rglru_mixer(h_lat, h_ctx, w_in, conv_w, conv_b, w_gate, b_gate, lam, w_out, ctx_out):
    def branch_in(h):
        p = h @ w_in
        return p[..., :D_RNN], centred_conv(p[..., D_RNN:], conv_w, conv_b)

    def readout(y, r):
        return (jax.nn.gelu(y.astype(F32)) * r) @ w_out

    y_c, u_c = branch_in(h_ctx)
    h0 = jnp.zeros((h_ctx.shape[0], D_RNN), F32)
    r_c, s_f, s_b = lru_bidir(u_c, w_gate, b_gate, lam, h0, h0)
    y_l, u_l = branch_in(h_lat)
    r_l, _, _ = lru_bidir(u_l, w_gate, b_gate, lam, s_f, s_b)
    out = readout(y_l, r_l).astype(h_lat.dtype)
    out_c = readout(y_c, r_c).astype(h_ctx.dtype) if ctx_out else None
    return out, out_c


def chunk_gated_delta(q, k, v, g, beta, s0):
    bsz, t, h, _ = q.shape
    dv = v.shape[-1]
    c = DN_CHUNK
    n = t // c

    def chunks(a):
        a = a.reshape((bsz, n, c, h) + a.shape[3:])
        return jnp.moveaxis(jnp.moveaxis(a, 1, 0), 3, 2)

    q, k, v = (chunks(a.astype(F32)) for a in (q, k, v))
    g = chunks(g.astype(F32))
    beta = chunks(beta.astype(F32))
    g_cum = jnp.cumsum(g, axis=-1)
    idx = jnp.arange(c)
    incl = idx[:, None] >= idx[None, :]
    strict = idx[:, None] > idx[None, :]
    decay = jnp.exp(jnp.where(incl, g_cum[..., :, None] - g_cum[..., None, :], -jnp.inf))
    kb = k * beta[..., None]
    a_mat = jnp.where(strict, jnp.einsum('nbhcd,nbhed->nbhce', kb, k) * decay, 0.0) + jnp.eye(c, dtype=F32)
    rhs = jnp.concatenate([v * beta[..., None], kb * jnp.exp(g_cum)[..., None]], axis=-1)
    sol = lax.linalg.triangular_solve(a_mat, rhs, left_side=True, lower=True, unit_diagonal=True)
    u, w = sol[..., :dv], sol[..., dv:]
    qk = jnp.einsum('nbhcd,nbhed->nbhce', q, k) * decay
    q_dec = q * jnp.exp(g_cum)[..., None]
    k_dec = k * jnp.exp(g_cum[..., -1:] - g_cum)[..., None]
    g_tot = jnp.exp(g_cum[..., -1])

    def step(s, inp):
        qk_c, qd_c, kd_c, u_c, w_c, gt_c = inp
        v_new = u_c - jnp.einsum('bhcd,bhde->bhce', w_c, s)
        o = jnp.einsum('bhcd,bhde->bhce', qd_c, s) + jnp.einsum('bhce,bhef->bhcf', qk_c, v_new)
        s = s * gt_c[..., None, None] + jnp.einsum('bhcd,bhce->bhde', kd_c, v_new)
        return s, o

    s_fin, o = lax.scan(step, s0, (qk, q_dec, k_dec, u, w, g_tot))
    o = o.transpose(1, 0, 3, 2, 4).reshape(bsz, t, h, dv)
    return o, s_fin


def dn_inputs(h, w_in, conv_w, a_log, dt_bias):
    bsz, t, _ = h.shape
    proj = h @ w_in
    qkv = jax.nn.silu(centred_conv(proj[..., :DN_QKV], conv_w))
    q = l2norm(qkv[..., :DN_QK].reshape(bsz, t, DN_HEADS, DN_DK)) * (DN_DK ** -0.5)
    k = l2norm(qkv[..., DN_QK:2 * DN_QK].reshape(bsz, t, DN_HEADS, DN_DK))
    v = qkv[..., 2 * DN_QK:].reshape(bsz, t, DN_HEADS, DN_DV).astype(F32)
    z = proj[..., DN_QKV:DN_QKV + DN_VW].reshape(bsz, t, DN_HEADS, DN_DV)
    ab = proj[..., DN_QKV + DN_VW:].astype(F32).reshape(bsz, t, 2, 2, DN_HEADS)
    g = -jnp.exp(a_log.astype(F32)) * jax.nn.softplus(ab[:, :, 0] + dt_bias.astype(F32))
    beta = jax.nn.sigmoid(ab[:, :, 1])
    return q, k, v, z, g, beta


def dn_bidir(q, k, v, g, beta, s0_f, s0_b):
    o_f, s_f = chunk_gated_delta(q, k, v, g[:, :, 0], beta[:, :, 0], s0_f)
    fl = lambda a: jnp.flip(a, 1)
    o_b, s_b = chunk_gated_delta(fl(q), fl(k), fl(v), fl(g[:, :, 1]), fl(beta[:, :, 1]), s0_b)
    return o_f + fl(o_b), s_f, s_b


def deltanet_mixer(h_lat, h_ctx, w_in, conv_w, a_log, dt_bias, g_norm, w_out, ctx_out):
    def readout(o, z):
        y = rms_norm(o, g_norm) * jax.nn.silu(z.astype(F32))
        return y.reshape(o.shape[0], o.shape[1], DN_VW) @ w_out

    qc, kc, vc, zc, gc, bc = dn_inputs(h_ctx, w_in, conv_w, a_log, dt_bias)
    s0 = jnp.zeros((h_ctx.shape[0], DN_HEADS, DN_DK, DN_DV), F32)
    oc, s_f, s_b = dn_bidir(qc, kc, vc, gc, bc, s0, s0)
    q, k, v, z, g, beta = dn_inputs(h_lat, w_in, conv_w, a_log, dt_bias)
    o, _, _ = dn_bidir(q, k, v, g, beta, s_f, s_b)
    out = readout(o, z).astype(h_lat.dtype)
    out_c = readout(oc, zc).astype(h_ctx.dtype) if ctx_out else None
    return out, out_c


def setup_inputs(seed: int = 0) -> dict:
    key = jax.random.key(seed)
    ks = jax.random.split(key, 24)
    n_a = (DEPTH + 1) // 2
    n_b = DEPTH // 2
    nrm = lambda k, shape, fan_in, gain=1.0: gain * jax.random.normal(k, shape, F32) * (fan_in ** -0.5)
    a_base = jax.random.uniform(ks[13], (n_a, 2, D_RNN), F32, 0.9, 0.999) ** (1.0 / LRU_C)
    dt = jnp.exp(jax.random.uniform(ks[17], (n_b, 2, DN_HEADS), F32, np.log(1e-3), np.log(1e-1)))
    return {
        "x": jax.random.normal(ks[0], (BATCH, SEQ, D_MODEL), F32),
        "c": jax.random.normal(ks[1], (BATCH, D_MODEL), F32),
        "ctx": jax.random.normal(ks[2], (BATCH, CTX_LEN, D_MODEL), F32),
        "c_ctx": jax.random.normal(ks[3], (D_MODEL,), F32),
        "w_ada": nrm(ks[4], (DEPTH, D_MODEL, 9 * D_MODEL), D_MODEL, 0.5),
        "b_ada": 0.02 * jax.random.normal(ks[5], (DEPTH, 9 * D_MODEL), F32),
        "g_sub": 1.0 + 0.05 * jax.random.normal(ks[6], (DEPTH, 3, D_MODEL), F32),
        "ffn_w_in": nrm(ks[7], (DEPTH, 2, D_MODEL, 2 * D_FF), D_MODEL),
        "ffn_w_out": nrm(ks[8], (DEPTH, 2, D_FF, D_MODEL), D_FF),
        "lru_w_in": nrm(ks[9], (n_a, D_MODEL, 2 * D_RNN), D_MODEL),
        "lru_conv_w": nrm(ks[10], (n_a, CONV_W, D_RNN), CONV_W),
        "lru_conv_b": 0.02 * jax.random.normal(ks[11], (n_a, D_RNN), F32),
        "lru_w_gate": nrm(ks[12], (n_a, 2, 2, LRU_HEADS, LRU_BW, LRU_BW), LRU_BW),
        "lru_b_gate": 0.02 * jax.random.normal(ks[14], (n_a, 2, 2, D_RNN), F32),
        "lru_lambda": jnp.log(a_base) - jnp.log1p(-a_base),
        "lru_w_out": nrm(ks[15], (n_a, D_RNN, D_MODEL), D_RNN),
        "dn_w_in": nrm(ks[16], (n_b, D_MODEL, DN_PROJ), D_MODEL),
        "dn_conv_w": nrm(ks[18], (n_b, CONV_W, DN_QKV), CONV_W),
        "dn_a_log": jnp.log(jax.random.uniform(ks[19], (n_b, 2, DN_HEADS), F32, 1.0, 16.0)),
        "dn_dt_bias": dt + jnp.log(-jnp.expm1(-dt)),
        "dn_g_norm": 1.0 + 0.05 * jax.random.normal(ks[20], (n_b, DN_DV), F32),
        "dn_w_out": nrm(ks[21], (n_b, DN_VW, D_MODEL), DN_VW),
        "g_final": 1.0 + 0.05 * jax.random.normal(ks[22], (D_MODEL,), F32),
    }


def reference(x, c, ctx, c_ctx, w_ada, b_ada, g_sub, ffn_w_in, ffn_w_out,
              lru_w_in, lru_conv_w, lru_conv_b, lru_w_gate, lru_b_gate, lru_lambda, lru_w_out,
              dn_w_in, dn_conv_w, dn_a_log, dn_dt_bias, dn_g_norm, dn_w_out, g_final):
    bsz, seq, d = x.shape
    rows = seq // GRID_W
    c_silu = jax.nn.silu(c)
    cc_silu = jax.nn.silu(c_ctx)[None]
    xc = ctx
    for i in range(DEPTH):
        last = i == DEPTH - 1
        j = i // N_MIXERS
        m = (c_silu @ w_ada[i] + b_ada[i]).reshape(bsz, 3, 3, 1, d)
        mc = (cc_silu @ w_ada[i] + b_ada[i]).reshape(1, 3, 3, 1, d)
        x = x + 0.5 * m[:, 0, 2] * swiglu(adaln(x, g_sub[i, 0], m[:, 0]), ffn_w_in[i, 0], ffn_w_out[i, 0])
        xc = xc + 0.5 * mc[:, 0, 2] * swiglu(adaln(xc, g_sub[i, 0], mc[:, 0]), ffn_w_in[i, 0], ffn_w_out[i, 0])
        h = adaln(x, g_sub[i, 1], m[:, 1])
        hc = adaln(xc, g_sub[i, 1], mc[:, 1])
        if i % N_MIXERS == 0:
            o, oc = rglru_mixer(h, hc, lru_w_in[j], lru_conv_w[j], lru_conv_b[j], lru_w_gate[j],
                                lru_b_gate[j], lru_lambda[j], lru_w_out[j], not last)
        else:
            o, oc = deltanet_mixer(to_col_major(h, rows), hc, dn_w_in[j], dn_conv_w[j], dn_a_log[j],
                                   dn_dt_bias[j], dn_g_norm[j], dn_w_out[j], not last)
            o = from_col_major(o, rows)
        x = x + m[:, 1, 2] * o
        x = x + 0.5 * m[:, 2, 2] * swiglu(adaln(x, g_sub[i, 2], m[:, 2]), ffn_w_in[i, 1], ffn_w_out[i, 1])
        if not last:
            xc = xc + mc[:, 1, 2] * oc
            xc = xc + 0.5 * mc[:, 2, 2] * swiglu(adaln(xc, g_sub[i, 2], mc[:, 2]), ffn_w_in[i, 1], ffn_w_out[i, 1])
    return rms_norm(x, g_final)
```

```cpp
#include <hip/hip_runtime.h>
#include <cstdio>
#include <cstdint>

#ifndef MK_PER_PHASE
#define MK_PER_PHASE 0
#endif

#define LAS __attribute__((address_space(3)))
typedef unsigned short bf16_t;
typedef short bf16x8 __attribute__((ext_vector_type(8)));
typedef float f32x4 __attribute__((ext_vector_type(4)));
typedef float f32x2 __attribute__((ext_vector_type(2)));
typedef unsigned u32x4 __attribute__((ext_vector_type(4)));
typedef unsigned u32x2 __attribute__((ext_vector_type(2)));

constexpr int D = 1024, NB = 4, SEQ = 4096, CTXL = 256, DFF = 2816;
constexpr int ML = NB * SEQ, MC = NB * CTXL, MT = ML + MC;
constexpr int NQ = MT / 64;
constexpr int MODL = 5 * 9 * D;
constexpr int DNP = 4128, DNPP = 4352;
constexpr float EPS = 1e-6f;

constexpr size_t MiB = 1u << 20;
constexpr size_t WS_CTL = 0, CTL_ZERO_BYTES = 2 * MiB;
constexpr size_t WS_MOD = 1 * MiB;
constexpr size_t WS_W1 = 2 * MiB, W1_SZ = (size_t)2 * DFF * D * 2;
constexpr size_t WS_W2 = 46 * MiB, W2_SZ = (size_t)D * DFF * 2;
constexpr size_t WS_WLIN = 68 * MiB, WS_WLG = 72 * MiB, WS_WLO = 74 * MiB, WS_WDIN = 76 * MiB, WS_WDO = 85 * MiB;
constexpr size_t WS_SP8 = 84 * MiB + 768 * 1024;
constexpr size_t WS_XC = 87 * MiB;
constexpr size_t WS_XN = 91 * MiB;
constexpr size_t WS_H = 125 * MiB;
constexpr size_t WS_Y = 125 * MiB, WS_UP = 159 * MiB, WS_U = 193 * MiB, WS_AGGA = 227 * MiB, WS_AGGB = 230 * MiB, WS_CARRY = 233 * MiB;
constexpr size_t WS_QKVP = 125 * MiB, WS_Z = 227 * MiB, WS_AB = 261 * MiB, WS_O = 264 * MiB, WS_END = 328 * MiB;
static_assert(WS_W1 + 4 * W1_SZ <= WS_W2 && WS_W2 + 4 * W2_SZ <= WS_WLIN && WS_WDIN + (size_t)DNPP * D * 2 <= WS_WDO, "weights map");
static_assert(WS_XN + (size_t)MT * D * 2 <= WS_H && WS_H + (size_t)MT * DFF * 2 <= WS_AGGA && WS_QKVP + (size_t)MT * 3072 * 2 <= WS_Z && WS_Z + (size_t)MT * D * 2 <= WS_AB && WS_O + (size_t)ML * D * 4 <= WS_END, "activation map");
constexpr int CW_BAR = 4096;

constexpr int RING_BYTES = 131072, LDSCTL_OFF = RING_BYTES, MISC_OFF = LDSCTL_OFF + 320, LDS_BYTES = 147456;
constexpr int NWAVES = 8;

#define RLX_AGENT __ATOMIC_RELAXED, __HIP_MEMORY_SCOPE_AGENT
#define LDS_WAIT() asm volatile("s_waitcnt lgkmcnt(0)" ::: "memory")
__device__ __forceinline__ unsigned f2bf(float f) { unsigned u = __builtin_bit_cast(unsigned, f); return (u + 0x7fffu + ((u >> 16) & 1u)) >> 16; }
__device__ __forceinline__ unsigned pk2(float lo, float hi) { return f2bf(lo) | (f2bf(hi) << 16); }
__device__ __forceinline__ float bflo(unsigned w) { return __builtin_bit_cast(float, w << 16); }
__device__ __forceinline__ float bfhi(unsigned w) { return __builtin_bit_cast(float, w & 0xffff0000u); }
__device__ __forceinline__ float sigmoidf_(float x) { return 1.0f / (1.0f + expf(-x)); }
__device__ __forceinline__ float siluf_(float x) { return x / (1.0f + expf(-x)); }
__device__ __forceinline__ float softplusf_(float x) { return fmaxf(x, 0.f) + log1pf(expf(-fabsf(x))); }
__device__ __forceinline__ float fexp_(float x) { return __builtin_amdgcn_exp2f(x * 1.4426950408889634f); }
__device__ __forceinline__ float fsigmoid_(float x) { return __builtin_amdgcn_rcpf(1.0f + fexp_(-x)); }
__device__ __forceinline__ float fgelu_tanh(float x) { const float z = 0.7978845608028654f * (x + 0.044715f * x * x * x); const float t = 1.0f - 2.0f * __builtin_amdgcn_rcpf(1.0f + fexp_(2.0f * z)); return 0.5f * x * (1.0f + t); }
__device__ __forceinline__ float gelu_tanh(float x) { const float t = tanhf(0.7978845608028654f * (x + 0.044715f * x * x * x)); return 0.5f * x * (1.0f + t); }
__device__ __forceinline__ float wave_sum(float v) {
#pragma unroll
    for (int o = 1; o < 64; o <<= 1) v += __shfl_xor(v, o);
    return v;
}

namespace pg8 {
constexpr int BM = 256, BK = 64, HALF = 128, HTB = HALF * BK * 2, STAGE_BYTES = 8 * HTB, NXCD = 8, WGM = 8;
__host__ __device__ __forceinline__ int lds_byte(int r, int c) { const int st = (r >> 4) * 2 + (c >> 5), rr = r & 15, cc = c & 31, ob = rr * 64 + cc * 2; return st * 1024 + (ob ^ (((ob >> 9) & 1) << 5)); }
__host__ __device__ __forceinline__ void stage_rc(int b, int& R, int& C) { const int st = b / 1024, sb = b % 1024, swz = sb ^ (((sb >> 9) & 1) << 5); R = (st >> 1) * 16 + swz / 64; C = (st & 1) * 32 + (swz % 64) / 2; }
__host__ __device__ __forceinline__ int perm32(int rho) { const int n = rho >> 4, i = rho & 15; return 8 * (i >> 2) + 4 * n + (i & 3); }

struct Unit { int pm, pn; };
struct Gemm { const bf16_t* A; const bf16_t* Bt; int M, N, K, lda, hdiv; };

struct StaticOrder {
    int nM, nN, nwg, G, c;
    __host__ __device__ void init(int M, int N, int G_, int c_) { nM = M / BM; nN = N / BM; nwg = nM * nN; G = G_; c = c_; }
    __host__ __device__ bool next(int i, Unit& u) const {
        const long L = (long)i * G + c; if (L >= nwg) return false;
        int wgid = (int)L; { const int q = nwg / NXCD, r = nwg % NXCD, xcd = wgid % NXCD, off = wgid / NXCD; wgid = (xcd < r ? xcd * (q + 1) : r * (q + 1) + (xcd - r) * q) + off; }
        const int nig = WGM * nN, gid = wgid / nig, fm = gid * WGM, gsz = (nM - fm) < WGM ? (nM - fm) : WGM;
        u.pm = fm + ((wgid % nig) % gsz); u.pn = (wgid % nig) / gsz; return true;
    }
    __device__ __forceinline__ void a_ready(const Unit&) const {}
    __device__ __forceinline__ void done(const Unit&) const {}
};

__device__ __forceinline__ unsigned cvt_pk_bf16(float lo, float hi) { unsigned r; asm volatile("v_cvt_pk_bf16_f32 %0, %1, %2" : "=v"(r) : "v"(lo), "v"(hi)); return r; }

template <class Epi, class Sched, bool ALIGN_EPI = true, bool SP2 = true>
__device__ __forceinline__ void gemm_phase(LAS unsigned char* lds, const Gemm g, const Sched& S, const Epi& E) {
    const int tid = threadIdx.x, wid = __builtin_amdgcn_readfirstlane(tid >> 6), lane = tid & 63, wr = wid >> 2, wc = wid & 3, fr = lane & 15, fq = lane >> 4;
    const int K = g.K, nt = K / BK, lda = g.lda;
    unsigned voffA[2], voffB[2];
#pragma unroll
    for (int i = 0; i < 2; ++i) { int R, C; stage_rc(tid * 16 + i * 8192, R, C); const int Rb = Epi::PERM ? ((R & ~31) + perm32(R & 31)) : R;
        voffA[i] = (unsigned)(R * lda + C) * 2u; voffB[i] = (unsigned)(Rb * K + C) * 2u; }
    const size_t kstep = (size_t)(BK * 2);
    const size_t hstepA = (size_t)HALF * lda * 2, hstepB = (size_t)HALF * K * 2;
    const size_t tstepA = 2 * hstepA, tstepB = 2 * hstepB;
    const unsigned ldsw = (unsigned)wid * 1024u;
    const int aoff = lds_byte(wr * 64 + fr, fq * 8), boff = lds_byte(wc * 32 + fr, fq * 8);
#define PG8_SA(b, h) (((b) * 2 + (h)) * HTB)
#define PG8_SB(b, h) ((4 + (b) * 2 + (h)) * HTB)
#define PG8_STAGE(bufoff, gbase, voff) do { _Pragma("unroll") for (int _i = 0; _i < 2; ++_i) \
        __builtin_amdgcn_global_load_lds((const unsigned*)((const char*)(gbase) + (voff)[_i]), (LAS unsigned*)(lds + (bufoff) + ldsw + _i * 8192), 16, 0, 0); } while (0)
#define PG8_LDA(dst, b, h) do { _Pragma("unroll") for (int m = 0; m < 4; ++m) _Pragma("unroll") for (int k = 0; k < 2; ++k) dst[m][k] = *(const LAS bf16x8*)(lds + PG8_SA(b, h) + aoff + m * 2048 + k * 1024); } while (0)
#define PG8_LDB(dst, b, h) do { _Pragma("unroll") for (int n = 0; n < 2; ++n) _Pragma("unroll") for (int k = 0; k < 2; ++k) dst[n][k] = *(const LAS bf16x8*)(lds + PG8_SB(b, h) + boff + n * 2048 + k * 1024); } while (0)
#define PG8_MMA(ai, bj, At, Bt) do { __builtin_amdgcn_s_setprio(1); _Pragma("unroll") for (int m = 0; m < 4; ++m) _Pragma("unroll") for (int n = 0; n < 2; ++n) _Pragma("unroll") for (int k = 0; k < 2; ++k) \
        acc[ai][bj][m][n] = __builtin_amdgcn_mfma_f32_16x16x32_bf16(Bt[n][k], At[m][k], acc[ai][bj][m][n], 0, 0, 0); __builtin_amdgcn_s_setprio(0); } while (0)
#define PG8_WAIT_V(n) asm volatile("s_waitcnt vmcnt(" #n ")" ::: "memory")
#define PG8_WAIT_L(n) asm volatile("s_waitcnt lgkmcnt(" #n ")" ::: "memory")
#define PG8_BAR __builtin_amdgcn_s_barrier()
#define PG8_SCHED __builtin_amdgcn_sched_barrier(0)
#define PG8_ABASE(u) ((const char*)g.A + (size_t)(u).pm * tstepA + (g.hdiv ? (size_t)((u).pn / g.hdiv) * (size_t)K * 2 : (size_t)0))
    Unit cur, nxt; int ui = 0;
    if (!S.next(0, cur)) return;
    f32x4 acc[2][2][4][2];
#pragma unroll
    for (int a = 0; a < 2; ++a)
#pragma unroll
        for (int b = 0; b < 2; ++b)
#pragma unroll
            for (int m = 0; m < 4; ++m)
#pragma unroll
                for (int n = 0; n < 2; ++n) acc[a][b][m][n] = (f32x4){0.f, 0.f, 0.f, 0.f};
    bf16x8 At[4][2], B0[2][2], B1[2][2];
    const char* cA = PG8_ABASE(cur); const char* cB = (const char*)g.Bt + (size_t)cur.pn * tstepB;
    S.a_ready(cur);
    if constexpr (SP2) {
        PG8_STAGE(PG8_SB(0, 0), cB, voffB); PG8_STAGE(PG8_SB(0, 1), cB + hstepB, voffB); PG8_STAGE(PG8_SA(0, 0), cA, voffA); PG8_STAGE(PG8_SA(0, 1), cA + hstepA, voffA);
        if (wr == 1) PG8_BAR;
        PG8_WAIT_V(2); PG8_BAR;
        PG8_STAGE(PG8_SB(1, 0), cB + kstep, voffB); PG8_STAGE(PG8_SA(1, 0), cA + kstep, voffA); PG8_STAGE(PG8_SB(1, 1), cB + hstepB + kstep, voffB);
        PG8_WAIT_V(6); PG8_BAR;
    } else {
        PG8_STAGE(PG8_SB(0, 0), cB, voffB); PG8_STAGE(PG8_SA(0, 0), cA, voffA); PG8_STAGE(PG8_SB(0, 1), cB + hstepB, voffB); PG8_STAGE(PG8_SA(0, 1), cA + hstepA, voffA);
        if (wr == 1) PG8_BAR;
        PG8_WAIT_V(4); PG8_BAR;
        PG8_STAGE(PG8_SB(1, 0), cB + kstep, voffB); PG8_STAGE(PG8_SA(1, 0), cA + kstep, voffA); PG8_STAGE(PG8_SB(1, 1), cB + hstepB + kstep, voffB);
        PG8_WAIT_V(6); PG8_BAR;
    }
    for (;;) {
        const bool has_next = S.next(ui + 1, nxt);
        const char* nA = has_next ? PG8_ABASE(nxt) : cA; const char* nB = has_next ? (const char*)g.Bt + (size_t)nxt.pn * tstepB : cB;
        for (int t = 0; t < nt; t += 2) {
            const bool last = (t == nt - 2);
            const char* a1 = cA + (size_t)(t + 1) * kstep;
            const char* a2 = last ? nA : cA + (size_t)(t + 2) * kstep; const char* b2 = last ? nB : cB + (size_t)(t + 2) * kstep;
            const char* a3 = a2 + kstep; const char* b3 = b2 + kstep;
            if (last && has_next) S.a_ready(nxt);
            if constexpr (SP2) {
            PG8_LDB(B0, 0, 0); PG8_LDB(B1, 0, 1); PG8_SCHED; PG8_LDA(At, 0, 0); PG8_STAGE(PG8_SA(1, 1), a1 + hstepA, voffA);
            PG8_WAIT_V(8); PG8_WAIT_L(0); PG8_BAR; PG8_MMA(0, 0, At, B0); PG8_MMA(0, 1, At, B1); PG8_BAR; PG8_SCHED;
            PG8_LDA(At, 0, 1); PG8_STAGE(PG8_SB(0, 0), b2, voffB); PG8_STAGE(PG8_SB(0, 1), b2 + hstepB, voffB); PG8_STAGE(PG8_SA(0, 0), a2, voffA);
            PG8_WAIT_V(8); PG8_WAIT_L(0); PG8_BAR; PG8_MMA(1, 0, At, B0); PG8_MMA(1, 1, At, B1); PG8_BAR; PG8_SCHED;
            PG8_LDB(B0, 1, 0); PG8_LDB(B1, 1, 1); PG8_SCHED; PG8_LDA(At, 1, 0); PG8_STAGE(PG8_SA(0, 1), a2 + hstepA, voffA);
            PG8_WAIT_V(8); PG8_WAIT_L(0); PG8_BAR; PG8_MMA(0, 0, At, B0); PG8_MMA(0, 1, At, B1); PG8_BAR; PG8_SCHED;
            PG8_LDA(At, 1, 1); PG8_STAGE(PG8_SB(1, 0), b3, voffB); PG8_STAGE(PG8_SB(1, 1), b3 + hstepB, voffB); PG8_STAGE(PG8_SA(1, 0), a3, voffA);
            PG8_WAIT_V(8); PG8_WAIT_L(0); PG8_BAR; PG8_MMA(1, 0, At, B0); PG8_MMA(1, 1, At, B1); PG8_BAR; PG8_SCHED;
            } else {
            PG8_LDB(B0, 0, 0); PG8_SCHED; PG8_LDA(At, 0, 0); PG8_STAGE(PG8_SA(1, 1), a1 + hstepA, voffA);
            PG8_WAIT_L(8); PG8_BAR; PG8_WAIT_L(0); PG8_MMA(0, 0, At, B0); PG8_BAR; PG8_SCHED;
            PG8_LDB(B1, 0, 1); PG8_STAGE(PG8_SB(0, 0), b2, voffB);
            PG8_BAR; PG8_WAIT_L(0); PG8_MMA(0, 1, At, B1); PG8_BAR;
            PG8_LDA(At, 0, 1); PG8_STAGE(PG8_SA(0, 0), a2, voffA);
            PG8_BAR; PG8_WAIT_L(0); PG8_MMA(1, 0, At, B0); PG8_BAR; PG8_SCHED;
            PG8_STAGE(PG8_SB(0, 1), b2 + hstepB, voffB);
            PG8_WAIT_V(6); PG8_BAR; PG8_MMA(1, 1, At, B1); PG8_BAR;
            PG8_LDB(B0, 1, 0); PG8_SCHED; PG8_LDA(At, 1, 0); PG8_STAGE(PG8_SA(0, 1), a2 + hstepA, voffA);
            PG8_WAIT_L(8); PG8_BAR; PG8_WAIT_L(0); PG8_MMA(0, 0, At, B0); PG8_BAR; PG8_SCHED;
            PG8_LDB(B1, 1, 1); PG8_STAGE(PG8_SB(1, 0), b3, voffB);
            PG8_BAR; PG8_WAIT_L(0); PG8_MMA(0, 1, At, B1); PG8_BAR;
            PG8_LDA(At, 1, 1); PG8_STAGE(PG8_SA(1, 0), a3, voffA);
            PG8_BAR; PG8_WAIT_L(0); PG8_MMA(1, 0, At, B0); PG8_BAR; PG8_SCHED;
            PG8_STAGE(PG8_SB(1, 1), b3 + hstepB, voffB);
            PG8_WAIT_V(6); PG8_BAR; PG8_MMA(1, 1, At, B1); PG8_BAR;
            }
        }
        if constexpr (ALIGN_EPI) { if (wr == 0) PG8_BAR; }
        E(acc, cur, wr, wc, fr, fq); S.done(cur);
        if (!has_next) break;
#pragma unroll
        for (int a = 0; a < 2; ++a)
#pragma unroll
            for (int b = 0; b < 2; ++b)
#pragma unroll
                for (int m = 0; m < 4; ++m)
#pragma unroll
                    for (int n = 0; n < 2; ++n) acc[a][b][m][n] = (f32x4){0.f, 0.f, 0.f, 0.f};
        cur = nxt; cA = nA; cB = nB; ++ui;
        if constexpr (ALIGN_EPI) { if (wr == 1) PG8_BAR; }
    }
    PG8_WAIT_V(0);
    if constexpr (!ALIGN_EPI) { if (wr == 0) PG8_BAR; }
    PG8_BAR;
#undef PG8_SA
#undef PG8_SB
#undef PG8_STAGE
#undef PG8_LDA
#undef PG8_LDB
#undef PG8_MMA
#undef PG8_WAIT_V
#undef PG8_WAIT_L
#undef PG8_BAR
#undef PG8_SCHED
#undef PG8_ABASE
}

struct EpiBf16 {
    static constexpr bool PERM = true;
    bf16_t* O; int ldc; int split_cols; size_t split_stride;
    __device__ __forceinline__ void operator()(const f32x4 (&acc)[2][2][4][2], const Unit& u, int wr, int wc, int fr, int fq) const {
        const int row0 = u.pm * BM + wr * 64 + fr; int colt = u.pn * BM; bf16_t* base = O;
        if (split_cols) { const int t = colt / split_cols; base += (size_t)t * split_stride; colt -= t * split_cols; }
        const int col0 = colt + wc * 32 + 8 * fq;
#pragma unroll
        for (int ai = 0; ai < 2; ++ai)
#pragma unroll
            for (int m = 0; m < 4; ++m) { bf16_t* rowp = base + (size_t)(row0 + ai * HALF + m * 16) * ldc + col0;
#pragma unroll
                for (int bj = 0; bj < 2; ++bj) { const f32x4 v0 = acc[ai][bj][m][0], v1 = acc[ai][bj][m][1];
                    u32x4 w; w.x = cvt_pk_bf16(v0[0], v0[1]); w.y = cvt_pk_bf16(v0[2], v0[3]); w.z = cvt_pk_bf16(v1[0], v1[1]); w.w = cvt_pk_bf16(v1[2], v1[3]);
                    *(u32x4*)(rowp + bj * HALF) = w; } }
    }
};
struct EpiSwiglu {
    static constexpr bool PERM = false;
    bf16_t* Hout;
    __device__ __forceinline__ void operator()(const f32x4 (&acc)[2][2][4][2], const Unit& u, int wr, int wc, int fr, int fq) const {
        const int row0 = u.pm * BM + wr * 64 + fr, col0 = u.pn * 128 + wc * 16 + 4 * fq;
#pragma unroll
        for (int ai = 0; ai < 2; ++ai)
#pragma unroll
            for (int m = 0; m < 4; ++m) { bf16_t* rowp = Hout + (size_t)(row0 + ai * HALF + m * 16) * DFF + col0;
#pragma unroll
                for (int bj = 0; bj < 2; ++bj) { const f32x4 gt = acc[ai][bj][m][0], up = acc[ai][bj][m][1]; float h[4];
#pragma unroll
                    for (int i = 0; i < 4; ++i) h[i] = gt[i] / (1.0f + __expf(-gt[i])) * up[i];
                    u32x2 w; w.x = cvt_pk_bf16(h[0], h[1]); w.y = cvt_pk_bf16(h[2], h[3]);
                    *(u32x2*)(rowp + bj * 64) = w; } }
    }
};
struct EpiResid {
    static constexpr bool PERM = false;
    const float* base_lat; const float* base_ctx; float* out_lat; float* out_ctx; const float* gate; float gs;
    __device__ __forceinline__ void operator()(const f32x4 (&acc)[2][2][4][2], const Unit& u, int wr, int wc, int fr, int fq) const {
        const bool lat = u.pm < ML / BM; const int set = lat ? (u.pm >> 4) : 4;
        const float* bp = lat ? base_lat + (size_t)u.pm * BM * D : base_ctx + (size_t)(u.pm - ML / BM) * BM * D;
        float* op = lat ? out_lat + (size_t)u.pm * BM * D : out_ctx + (size_t)(u.pm - ML / BM) * BM * D;
        const int col0 = u.pn * BM + wc * 32 + 4 * fq;
        f32x4 gv[2][2];
#pragma unroll
        for (int bj = 0; bj < 2; ++bj)
#pragma unroll
            for (int n = 0; n < 2; ++n) gv[bj][n] = *(const f32x4*)(gate + (size_t)set * 9 * D + col0 + bj * HALF + n * 16) * gs;
#pragma unroll
        for (int ai = 0; ai < 2; ++ai)
#pragma unroll
            for (int m = 0; m < 4; ++m) { const size_t off = (size_t)(wr * 64 + fr + ai * HALF + m * 16) * D + col0;
#pragma unroll
                for (int bj = 0; bj < 2; ++bj)
#pragma unroll
                    for (int n = 0; n < 2; ++n) { const f32x4 bs = *(const f32x4*)(bp + off + bj * HALF + n * 16); *(f32x4*)(op + off + bj * HALF + n * 16) = bs + gv[bj][n] * acc[ai][bj][m][n]; }
                if (m & 1) asm volatile("" ::: "memory"); }
    }
};
struct EpiDnIn {
    static constexpr bool PERM = true;
    bf16_t* QKVP; bf16_t* Z; float* AB;
    __device__ __forceinline__ void operator()(const f32x4 (&acc)[2][2][4][2], const Unit& u, int wr, int wc, int fr, int fq) const {
#pragma unroll
        for (int ai = 0; ai < 2; ++ai)
#pragma unroll
            for (int m = 0; m < 4; ++m) {
                const int r = u.pm * BM + ai * HALF + wr * 64 + m * 16 + fr; int sr = r;
                if (r < ML) { const int s = r & (SEQ - 1); sr = (r & ~(SEQ - 1)) + ((s & 63) << 6) + (s >> 6); }
                if (u.pn < 16) {
                    bf16_t* rowp = (u.pn < 12) ? QKVP + (size_t)sr * 3072 + u.pn * BM : Z + (size_t)sr * D + (u.pn - 12) * BM;
                    rowp += wc * 32 + 8 * fq;
#pragma unroll
                    for (int bj = 0; bj < 2; ++bj) { const f32x4 v0 = acc[ai][bj][m][0], v1 = acc[ai][bj][m][1];
                        u32x4 w; w.x = cvt_pk_bf16(v0[0], v0[1]); w.y = cvt_pk_bf16(v0[2], v0[3]); w.z = cvt_pk_bf16(v1[0], v1[1]); w.w = cvt_pk_bf16(v1[2], v1[3]);
                        *(u32x4*)(rowp + bj * HALF) = w; }
                } else if (wc == 0) {
                    float* rowp = AB + (size_t)sr * 32 + 8 * fq;
                    *(f32x4*)(rowp) = acc[ai][0][m][0]; *(f32x4*)(rowp + 4) = acc[ai][0][m][1];
                }
            }
    }
};
template <int PASS> struct EpiGates {
    static constexpr bool PERM = false;
    const bf16_t* U; const bf16_t* Y; bf16_t* RO; const float* bgate; const float* lam; float* agga; float* aggb; const float* carry;
    __device__ __forceinline__ void operator()(const f32x4 (&acc)[2][2][4][2], const Unit& u, int wr, int wc, int fr, int fq) const {
        const int ch0 = (u.pn >> 2) * 256 + (u.pn & 3) * 64 + wc * 16 + fq * 4;
#pragma unroll
        for (int ai = 0; ai < 2; ++ai) {
            const int q = u.pm * 4 + ai * 2 + wr;
            f32x4 hsum[4];
#pragma unroll
            for (int dir = 0; dir < 2; ++dir) {
                const f32x4 br = *(const f32x4*)(bgate + (dir * 2 + 0) * D + ch0), bi = *(const f32x4*)(bgate + (dir * 2 + 1) * D + ch0);
                const f32x4 sp8 = *(const f32x4*)(lam + dir * D + ch0);
                const size_t qo = ((size_t)dir * NQ + q) * D + ch0;
                f32x4 hin, Ac = {1.f, 1.f, 1.f, 1.f};
                if (PASS == 0) hin = (f32x4){0.f, 0.f, 0.f, 0.f}; else hin = *(const f32x4*)(carry + qo);
#pragma unroll
                for (int mm = 0; mm < 4; ++mm) {
                    const int m = dir == 0 ? mm : 3 - mm;
                    const u32x2 w = *(const u32x2*)(U + (size_t)(q * 64 + m * 16 + fr) * D + ch0);
                    const f32x4 uv = {bflo(w.x), bfhi(w.x), bflo(w.y), bfhi(w.y)};
                    const f32x4 pr = acc[ai][dir][m][0] + br, pi = acc[ai][dir][m][1] + bi;
                    f32x4 a, b;
#pragma unroll
                    for (int i = 0; i < 4; ++i) { const float rg = fsigmoid_(pr[i]), ig = fsigmoid_(pi[i]); const float la = -sp8[i] * rg;
                        a[i] = fexp_(la); b[i] = __builtin_amdgcn_sqrtf(fmaxf(1.0f - a[i] * a[i], 0.f)) * ig * uv[i]; }
#pragma unroll
                    for (int d = 1; d < 16; d <<= 1) {
                        f32x4 ap, bp; bool ok;
                        if (dir == 0) { ok = fr >= d;
#pragma unroll
                            for (int i = 0; i < 4; ++i) { ap[i] = __shfl_up(a[i], d, 16); bp[i] = __shfl_up(b[i], d, 16); } }
                        else { ok = fr + d < 16;
#pragma unroll
                            for (int i = 0; i < 4; ++i) { ap[i] = __shfl_down(a[i], d, 16); bp[i] = __shfl_down(b[i], d, 16); } }
                        if (ok) { b = a * bp + b; a = a * ap; }
                    }
                    f32x4 at, bt;
#pragma unroll
                    for (int i = 0; i < 4; ++i) { at[i] = __shfl(a[i], dir == 0 ? 15 : 0, 16); bt[i] = __shfl(b[i], dir == 0 ? 15 : 0, 16); }
                    if (PASS == 1) { const f32x4 h = a * hin + b; if (dir == 0) hsum[m] = h; else hsum[m] = hsum[m] + h; }
                    hin = at * hin + bt; Ac = Ac * at;
                    asm volatile("" ::: "memory");
                }
                if (PASS == 0) { if (fr == 0) { *(f32x4*)(agga + qo) = Ac; *(f32x4*)(aggb + qo) = hin; } }
            }
            if (PASS == 1) {
#pragma unroll
                for (int m = 0; m < 4; ++m) { const size_t off = (size_t)(q * 64 + m * 16 + fr) * D + ch0; const u32x2 w = *(const u32x2*)(Y + off);
                    const float y0 = bflo(w.x), y1 = bfhi(w.x), y2 = bflo(w.y), y3 = bfhi(w.y);
                    u32x2 o; o.x = cvt_pk_bf16(fgelu_tanh(y0) * hsum[m][0], fgelu_tanh(y1) * hsum[m][1]); o.y = cvt_pk_bf16(fgelu_tanh(y2) * hsum[m][2], fgelu_tanh(y3) * hsum[m][3]);
                    *(u32x2*)(RO + off) = o; }
            }
        }
    }
};
}

#define XB_TMO      128
#define XB_XCNT(j)  (256  + 64 * (j))
#define XB_XSUB(j)  (1280 + 64 * (j))
#define XB_XGEN(j)  (2304 + 64 * (j))
#define XB_TOP      3328
#define XB_TOPGEN   3392
#define XCD_BAR_WORDS 3456
#define XB_SPIN_CAP (1u << 18)
__device__ __forceinline__ unsigned xb_ld(unsigned* p)              { return __hip_atomic_load(p, __ATOMIC_RELAXED, __HIP_MEMORY_SCOPE_AGENT); }
__device__ __forceinline__ unsigned xb_add(unsigned* p, unsigned v) { return __hip_atomic_fetch_add(p, v, __ATOMIC_RELAXED, __HIP_MEMORY_SCOPE_AGENT); }
__device__ __forceinline__ unsigned xb_xcc_id() { return (unsigned)__builtin_amdgcn_s_getreg((3 << 11) | 20) & 0xFu; }
#define XB_SPIN(cond, bar) do { unsigned _sp = 0; while (cond) { __builtin_amdgcn_s_sleep(1); \
    if ((++_sp & 255u) == 0u) { if (xb_ld(&(bar)[XB_TMO])) break; if (_sp > XB_SPIN_CAP) { atomicAdd(&(bar)[XB_TMO], 1u); break; } } } } while (0)
struct XcdBarrier { unsigned* bar; unsigned x; volatile LAS unsigned* st; };
__device__ __forceinline__ XcdBarrier xcd_barrier_post(unsigned* bar, volatile LAS unsigned* st) {
    XcdBarrier b; b.bar = bar; b.x = xb_xcc_id(); b.st = st;
    if (threadIdx.x == 0) (void)xb_add(&bar[XB_XCNT(b.x)], 1u);
    return b;
}
__device__ __forceinline__ void xcd_barrier_complete(unsigned* bar, unsigned x, unsigned& nloc, unsigned& nx) {
    const unsigned G = gridDim.x * gridDim.y * gridDim.z;
    unsigned sum, cnt, mine, sp = 0u;
    for (;;) {
        sum = 0u; cnt = 0u; mine = 0u;
#pragma unroll
        for (unsigned j = 0; j < 16; ++j) { const unsigned c = xb_ld(&bar[XB_XCNT(j)]); sum += c; cnt += (c > 0u) ? 1u : 0u; mine = (j == x) ? c : mine; }
        if (sum == G) break;
        __builtin_amdgcn_s_sleep(1);
        if ((++sp & 255u) == 0u) { if (xb_ld(&bar[XB_TMO])) break; if (sp > XB_SPIN_CAP) { atomicAdd(&bar[XB_TMO], 1u); break; } }
    }
    nloc = mine > 0u ? mine : 1u; nx = cnt > 0u ? cnt : 1u;
}
__device__ __forceinline__ void xcd_barrier(const XcdBarrier& b) {
    asm volatile("s_waitcnt vmcnt(0)" ::: "memory");
    __syncthreads();
    if (threadIdx.x == 0) {
        unsigned* bar = b.bar;
        __builtin_amdgcn_s_waitcnt(0);
        unsigned nloc = b.st[0], nx = b.st[1];
        if (nloc == 0u) { xcd_barrier_complete(bar, b.x, nloc, nx); b.st[0] = nloc; b.st[1] = nx; }
        const unsigned old = xb_add(&bar[XB_XSUB(b.x)], 1u);
        const unsigned gen = old / nloc;
        if (old + 1u == (gen + 1u) * nloc) {
            __builtin_amdgcn_fence(__ATOMIC_RELEASE, "agent");
            asm volatile("s_waitcnt vmcnt(0)" ::: "memory");
            const unsigned og = xb_add(&bar[XB_TOP], 1u);
            const unsigned tg = og / nx;
            if (og + 1u == (tg + 1u) * nx) xb_add(&bar[XB_TOPGEN], 1u);
            else XB_SPIN(xb_ld(&bar[XB_TOPGEN]) == tg, bar);
            __builtin_amdgcn_fence(__ATOMIC_ACQUIRE, "agent");
            xb_add(&bar[XB_XGEN(b.x)], 1u);
            asm volatile("s_waitcnt vmcnt(0)" ::: "memory");
        } else {
            XB_SPIN(xb_ld(&bar[XB_XGEN(b.x)]) == gen, bar);
            __builtin_amdgcn_fence(__ATOMIC_ACQUIRE, "agent");
            asm volatile("s_waitcnt vmcnt(0)" ::: "memory");
        }
    }
    __syncthreads();
}

struct Args { const float* in[23]; float* out; unsigned char* ws; int ph_lo, ph_hi; };
struct Frame { LAS unsigned char* lds; int tid, lane, wave, vcu, G; };

struct MapId { __device__ __forceinline__ int operator()(int s) const { return s; } };
struct MapW1 { __device__ __forceinline__ int operator()(int s) const { const int n = s >= DFF ? 1 : 0, hid = s - n * DFF, rem = hid & 127; return (hid >> 7) * 256 + (rem >> 6) * 128 + ((rem >> 4) & 3) * 32 + n * 16 + (rem & 15); } };
struct MapWG { int dir, gate; __device__ __forceinline__ int operator()(int ch) const { return (ch >> 6) * 256 + dir * 128 + ((ch >> 4) & 3) * 32 + gate * 16 + (ch & 15); } };
template <class RowMap>
__device__ __forceinline__ void transpose_item(const float* src, int ld, int item, int nblk, bf16_t* dst, int Kd, LAS float* scr, int lane, const RowMap rm) {
    const int kb = item / nblk, nb = item % nblk, k0 = 64 * kb, n0 = 32 * nb;
#pragma unroll 8
    for (int i = 0; i < 32; ++i) { const int kk = 2 * i + (lane >> 5); scr[kk * 33 + (lane & 31)] = src[(size_t)(k0 + kk) * ld + n0 + (lane & 31)]; }
    LDS_WAIT(); asm volatile("" ::: "memory");
    const int c = lane & 7;
#pragma unroll
    for (int j = 0; j < 4; ++j) { const int n = (lane >> 3) + 8 * j; const LAS float* s = scr + (8 * c) * 33 + n;
        u32x4 o; o.x = pk2(s[0 * 33], s[1 * 33]); o.y = pk2(s[2 * 33], s[3 * 33]); o.z = pk2(s[4 * 33], s[5 * 33]); o.w = pk2(s[6 * 33], s[7 * 33]);
        *(u32x4*)(dst + (size_t)rm(n0 + n) * Kd + k0 + 8 * c) = o; }
    LDS_WAIT(); asm volatile("" ::: "memory");
}

__device__ __forceinline__ void p_prologue(const Frame& F, const Args& a) {
    unsigned char* ws = a.ws;
    LAS float* scr = (LAS float*)(F.lds + F.wave * 16384);
    const int gw = F.vcu * NWAVES + F.wave, NGW = F.G * NWAVES;
    constexpr int I_W1 = (D / 64) * (2 * DFF / 32), I_W2 = (DFF / 64) * (D / 32), I_LIN = (D / 64) * (2048 / 32), I_LG = (256 / 64) * (256 / 32), I_SQ = (D / 64) * (D / 32), I_DIN = (D / 64) * (DNP / 32);
    constexpr int NITEMS = 4 * I_W1 + 4 * I_W2 + I_LIN + 16 * I_LG + I_SQ + I_DIN + I_SQ;
    for (int it = gw; it < NITEMS; it += NGW) {
        int r = it;
        if (r < 4 * I_W1) { const int w = r / I_W1; transpose_item(a.in[7] + (size_t)w * D * 2 * DFF, 2 * DFF, r % I_W1, 2 * DFF / 32, (bf16_t*)(ws + WS_W1 + w * W1_SZ), D, scr, F.lane, MapW1()); continue; } r -= 4 * I_W1;
        if (r < 4 * I_W2) { const int w = r / I_W2; transpose_item(a.in[8] + (size_t)w * DFF * D, D, r % I_W2, D / 32, (bf16_t*)(ws + WS_W2 + w * W2_SZ), DFF, scr, F.lane, MapId()); continue; } r -= 4 * I_W2;
        if (r < I_LIN) { transpose_item(a.in[9], 2048, r, 2048 / 32, (bf16_t*)(ws + WS_WLIN), D, scr, F.lane, MapId()); continue; } r -= I_LIN;
        if (r < 16 * I_LG) { const int j = r / I_LG, dir = j >> 3, gate = (j >> 2) & 1, head = j & 3;
            transpose_item(a.in[12] + (size_t)j * 256 * 256, 256, r % I_LG, 256 / 32, (bf16_t*)(ws + WS_WLG) + (size_t)head * 1024 * 256, 256, scr, F.lane, MapWG{dir, gate}); continue; } r -= 16 * I_LG;
        if (r < I_SQ) { transpose_item(a.in[15], D, r, D / 32, (bf16_t*)(ws + WS_WLO), D, scr, F.lane, MapId()); continue; } r -= I_SQ;
        if (r < I_DIN) { transpose_item(a.in[16], DNP, r, DNP / 32, (bf16_t*)(ws + WS_WDIN), D, scr, F.lane, MapId()); continue; } r -= I_DIN;
        transpose_item(a.in[21], D, r, D / 32, (bf16_t*)(ws + WS_WDO), D, scr, F.lane, MapId());
    }
    const size_t gt = (size_t)F.vcu * (NWAVES * 64) + F.tid, GT = (size_t)F.G * NWAVES * 64;
    { u32x4* p = (u32x4*)(ws + WS_WDIN + (size_t)DNP * D * 2); const size_t n = (size_t)(DNPP - DNP) * D * 2 / 16; for (size_t i = gt; i < n; i += GT) p[i] = (u32x4){0u, 0u, 0u, 0u}; }
    { u32x4* p = (u32x4*)(ws + WS_O); const size_t n = (size_t)ML * D * 4 / 16; for (size_t i = gt; i < n; i += GT) p[i] = (u32x4){0u, 0u, 0u, 0u}; }
    if (gt < 2 * D) ((float*)(ws + WS_SP8))[gt] = 8.0f * softplusf_(-a.in[14][gt]);
    float* MOD = (float*)(ws + WS_MOD);
    for (int it = F.vcu; it < 2 * 18 * 32; it += F.G) {
        const int l = it / (18 * 32), rem = it % (18 * 32), cb = rem >> 5, kc = rem & 31, col = cb * 512 + F.tid;
        const float* w = a.in[4] + (size_t)l * D * 9 * D + (size_t)(kc * 32) * 9 * D + col;
        float s[5] = {0.f, 0.f, 0.f, 0.f, 0.f};
#pragma unroll 4
        for (int k = 0; k < 32; ++k) { const float wv = w[(size_t)k * 9 * D]; const int kk = kc * 32 + k;
#pragma unroll
            for (int st = 0; st < 5; ++st) { const float cv = st < 4 ? a.in[1][st * D + kk] : a.in[3][kk]; s[st] += siluf_(cv) * wv; } }
        const float bias = kc == 0 ? a.in[5][l * 9 * D + col] : 0.f;
#pragma unroll
        for (int st = 0; st < 5; ++st) atomicAdd(MOD + (size_t)l * MODL + st * 9 * D + col, s[st] + bias);
    }
}

__device__ __forceinline__ void p_norm(const Frame& F, const float* xl, const float* xc, int nrows, const float* g, const float* mod, bf16_t* XN) {
    const int gw = F.vcu * NWAVES + F.wave, NGW = F.G * NWAVES;
    for (int r = gw; r < nrows; r += NGW) {
        const float* src = r < ML ? xl + (size_t)r * D : xc + (size_t)(r - ML) * D; const int set = r < ML ? (r >> 12) : 4;
        const f32x4* x4 = (const f32x4*)src + F.lane; const f32x4* g4 = (const f32x4*)g + F.lane;
        const f32x4* sh4 = (const f32x4*)(mod + (size_t)set * 9 * D) + F.lane; const f32x4* sc4 = (const f32x4*)(mod + (size_t)set * 9 * D + D) + F.lane;
        f32x4 v[4]; float ss = 0.f;
#pragma unroll
        for (int j = 0; j < 4; ++j) { v[j] = x4[64 * j]; ss += (v[j].x * v[j].x + v[j].y * v[j].y) + (v[j].z * v[j].z + v[j].w * v[j].w); }
        const float rstd = 1.0f / sqrtf(wave_sum(ss) * (1.0f / D) + EPS);
        u32x2* o8 = (u32x2*)(XN + (size_t)r * D) + F.lane;
#pragma unroll
        for (int j = 0; j < 4; ++j) { const f32x4 y = v[j] * rstd * g4[64 * j] * (sc4[64 * j] + 1.0f) + sh4[64 * j]; u32x2 w; w.x = pk2(y.x, y.y); w.y = pk2(y.z, y.w); o8[64 * j] = w; }
    }
}
__device__ __forceinline__ void p_final(const Frame& F, float* x, const float* g) {
    const int gw = F.vcu * NWAVES + F.wave, NGW = F.G * NWAVES;
    for (int r = gw; r < ML; r += NGW) {
        f32x4* x4 = (f32x4*)(x + (size_t)r * D) + F.lane; const f32x4* g4 = (const f32x4*)g + F.lane;
        f32x4 v[4]; float ss = 0.f;
#pragma unroll
        for (int j = 0; j < 4; ++j) { v[j] = x4[64 * j]; ss += (v[j].x * v[j].x + v[j].y * v[j].y) + (v[j].z * v[j].z + v[j].w * v[j].w); }
        const float rstd = 1.0f / sqrtf(wave_sum(ss) * (1.0f / D) + EPS);
#pragma unroll
        for (int j = 0; j < 4; ++j) x4[64 * j] = v[j] * rstd * g4[64 * j];
    }
}
__device__ __forceinline__ void p_lru_conv(const Frame& F, const bf16_t* UP, const float* cw, const float* cb, bf16_t* U) {
    const size_t gt = (size_t)F.vcu * (NWAVES * 64) + F.tid, GT = (size_t)F.G * NWAVES * 64;
    for (size_t idx = gt; idx < (size_t)MT * 128; idx += GT) {
        const int r = (int)(idx >> 7), c8 = (int)(idx & 127) * 8;
        int pos, len; if (r < ML) { pos = r & (SEQ - 1); len = SEQ; } else { pos = (r - ML) & (CTXL - 1); len = CTXL; }
        float o[8];
#pragma unroll
        for (int i = 0; i < 8; ++i) o[i] = cb[c8 + i];
#pragma unroll
        for (int j = 0; j < 4; ++j) { const int p = pos + j - 2; if (p < 0 || p >= len) continue;
            const u32x4 w = *(const u32x4*)(UP + (size_t)(r + j - 2) * D + c8); const float* cwj = cw + j * D + c8;
            o[0] += bflo(w.x) * cwj[0]; o[1] += bfhi(w.x) * cwj[1]; o[2] += bflo(w.y) * cwj[2]; o[3] += bfhi(w.y) * cwj[3];
            o[4] += bflo(w.z) * cwj[4]; o[5] += bfhi(w.z) * cwj[5]; o[6] += bflo(w.w) * cwj[6]; o[7] += bfhi(w.w) * cwj[7]; }
        u32x4 ov; ov.x = pk2(o[0], o[1]); ov.y = pk2(o[2], o[3]); ov.z = pk2(o[4], o[5]); ov.w = pk2(o[6], o[7]);
        *(u32x4*)(U + (size_t)r * D + c8) = ov;
    }
}
__device__ __forceinline__ void p_lru_carry(const Frame& F, const float* agga, const float* aggb, float* carry) {
    const int idx = F.vcu * (NWAVES * 64) + F.tid;
    if (idx >= NB * 2 * D) return;
    const int ch = idx & (D - 1), dir = (idx >> 10) & 1, b = idx >> 11;
    float st = 0.f;
    for (int n = 0; n < 68; ++n) {
        int q; if (n < 4) q = 256 + 4 * b + (dir == 0 ? n : 3 - n); else q = 64 * b + (dir == 0 ? n - 4 : 63 - (n - 4));
        const size_t o = ((size_t)dir * NQ + q) * D + ch;
        carry[o] = st; st = agga[o] * st + aggb[o];
    }
}
__device__ __forceinline__ void p_dn_seq(const Frame& F, const bf16_t* QKVP, const float* AB, const float* cw, const float* a_log, const float* dt_bias, float* O) {
    LAS float* kq = (LAS float*)F.lds;
    LAS float* vb = (LAS float*)(F.lds + 32768);
    LAS float* sc = (LAS float*)(F.lds + 49152);
    const int tid = F.tid, dv = tid >> 2, kqi = tid & 3, tok = tid >> 5, l32 = tid & 31, col4 = l32 * 4;
    for (int item = blockIdx.x; item < 64; item += F.G) {
        const int b = item >> 4, h = (item >> 1) & 7, dir = item & 1;
        float cwr[4][3][4];
#pragma unroll
        for (int j = 0; j < 4; ++j)
#pragma unroll
            for (int p = 0; p < 3; ++p)
#pragma unroll
                for (int i = 0; i < 4; ++i) cwr[j][p][i] = cw[j * 3072 + p * 1024 + h * 128 + col4 + i];
        const float nexpa = -expf(a_log[dir * 8 + h]), dtb = dt_bias[dir * 8 + h];
        float S[32];
#pragma unroll
        for (int j = 0; j < 32; ++j) S[j] = 0.f;
        u32x2 raw[4][3]; float ra = 0.f, rb = 0.f;
#define DN_LOAD(bt) do { const int n_ = (bt) * 16 + tok; int pos_, len_, rowb_; \
            if (n_ < CTXL) { pos_ = dir == 0 ? n_ : CTXL - 1 - n_; len_ = CTXL; rowb_ = ML + b * CTXL; } else { pos_ = dir == 0 ? n_ - CTXL : SEQ - 1 - (n_ - CTXL); len_ = SEQ; rowb_ = b * SEQ; } \
            _Pragma("unroll") for (int j = 0; j < 4; ++j) { const int p_ = pos_ + j - 2; const bool ok_ = p_ >= 0 && p_ < len_; const bf16_t* rp_ = QKVP + (size_t)(rowb_ + (ok_ ? p_ : pos_)) * 3072 + h * 128 + col4; \
                _Pragma("unroll") for (int p3 = 0; p3 < 3; ++p3) { u32x2 w_ = *(const u32x2*)(rp_ + p3 * 1024); if (!ok_) { w_.x = 0u; w_.y = 0u; } raw[j][p3] = w_; } } \
            ra = AB[(size_t)(rowb_ + pos_) * 32 + dir * 8 + h]; rb = AB[(size_t)(rowb_ + pos_) * 32 + 16 + dir * 8 + h]; } while (0)
        DN_LOAD(0);
        for (int bt = 0; bt < (CTXL + SEQ) / 16; ++bt) {
            const int buf = bt & 1;
            {
                float x[3][4];
#pragma unroll
                for (int p = 0; p < 3; ++p) {
#pragma unroll
                    for (int i = 0; i < 4; ++i) x[p][i] = 0.f;
#pragma unroll
                    for (int j = 0; j < 4; ++j) { const u32x2 w = raw[j][p];
                        x[p][0] += bflo(w.x) * cwr[j][p][0]; x[p][1] += bfhi(w.x) * cwr[j][p][1]; x[p][2] += bflo(w.y) * cwr[j][p][2]; x[p][3] += bfhi(w.y) * cwr[j][p][3]; }
#pragma unroll
                    for (int i = 0; i < 4; ++i) x[p][i] = siluf_(x[p][i]);
                }
                float sq = (x[0][0] * x[0][0] + x[0][1] * x[0][1]) + (x[0][2] * x[0][2] + x[0][3] * x[0][3]);
                float sk = (x[1][0] * x[1][0] + x[1][1] * x[1][1]) + (x[1][2] * x[1][2] + x[1][3] * x[1][3]);
#pragma unroll
                for (int o = 1; o < 32; o <<= 1) { sq += __shfl_xor(sq, o); sk += __shfl_xor(sk, o); }
                const float rq = 0.08838834764831845f / sqrtf(sq + EPS), rk = 1.0f / sqrtf(sk + EPS);
                LAS float* kp = kq + (buf * 16 + tok) * 256;
                *(LAS f32x4*)(kp + col4) = (f32x4){x[1][0] * rk, x[1][1] * rk, x[1][2] * rk, x[1][3] * rk};
                *(LAS f32x4*)(kp + 128 + col4) = (f32x4){x[0][0] * rq, x[0][1] * rq, x[0][2] * rq, x[0][3] * rq};
                *(LAS f32x4*)(vb + (buf * 16 + tok) * 128 + col4) = (f32x4){x[2][0], x[2][1], x[2][2], x[2][3]};
                if (l32 == 0) { sc[(buf * 16 + tok) * 2] = expf(nexpa * softplusf_(ra + dtb)); sc[(buf * 16 + tok) * 2 + 1] = sigmoidf_(rb); }
            }
            __syncthreads();
            if (bt + 1 < (CTXL + SEQ) / 16) DN_LOAD(bt + 1);
            const bool latent = bt >= CTXL / 16;
            for (int t = 0; t < 16; ++t) {
                const LAS float* kp = kq + (buf * 16 + t) * 256 + kqi * 32;
                const float eg = sc[(buf * 16 + t) * 2], beta = sc[(buf * 16 + t) * 2 + 1], vv = vb[(buf * 16 + t) * 128 + dv];
                float kr[32]; float part = 0.f;
#pragma unroll
                for (int j = 0; j < 8; ++j) { const f32x4 k4 = *(const LAS f32x4*)(kp + 4 * j); kr[4 * j] = k4.x; kr[4 * j + 1] = k4.y; kr[4 * j + 2] = k4.z; kr[4 * j + 3] = k4.w; }
#pragma unroll
                for (int j = 0; j < 32; ++j) part += kr[j] * S[j];
                part += __shfl_xor(part, 1); part += __shfl_xor(part, 2);
                const float vn = beta * (vv - eg * part);
#pragma unroll
                for (int j = 0; j < 32; ++j) S[j] = eg * S[j] + kr[j] * vn;
                float op = 0.f;
#pragma unroll
                for (int j = 0; j < 8; ++j) { const f32x4 q4 = *(const LAS f32x4*)(kp + 128 + 4 * j); op += q4.x * S[4 * j] + q4.y * S[4 * j + 1] + q4.z * S[4 * j + 2] + q4.w * S[4 * j + 3]; }
                op += __shfl_xor(op, 1); op += __shfl_xor(op, 2);
                if (latent && kqi == 0) { const int n = bt * 16 + t - CTXL; const int p = dir == 0 ? n : SEQ - 1 - n; const int s = ((p & 63) << 6) + (p >> 6);
                    atomicAdd(O + (size_t)(b * SEQ + s) * D + h * 128 + dv, op); }
            }
        }
#undef DN_LOAD
        __syncthreads();
    }
}
__device__ __forceinline__ void p_dn_ro(const Frame& F, const float* O, const bf16_t* Z, const float* gn, bf16_t* RO) {
    const int gw = F.vcu * NWAVES + F.wave, NGW = F.G * NWAVES;
    for (int r = gw; r < ML; r += NGW) {
        const int s = r & (SEQ - 1), sr = (r & ~(SEQ - 1)) + ((s & 63) << 6) + (s >> 6);
        const f32x4* o4 = (const f32x4*)(O + (size_t)r * D + F.lane * 16);
        f32x4 v[4]; float ss = 0.f;
#pragma unroll
        for (int j = 0; j < 4; ++j) { v[j] = o4[j]; ss += (v[j].x * v[j].x + v[j].y * v[j].y) + (v[j].z * v[j].z + v[j].w * v[j].w); }
        ss += __shfl_xor(ss, 1); ss += __shfl_xor(ss, 2); ss += __shfl_xor(ss, 4);
        const float rstd = 1.0f / sqrtf(ss * (1.0f / 128.0f) + EPS);
        const u32x4* z4 = (const u32x4*)(Z + (size_t)sr * D + F.lane * 16);
        const f32x4* g4 = (const f32x4*)(gn + (F.lane & 7) * 16);
        u32x4 ov[2];
#pragma unroll
        for (int hh = 0; hh < 2; ++hh) { const u32x4 zw = z4[hh]; const f32x4 a = v[2 * hh] * rstd * g4[2 * hh], c = v[2 * hh + 1] * rstd * g4[2 * hh + 1];
            ov[hh].x = pk2(a.x * siluf_(bflo(zw.x)), a.y * siluf_(bfhi(zw.x))); ov[hh].y = pk2(a.z * siluf_(bflo(zw.y)), a.w * siluf_(bfhi(zw.y)));
            ov[hh].z = pk2(c.x * siluf_(bflo(zw.z)), c.y * siluf_(bfhi(zw.z))); ov[hh].w = pk2(c.z * siluf_(bflo(zw.w)), c.w * siluf_(bfhi(zw.w))); }
        u32x4* op = (u32x4*)(RO + (size_t)r * D + F.lane * 16); op[0] = ov[0]; op[1] = ov[1];
    }
}

constexpr int N_PHASES = 26;
__global__ void __launch_bounds__(NWAVES * 64, 2) trunk_fwd(Args args) {
    extern __shared__ __attribute__((aligned(16))) unsigned char lds_raw[];
    Frame F;
    F.lds = (LAS unsigned char*)lds_raw;
    F.tid = threadIdx.x; F.lane = F.tid & 63; F.wave = __builtin_amdgcn_readfirstlane(F.tid >> 6);
    F.G = gridDim.x; { const int bx = blockIdx.x; F.vcu = (F.G % 8 == 0) ? (bx % 8) * (F.G / 8) + bx / 8 : bx; }
    unsigned char* ws = args.ws;
    unsigned* ctl = (unsigned*)(ws + WS_CTL);
    for (int u = F.tid; u < (LDS_BYTES - LDSCTL_OFF) / 4; u += NWAVES * 64) ((LAS unsigned*)(F.lds + LDSCTL_OFF))[u] = 0u;
    __syncthreads();
    XcdBarrier bar; bar.bar = ctl + CW_BAR; bar.x = 0; bar.st = nullptr;
    if (!MK_PER_PHASE) bar = xcd_barrier_post(ctl + CW_BAR, (volatile LAS unsigned*)(F.lds + MISC_OFF) + 8);
    const int lo = args.ph_lo, hi = args.ph_hi;
#ifndef MK_PHMASK
#define MK_PHMASK 0xffffffffu
#endif
#define IN(k) ((((unsigned)MK_PHMASK >> (k)) & 1u) && lo <= (k) && (k) < hi)
#define SEAM(k) do { if (IN(k) && IN((k) + 1)) xcd_barrier(bar); } while (0)

    float* MOD = (float*)(ws + WS_MOD);
    float* XL = args.out; float* XC = (float*)(ws + WS_XC);
    bf16_t* XN = (bf16_t*)(ws + WS_XN); bf16_t* HB = (bf16_t*)(ws + WS_H);
    const float* g_sub = args.in[6];
    const int bid = (int)blockIdx.x;

#define PH_FFN1(k, w, MROWS) if (IN(k)) { pg8::Gemm g{XN, (const bf16_t*)(ws + WS_W1 + (w) * W1_SZ), MROWS, 2 * DFF, D, D, 0}; pg8::StaticOrder S; S.init(MROWS, 2 * DFF, F.G, bid); \
        pg8::EpiSwiglu E{HB}; pg8::gemm_phase<pg8::EpiSwiglu, pg8::StaticOrder>(F.lds, g, S, E); } SEAM(k);
#define PH_FFN2(k, w, MROWS, BL, BC, GATE) if (IN(k)) { pg8::Gemm g{HB, (const bf16_t*)(ws + WS_W2 + (w) * W2_SZ), MROWS, D, DFF, DFF, 0}; pg8::StaticOrder S; S.init(MROWS, D, F.G, bid); \
        pg8::EpiResid E{BL, BC, XL, XC, GATE, 0.5f}; pg8::gemm_phase<pg8::EpiResid, pg8::StaticOrder>(F.lds, g, S, E); } SEAM(k);
#define PH_NORM(k, SRCL, SRCC, NROWS, l, sub) if (IN(k)) { p_norm(F, SRCL, SRCC, NROWS, g_sub + ((l) * 3 + (sub)) * D, MOD + (size_t)(l) * MODL + (sub) * 3 * D, XN); } SEAM(k);

    if (IN(0)) { p_prologue(F, args); } SEAM(0);
    PH_NORM(1, args.in[0], args.in[2], MT, 0, 0)
    PH_FFN1(2, 0, MT)
    PH_FFN2(3, 0, MT, args.in[0], args.in[2], MOD + 0 * MODL + 2 * D)
    PH_NORM(4, XL, XC, MT, 0, 1)
    if (IN(5)) { pg8::Gemm g{XN, (const bf16_t*)(ws + WS_WLIN), MT, 2048, D, D, 0}; pg8::StaticOrder S; S.init(MT, 2048, F.G, bid);
        pg8::EpiBf16 E{(bf16_t*)(ws + WS_Y), D, D, (size_t)(WS_UP - WS_Y) / 2}; pg8::gemm_phase<pg8::EpiBf16, pg8::StaticOrder>(F.lds, g, S, E); } SEAM(5);
    if (IN(6)) { p_lru_conv(F, (const bf16_t*)(ws + WS_UP), args.in[10], args.in[11], (bf16_t*)(ws + WS_U)); } SEAM(6);
    if (IN(7)) { pg8::Gemm g{(const bf16_t*)(ws + WS_U), (const bf16_t*)(ws + WS_WLG), MT, 4096, 256, D, 4}; pg8::StaticOrder S; S.init(MT, 4096, F.G, bid);
        pg8::EpiGates<0> E{(const bf16_t*)(ws + WS_U), (const bf16_t*)(ws + WS_Y), XN, args.in[13], (const float*)(ws + WS_SP8), (float*)(ws + WS_AGGA), (float*)(ws + WS_AGGB), (const float*)(ws + WS_CARRY)};
        pg8::gemm_phase<pg8::EpiGates<0>, pg8::StaticOrder>(F.lds, g, S, E); } SEAM(7);
    if (IN(8)) { p_lru_carry(F, (const float*)(ws + WS_AGGA), (const float*)(ws + WS_AGGB), (float*)(ws + WS_CARRY)); } SEAM(8);
    if (IN(9)) { pg8::Gemm g{(const bf16_t*)(ws + WS_U), (const bf16_t*)(ws + WS_WLG), MT, 4096, 256, D, 4}; pg8::StaticOrder S; S.init(MT, 4096, F.G, bid);
        pg8::EpiGates<1> E{(const bf16_t*)(ws + WS_U), (const bf16_t*)(ws + WS_Y), XN, args.in[13], (const float*)(ws + WS_SP8), (float*)(ws + WS_AGGA), (float*)(ws + WS_AGGB), (const float*)(ws + WS_CARRY)};
        pg8::gemm_phase<pg8::EpiGates<1>, pg8::StaticOrder>(F.lds, g, S, E); } SEAM(9);
    if (IN(10)) { pg8::Gemm g{XN, (const bf16_t*)(ws + WS_WLO), MT, D, D, D, 0}; pg8::StaticOrder S; S.init(MT, D, F.G, bid);
        pg8::EpiResid E{XL, XC, XL, XC, MOD + 0 * MODL + 5 * D, 1.0f}; pg8::gemm_phase<pg8::EpiResid, pg8::StaticOrder>(F.lds, g, S, E); } SEAM(10);
    PH_NORM(11, XL, XC, MT, 0, 2)
    PH_FFN1(12, 1, MT)
    PH_FFN2(13, 1, MT, XL, XC, MOD + 0 * MODL + 8 * D)
    PH_NORM(14, XL, XC, MT, 1, 0)
    PH_FFN1(15, 2, MT)
    PH_FFN2(16, 2, MT, XL, XC, MOD + 1 * MODL + 2 * D)
    PH_NORM(17, XL, XC, MT, 1, 1)
    if (IN(18)) { pg8::Gemm g{XN, (const bf16_t*)(ws + WS_WDIN), MT, DNPP, D, D, 0}; pg8::StaticOrder S; S.init(MT, DNPP, F.G, bid);
        pg8::EpiDnIn E{(bf16_t*)(ws + WS_QKVP), (bf16_t*)(ws + WS_Z), (float*)(ws + WS_AB)}; pg8::gemm_phase<pg8::EpiDnIn, pg8::StaticOrder>(F.lds, g, S, E); } SEAM(18);
    if (IN(19)) { p_dn_seq(F, (const bf16_t*)(ws + WS_QKVP), (const float*)(ws + WS_AB), args.in[17], args.in[18], args.in[19], (float*)(ws + WS_O)); } SEAM(19);
    if (IN(20)) { p_dn_ro(F, (const float*)(ws + WS_O), (const bf16_t*)(ws + WS_Z), args.in[20], XN); } SEAM(20);
    if (IN(21)) { pg8::Gemm g{XN, (const bf16_t*)(ws + WS_WDO), ML, D, D, D, 0}; pg8::StaticOrder S; S.init(ML, D, F.G, bid);
        pg8::EpiResid E{XL, XC, XL, XC, MOD + 1 * MODL + 5 * D, 1.0f}; pg8::gemm_phase<pg8::EpiResid, pg8::StaticOrder>(F.lds, g, S, E); } SEAM(21);
    PH_NORM(22, XL, XC, ML, 1, 2)
    PH_FFN1(23, 3, ML)
    PH_FFN2(24, 3, ML, XL, XC, MOD + 1 * MODL + 8 * D)
    if (IN(25)) { p_final(F, XL, args.in[22]); }
#undef IN
#undef SEAM
#undef PH_FFN1
#undef PH_FFN2
#undef PH_NORM
}

extern "C" void kernel_launch(void* const* d_in, const int* in_sizes, int n_in, void* d_out, int out_size, void* d_ws, size_t ws_size, hipStream_t stream) {
    static int grid = 0;
    if (grid == 0) {
        if (n_in != 23 || in_sizes[0] != ML * D || out_size != ML * D || ws_size < WS_END) { fprintf(stderr, "kernel_launch: unexpected problem shape (n_in %d, in0 %d, out %d, ws %zu); nothing launched\n", n_in, n_in > 0 ? in_sizes[0] : -1, out_size, ws_size); grid = -1; return; }
        int dev = 0, cus = 0;
        if (hipGetDevice(&dev) != hipSuccess || hipDeviceGetAttribute(&cus, hipDeviceAttributeMultiprocessorCount, dev) != hipSuccess) { grid = -1; return; }
        if (hipFuncSetAttribute((const void*)trunk_fwd, hipFuncAttributeMaxDynamicSharedMemorySize, LDS_BYTES) != hipSuccess) { fprintf(stderr, "kernel_launch: hipFuncSetAttribute failed\n"); grid = -1; return; }
        (void)hipGetLastError();
        grid = cus;
    }
    if (grid < 0) return;
    if (hipMemsetAsync((char*)d_ws + WS_CTL, 0, CTL_ZERO_BYTES, stream) != hipSuccess) return;
    Args a{};
    for (int i = 0; i < 23; ++i) a.in[i] = (const float*)d_in[i];
    a.out = (float*)d_out; a.ws = (unsigned char*)d_ws;
#if MK_PER_PHASE
    for (int p = 0; p < N_PHASES; ++p) { a.ph_lo = p; a.ph_hi = p + 1; hipLaunchKernelGGL(trunk_fwd, dim3(grid), dim3(NWAVES * 64), LDS_BYTES, stream, a); }
#else
    a.ph_lo = 0; a.ph_hi = N_PHASES;
    hipLaunchKernelGGL(trunk_fwd, dim3(grid), dim3(NWAVES * 64), LDS_BYTES, stream, a);
#endif
}
```

```cpp
#include <hip/hip_runtime.h>
#include <cstdio>
#include <cstdint>

#ifndef MK_PER_PHASE
#define MK_PER_PHASE 0
#endif

#define LAS __attribute__((address_space(3)))
typedef unsigned short bf16_t;
typedef short bf16x8 __attribute__((ext_vector_type(8)));
typedef float f32x4 __attribute__((ext_vector_type(4)));
typedef float f32x2 __attribute__((ext_vector_type(2)));
typedef unsigned u32x4 __attribute__((ext_vector_type(4)));
typedef unsigned u32x2 __attribute__((ext_vector_type(2)));

constexpr int D = 1024, NB = 4, SEQ = 4096, CTXL = 256, DFF = 2816;
constexpr int ML = NB * SEQ, MC = NB * CTXL, MT = ML + MC;
constexpr int NQ = MT / 64;
constexpr int MODL = 5 * 9 * D;
constexpr int DNP = 4128, DNPP = 4352;
constexpr float EPS = 1e-6f;

constexpr size_t MiB = 1u << 20;
constexpr size_t WS_CTL = 0, CTL_ZERO_BYTES = 2 * MiB;
constexpr size_t WS_MOD = 1 * MiB;
constexpr size_t WS_W1 = 2 * MiB, W1_SZ = (size_t)2 * DFF * D * 2;
constexpr size_t WS_W2 = 46 * MiB, W2_SZ = (size_t)D * DFF * 2;
constexpr size_t WS_WLIN = 68 * MiB, WS_WLG = 72 * MiB, WS_WLO = 74 * MiB, WS_WDIN = 76 * MiB, WS_WDO = 85 * MiB;
constexpr size_t WS_SP8 = 84 * MiB + 768 * 1024;
constexpr size_t WS_XC = 87 * MiB;
constexpr size_t WS_XN = 91 * MiB;
constexpr size_t WS_H = 125 * MiB;
constexpr size_t WS_Y = 125 * MiB, WS_UP = 159 * MiB, WS_U = 193 * MiB, WS_AGGA = 227 * MiB, WS_AGGB = 230 * MiB, WS_CARRY = 233 * MiB;
constexpr size_t WS_Z = 13 * MiB;
constexpr size_t WS_GC = 48 * MiB;
constexpr size_t WS_HALO = 53 * MiB;
constexpr size_t WS_O = 91 * MiB;
constexpr size_t WS_QKV = 155 * MiB;
constexpr size_t WS_VC = 257 * MiB;
constexpr size_t WS_T = 291 * MiB, WS_P = 317 * MiB;
constexpr size_t WS_AB = 343 * MiB, WS_END = 346 * MiB;
constexpr size_t WS_RO2 = WS_QKV;
static_assert(WS_W1 + 4 * W1_SZ <= WS_W2 && WS_W2 + 4 * W2_SZ <= WS_WLIN && WS_WDIN + (size_t)DNPP * D * 2 <= WS_WDO, "weights map");
static_assert(WS_XN + (size_t)MT * D * 2 <= WS_H && WS_H + (size_t)MT * DFF * 2 <= WS_AGGA, "activation map");
static_assert(WS_Z >= WS_W1 + W1_SZ && WS_Z + (size_t)MT * D * 2 <= WS_GC && WS_GC + (size_t)4352 * 1024 <= WS_HALO && WS_HALO + (size_t)NQ * 3 * 3072 * 2 <= WS_W2 + 3 * W2_SZ, "DeltaNet records over dead weights");
static_assert(WS_O + (size_t)ML * D * 4 <= WS_QKV && WS_QKV + (size_t)MT * 3072 * 2 <= WS_VC && WS_VC + (size_t)2176 * 16384 <= WS_T && WS_T + (size_t)4352 * 6144 <= WS_P && WS_P + (size_t)4352 * 6144 <= WS_AB && WS_AB + (size_t)MT * 32 * 4 <= WS_END, "DeltaNet map");
constexpr int CW_BAR = 4096;

constexpr int RING_BYTES = 131072, LDSCTL_OFF = RING_BYTES, MISC_OFF = LDSCTL_OFF + 320, LDS_BYTES = 147456;
constexpr int NWAVES = 8;

#define RLX_AGENT __ATOMIC_RELAXED, __HIP_MEMORY_SCOPE_AGENT
#define LDS_WAIT() asm volatile("s_waitcnt lgkmcnt(0)" ::: "memory")
__device__ __forceinline__ unsigned f2bf(float f) { unsigned u = __builtin_bit_cast(unsigned, f); return (u + 0x7fffu + ((u >> 16) & 1u)) >> 16; }
__device__ __forceinline__ unsigned pk2(float lo, float hi) { return f2bf(lo) | (f2bf(hi) << 16); }
__device__ __forceinline__ float bflo(unsigned w) { return __builtin_bit_cast(float, w << 16); }
__device__ __forceinline__ float bfhi(unsigned w) { return __builtin_bit_cast(float, w & 0xffff0000u); }
__device__ __forceinline__ float sigmoidf_(float x) { return 1.0f / (1.0f + expf(-x)); }
__device__ __forceinline__ float siluf_(float x) { return x / (1.0f + expf(-x)); }
__device__ __forceinline__ float softplusf_(float x) { return fmaxf(x, 0.f) + log1pf(expf(-fabsf(x))); }
__device__ __forceinline__ float fexp_(float x) { return __builtin_amdgcn_exp2f(x * 1.4426950408889634f); }
__device__ __forceinline__ float fsigmoid_(float x) { return __builtin_amdgcn_rcpf(1.0f + fexp_(-x)); }
__device__ __forceinline__ float fgelu_tanh(float x) { const float z = 0.7978845608028654f * (x + 0.044715f * x * x * x); const float t = 1.0f - 2.0f * __builtin_amdgcn_rcpf(1.0f + fexp_(2.0f * z)); return 0.5f * x * (1.0f + t); }
__device__ __forceinline__ float gelu_tanh(float x) { const float t = tanhf(0.7978845608028654f * (x + 0.044715f * x * x * x)); return 0.5f * x * (1.0f + t); }
__device__ __forceinline__ float wave_sum(float v) {
#pragma unroll
    for (int o = 1; o < 64; o <<= 1) v += __shfl_xor(v, o);
    return v;
}

namespace pg8 {
constexpr int BM = 256, BK = 64, HALF = 128, HTB = HALF * BK * 2, STAGE_BYTES = 8 * HTB, NXCD = 8, WGM = 8;
__host__ __device__ __forceinline__ int lds_byte(int r, int c) { const int st = (r >> 4) * 2 + (c >> 5), rr = r & 15, cc = c & 31, ob = rr * 64 + cc * 2; return st * 1024 + (ob ^ (((ob >> 9) & 1) << 5)); }
__host__ __device__ __forceinline__ void stage_rc(int b, int& R, int& C) { const int st = b / 1024, sb = b % 1024, swz = sb ^ (((sb >> 9) & 1) << 5); R = (st >> 1) * 16 + swz / 64; C = (st & 1) * 32 + (swz % 64) / 2; }
__host__ __device__ __forceinline__ int perm32(int rho) { const int n = rho >> 4, i = rho & 15; return 8 * (i >> 2) + 4 * n + (i & 3); }

struct Unit { int pm, pn, r; };
struct Gemm { const bf16_t* A; const bf16_t* Bt; int M, N, K, lda, hdiv; };

struct StaticOrder {
    int nM, nN, nwg, G, c, rep;
    __host__ __device__ void init(int M, int N, int G_, int c_, int rep_ = 1) { nM = M / BM; nN = N / BM; nwg = nM * nN; G = G_; c = c_; rep = rep_; }
    __host__ __device__ bool next(int i, Unit& u) const {
        const int nc = c < nwg ? (nwg - c + G - 1) / G : 0;
        if (i >= nc * rep) return false;
        u.r = i / nc; const long L = (long)(i % nc) * G + c;
        int wgid = (int)L; { const int q = nwg / NXCD, r = nwg % NXCD, xcd = wgid % NXCD, off = wgid / NXCD; wgid = (xcd < r ? xcd * (q + 1) : r * (q + 1) + (xcd - r) * q) + off; }
        const int nig = WGM * nN, gid = wgid / nig, fm = gid * WGM, gsz = (nM - fm) < WGM ? (nM - fm) : WGM;
        u.pm = fm + ((wgid % nig) % gsz); u.pn = (wgid % nig) / gsz; return true;
    }
    __device__ __forceinline__ void a_ready(const Unit&) const {}
    __device__ __forceinline__ void done(const Unit&) const {}
};

__device__ __forceinline__ unsigned cvt_pk_bf16(float lo, float hi) { unsigned r; asm volatile("v_cvt_pk_bf16_f32 %0, %1, %2" : "=v"(r) : "v"(lo), "v"(hi)); return r; }

template <class Epi, class Sched, bool ALIGN_EPI = true, bool SP2 = true>
__device__ __forceinline__ void gemm_phase(LAS unsigned char* lds, const Gemm g, const Sched& S, const Epi& E) {
    const int tid = threadIdx.x, wid = __builtin_amdgcn_readfirstlane(tid >> 6), lane = tid & 63, wr = wid >> 2, wc = wid & 3, fr = lane & 15, fq = lane >> 4;
    const int K = g.K, nt = K / BK, lda = g.lda;
    unsigned voffA[2], voffB[2];
#pragma unroll
    for (int i = 0; i < 2; ++i) { int R, C; stage_rc(tid * 16 + i * 8192, R, C); const int Rb = Epi::PERM ? ((R & ~31) + perm32(R & 31)) : R;
        voffA[i] = (unsigned)(R * lda + C) * 2u; voffB[i] = (unsigned)(Rb * K + C) * 2u; }
    const size_t kstep = (size_t)(BK * 2);
    const size_t hstepA = (size_t)HALF * lda * 2, hstepB = (size_t)HALF * K * 2;
    const size_t tstepA = 2 * hstepA, tstepB = 2 * hstepB;
    const unsigned ldsw = (unsigned)wid * 1024u;
    const int aoff = lds_byte(wr * 64 + fr, fq * 8), boff = lds_byte(wc * 32 + fr, fq * 8);
#define PG8_SA(b, h) (((b) * 2 + (h)) * HTB)
#define PG8_SB(b, h) ((4 + (b) * 2 + (h)) * HTB)
#define PG8_STAGE(bufoff, gbase, voff) do { _Pragma("unroll") for (int _i = 0; _i < 2; ++_i) \
        __builtin_amdgcn_global_load_lds((const unsigned*)((const char*)(gbase) + (voff)[_i]), (LAS unsigned*)(lds + (bufoff) + ldsw + _i * 8192), 16, 0, 0); } while (0)
#define PG8_LDA(dst, b, h) do { _Pragma("unroll") for (int m = 0; m < 4; ++m) _Pragma("unroll") for (int k = 0; k < 2; ++k) dst[m][k] = *(const LAS bf16x8*)(lds + PG8_SA(b, h) + aoff + m * 2048 + k * 1024); } while (0)
#define PG8_LDB(dst, b, h) do { _Pragma("unroll") for (int n = 0; n < 2; ++n) _Pragma("unroll") for (int k = 0; k < 2; ++k) dst[n][k] = *(const LAS bf16x8*)(lds + PG8_SB(b, h) + boff + n * 2048 + k * 1024); } while (0)
#define PG8_MMA(ai, bj, At, Bt) do { __builtin_amdgcn_s_setprio(1); _Pragma("unroll") for (int m = 0; m < 4; ++m) _Pragma("unroll") for (int n = 0; n < 2; ++n) _Pragma("unroll") for (int k = 0; k < 2; ++k) \
        acc[ai][bj][m][n] = __builtin_amdgcn_mfma_f32_16x16x32_bf16(Bt[n][k], At[m][k], acc[ai][bj][m][n], 0, 0, 0); __builtin_amdgcn_s_setprio(0); } while (0)
#define PG8_WAIT_V(n) asm volatile("s_waitcnt vmcnt(" #n ")" ::: "memory")
#define PG8_WAIT_L(n) asm volatile("s_waitcnt lgkmcnt(" #n ")" ::: "memory")
#define PG8_BAR __builtin_amdgcn_s_barrier()
#define PG8_SCHED __builtin_amdgcn_sched_barrier(0)
#define PG8_ABASE(u) ((const char*)g.A + (size_t)(u).pm * tstepA + (g.hdiv ? (size_t)((u).pn / g.hdiv) * (size_t)K * 2 : (size_t)0))
    Unit cur, nxt; int ui = 0;
    if (!S.next(0, cur)) return;
    f32x4 acc[2][2][4][2];
#pragma unroll
    for (int a = 0; a < 2; ++a)
#pragma unroll
        for (int b = 0; b < 2; ++b)
#pragma unroll
            for (int m = 0; m < 4; ++m)
#pragma unroll
                for (int n = 0; n < 2; ++n) acc[a][b][m][n] = (f32x4){0.f, 0.f, 0.f, 0.f};
    bf16x8 At[4][2], B0[2][2], B1[2][2];
    const char* cA = PG8_ABASE(cur); const char* cB = (const char*)g.Bt + (size_t)cur.pn * tstepB;
    S.a_ready(cur);
    if constexpr (SP2) {
        PG8_STAGE(PG8_SB(0, 0), cB, voffB); PG8_STAGE(PG8_SB(0, 1), cB + hstepB, voffB); PG8_STAGE(PG8_SA(0, 0), cA, voffA); PG8_STAGE(PG8_SA(0, 1), cA + hstepA, voffA);
        if (wr == 1) PG8_BAR;
        PG8_WAIT_V(2); PG8_BAR;
        PG8_STAGE(PG8_SB(1, 0), cB + kstep, voffB); PG8_STAGE(PG8_SA(1, 0), cA + kstep, voffA); PG8_STAGE(PG8_SB(1, 1), cB + hstepB + kstep, voffB);
        PG8_WAIT_V(6); PG8_BAR;
    } else {
        PG8_STAGE(PG8_SB(0, 0), cB, voffB); PG8_STAGE(PG8_SA(0, 0), cA, voffA); PG8_STAGE(PG8_SB(0, 1), cB + hstepB, voffB); PG8_STAGE(PG8_SA(0, 1), cA + hstepA, voffA);
        if (wr == 1) PG8_BAR;
        PG8_WAIT_V(4); PG8_BAR;
        PG8_STAGE(PG8_SB(1, 0), cB + kstep, voffB); PG8_STAGE(PG8_SA(1, 0), cA + kstep, voffA); PG8_STAGE(PG8_SB(1, 1), cB + hstepB + kstep, voffB);
        PG8_WAIT_V(6); PG8_BAR;
    }
    for (;;) {
        const bool has_next = S.next(ui + 1, nxt);
        const char* nA = has_next ? PG8_ABASE(nxt) : cA; const char* nB = has_next ? (const char*)g.Bt + (size_t)nxt.pn * tstepB : cB;
        for (int t = 0; t < nt; t += 2) {
            const bool last = (t == nt - 2);
            const char* a1 = cA + (size_t)(t + 1) * kstep;
            const char* a2 = last ? nA : cA + (size_t)(t + 2) * kstep; const char* b2 = last ? nB : cB + (size_t)(t + 2) * kstep;
            const char* a3 = a2 + kstep; const char* b3 = b2 + kstep;
            if (last && has_next) S.a_ready(nxt);
            if constexpr (SP2) {
            PG8_LDB(B0, 0, 0); PG8_LDB(B1, 0, 1); PG8_SCHED; PG8_LDA(At, 0, 0); PG8_STAGE(PG8_SA(1, 1), a1 + hstepA, voffA);
            PG8_WAIT_V(8); PG8_WAIT_L(0); PG8_BAR; PG8_MMA(0, 0, At, B0); PG8_MMA(0, 1, At, B1); PG8_BAR; PG8_SCHED;
            PG8_LDA(At, 0, 1); PG8_STAGE(PG8_SB(0, 0), b2, voffB); PG8_STAGE(PG8_SB(0, 1), b2 + hstepB, voffB); PG8_STAGE(PG8_SA(0, 0), a2, voffA);
            PG8_WAIT_V(8); PG8_WAIT_L(0); PG8_BAR; PG8_MMA(1, 0, At, B0); PG8_MMA(1, 1, At, B1); PG8_BAR; PG8_SCHED;
            PG8_LDB(B0, 1, 0); PG8_LDB(B1, 1, 1); PG8_SCHED; PG8_LDA(At, 1, 0); PG8_STAGE(PG8_SA(0, 1), a2 + hstepA, voffA);
            PG8_WAIT_V(8); PG8_WAIT_L(0); PG8_BAR; PG8_MMA(0, 0, At, B0); PG8_MMA(0, 1, At, B1); PG8_BAR; PG8_SCHED;
            PG8_LDA(At, 1, 1); PG8_STAGE(PG8_SB(1, 0), b3, voffB); PG8_STAGE(PG8_SB(1, 1), b3 + hstepB, voffB); PG8_STAGE(PG8_SA(1, 0), a3, voffA);
            PG8_WAIT_V(8); PG8_WAIT_L(0); PG8_BAR; PG8_MMA(1, 0, At, B0); PG8_MMA(1, 1, At, B1); PG8_BAR; PG8_SCHED;
            } else {
            PG8_LDB(B0, 0, 0); PG8_SCHED; PG8_LDA(At, 0, 0); PG8_STAGE(PG8_SA(1, 1), a1 + hstepA, voffA);
            PG8_WAIT_L(8); PG8_BAR; PG8_WAIT_L(0); PG8_MMA(0, 0, At, B0); PG8_BAR; PG8_SCHED;
            PG8_LDB(B1, 0, 1); PG8_STAGE(PG8_SB(0, 0), b2, voffB);
            PG8_BAR; PG8_WAIT_L(0); PG8_MMA(0, 1, At, B1); PG8_BAR;
            PG8_LDA(At, 0, 1); PG8_STAGE(PG8_SA(0, 0), a2, voffA);
            PG8_BAR; PG8_WAIT_L(0); PG8_MMA(1, 0, At, B0); PG8_BAR; PG8_SCHED;
            PG8_STAGE(PG8_SB(0, 1), b2 + hstepB, voffB);
            PG8_WAIT_V(6); PG8_BAR; PG8_MMA(1, 1, At, B1); PG8_BAR;
            PG8_LDB(B0, 1, 0); PG8_SCHED; PG8_LDA(At, 1, 0); PG8_STAGE(PG8_SA(0, 1), a2 + hstepA, voffA);
            PG8_WAIT_L(8); PG8_BAR; PG8_WAIT_L(0); PG8_MMA(0, 0, At, B0); PG8_BAR; PG8_SCHED;
            PG8_LDB(B1, 1, 1); PG8_STAGE(PG8_SB(1, 0), b3, voffB);
            PG8_BAR; PG8_WAIT_L(0); PG8_MMA(0, 1, At, B1); PG8_BAR;
            PG8_LDA(At, 1, 1); PG8_STAGE(PG8_SA(1, 0), a3, voffA);
            PG8_BAR; PG8_WAIT_L(0); PG8_MMA(1, 0, At, B0); PG8_BAR; PG8_SCHED;
            PG8_STAGE(PG8_SB(1, 1), b3 + hstepB, voffB);
            PG8_WAIT_V(6); PG8_BAR; PG8_MMA(1, 1, At, B1); PG8_BAR;
            }
        }
        if constexpr (ALIGN_EPI) { if (wr == 0) PG8_BAR; }
        E(acc, cur, wr, wc, fr, fq); S.done(cur);
        if (!has_next) break;
#pragma unroll
        for (int a = 0; a < 2; ++a)
#pragma unroll
            for (int b = 0; b < 2; ++b)
#pragma unroll
                for (int m = 0; m < 4; ++m)
#pragma unroll
                    for (int n = 0; n < 2; ++n) acc[a][b][m][n] = (f32x4){0.f, 0.f, 0.f, 0.f};
        cur = nxt; cA = nA; cB = nB; ++ui;
        if constexpr (ALIGN_EPI) { if (wr == 1) PG8_BAR; }
    }
    PG8_WAIT_V(0);
    if constexpr (!ALIGN_EPI) { if (wr == 0) PG8_BAR; }
    PG8_BAR;
#undef PG8_SA
#undef PG8_SB
#undef PG8_STAGE
#undef PG8_LDA
#undef PG8_LDB
#undef PG8_MMA
#undef PG8_WAIT_V
#undef PG8_WAIT_L
#undef PG8_BAR
#undef PG8_SCHED
#undef PG8_ABASE
}

struct EpiBf16 {
    static constexpr bool PERM = true;
    bf16_t* O; int ldc; int split_cols; size_t split_stride;
    __device__ __forceinline__ void operator()(const f32x4 (&acc)[2][2][4][2], const Unit& u, int wr, int wc, int fr, int fq) const {
        const int row0 = u.pm * BM + wr * 64 + fr; int colt = u.pn * BM; bf16_t* base = O;
        if (split_cols) { const int t = colt / split_cols; base += (size_t)t * split_stride; colt -= t * split_cols; }
        const int col0 = colt + wc * 32 + 8 * fq;
#pragma unroll
        for (int ai = 0; ai < 2; ++ai)
#pragma unroll
            for (int m = 0; m < 4; ++m) { bf16_t* rowp = base + (size_t)(row0 + ai * HALF + m * 16) * ldc + col0;
#pragma unroll
                for (int bj = 0; bj < 2; ++bj) { const f32x4 v0 = acc[ai][bj][m][0], v1 = acc[ai][bj][m][1];
                    u32x4 w; w.x = cvt_pk_bf16(v0[0], v0[1]); w.y = cvt_pk_bf16(v0[2], v0[3]); w.z = cvt_pk_bf16(v1[0], v1[1]); w.w = cvt_pk_bf16(v1[2], v1[3]);
                    *(u32x4*)(rowp + bj * HALF) = w; } }
    }
};
struct EpiSwiglu {
    static constexpr bool PERM = false;
    bf16_t* Hout;
    __device__ __forceinline__ void operator()(const f32x4 (&acc)[2][2][4][2], const Unit& u, int wr, int wc, int fr, int fq) const {
        const int row0 = u.pm * BM + wr * 64 + fr, col0 = u.pn * 128 + wc * 16 + 4 * fq;
#pragma unroll
        for (int ai = 0; ai < 2; ++ai)
#pragma unroll
            for (int m = 0; m < 4; ++m) { bf16_t* rowp = Hout + (size_t)(row0 + ai * HALF + m * 16) * DFF + col0;
#pragma unroll
                for (int bj = 0; bj < 2; ++bj) { const f32x4 gt = acc[ai][bj][m][0], up = acc[ai][bj][m][1]; float h[4];
#pragma unroll
                    for (int i = 0; i < 4; ++i) h[i] = gt[i] / (1.0f + __expf(-gt[i])) * up[i];
                    u32x2 w; w.x = cvt_pk_bf16(h[0], h[1]); w.y = cvt_pk_bf16(h[2], h[3]);
                    *(u32x2*)(rowp + bj * 64) = w; } }
    }
};
struct EpiResid {
    static constexpr bool PERM = false;
    const float* base_lat; const float* base_ctx; float* out_lat; float* out_ctx; const float* gate; float gs;
    __device__ __forceinline__ void operator()(const f32x4 (&acc)[2][2][4][2], const Unit& u, int wr, int wc, int fr, int fq) const {
        const bool lat = u.pm < ML / BM; const int set = lat ? (u.pm >> 4) : 4;
        const float* bp = lat ? base_lat + (size_t)u.pm * BM * D : base_ctx + (size_t)(u.pm - ML / BM) * BM * D;
        float* op = lat ? out_lat + (size_t)u.pm * BM * D : out_ctx + (size_t)(u.pm - ML / BM) * BM * D;
        const int col0 = u.pn * BM + wc * 32 + 4 * fq;
        f32x4 gv[2][2];
#pragma unroll
        for (int bj = 0; bj < 2; ++bj)
#pragma unroll
            for (int n = 0; n < 2; ++n) gv[bj][n] = *(const f32x4*)(gate + (size_t)set * 9 * D + col0 + bj * HALF + n * 16) * (u.r ? 0.f : gs);
#pragma unroll
        for (int ai = 0; ai < 2; ++ai)
#pragma unroll
            for (int m = 0; m < 4; ++m) { const size_t off = (size_t)(wr * 64 + fr + ai * HALF + m * 16) * D + col0;
#pragma unroll
                for (int bj = 0; bj < 2; ++bj)
#pragma unroll
                    for (int n = 0; n < 2; ++n) { const f32x4 bs = *(const f32x4*)(bp + off + bj * HALF + n * 16); *(f32x4*)(op + off + bj * HALF + n * 16) = bs + gv[bj][n] * acc[ai][bj][m][n]; }
                if (m & 1) asm volatile("" ::: "memory"); }
    }
};
struct EpiDnIn {
    static constexpr bool PERM = true;
    bf16_t* QKVP; bf16_t* Z; float* AB; bf16_t* HALO;
    __device__ __forceinline__ void operator()(const f32x4 (&acc)[2][2][4][2], const Unit& u, int wr, int wc, int fr, int fq) const {
#pragma unroll
        for (int ai = 0; ai < 2; ++ai)
#pragma unroll
            for (int m = 0; m < 4; ++m) {
                const int r = u.pm * BM + ai * HALF + wr * 64 + m * 16 + fr; int sr = r;
                if (r < ML) { const int s = r & (SEQ - 1); sr = (r & ~(SEQ - 1)) + ((s & 63) << 6) + (s >> 6); }
                if (u.pn < 16) {
                    bf16_t* rowp = (u.pn < 12) ? QKVP + (size_t)sr * 3072 + u.pn * BM : Z + (size_t)sr * D + (u.pn - 12) * BM;
                    rowp += wc * 32 + 8 * fq;
#pragma unroll
                    for (int bj = 0; bj < 2; ++bj) { const f32x4 v0 = acc[ai][bj][m][0], v1 = acc[ai][bj][m][1];
                        u32x4 w; w.x = cvt_pk_bf16(v0[0], v0[1]); w.y = cvt_pk_bf16(v0[2], v0[3]); w.z = cvt_pk_bf16(v1[0], v1[1]); w.w = cvt_pk_bf16(v1[2], v1[3]);
                        *(u32x4*)(rowp + bj * HALF) = w;
                        if (u.pn < 12) { const int p63 = sr & 63; if (p63 == 0 || p63 >= 62) *(u32x4*)(HALO + ((size_t)(sr >> 6) * 3 + (p63 == 0 ? 0 : p63 - 61)) * 3072 + u.pn * BM + wc * 32 + 8 * fq + bj * HALF) = w; } }
                } else if (wc == 0) {
                    float* rowp = AB + (size_t)sr * 32 + 8 * fq;
                    *(f32x4*)(rowp) = acc[ai][0][m][0]; *(f32x4*)(rowp + 4) = acc[ai][0][m][1];
                }
            }
    }
};
template <int PASS> struct EpiGates {
    static constexpr bool PERM = false;
    const bf16_t* U; const bf16_t* Y; bf16_t* RO; const float* bgate; const float* lam; float* agga; float* aggb; const float* carry;
    __device__ __forceinline__ void operator()(const f32x4 (&acc)[2][2][4][2], const Unit& u, int wr, int wc, int fr, int fq) const {
        const int ch0 = (u.pn >> 2) * 256 + (u.pn & 3) * 64 + wc * 16 + fq * 4;
#pragma unroll
        for (int ai = 0; ai < 2; ++ai) {
            const int q = u.pm * 4 + ai * 2 + wr;
            f32x4 hsum[4];
#pragma unroll
            for (int dir = 0; dir < 2; ++dir) {
                const f32x4 br = *(const f32x4*)(bgate + (dir * 2 + 0) * D + ch0), bi = *(const f32x4*)(bgate + (dir * 2 + 1) * D + ch0);
                const f32x4 sp8 = *(const f32x4*)(lam + dir * D + ch0);
                const size_t qo = ((size_t)dir * NQ + q) * D + ch0;
                f32x4 hin, Ac = {1.f, 1.f, 1.f, 1.f};
                if (PASS == 0) hin = (f32x4){0.f, 0.f, 0.f, 0.f}; else hin = *(const f32x4*)(carry + qo);
#pragma unroll
                for (int mm = 0; mm < 4; ++mm) {
                    const int m = dir == 0 ? mm : 3 - mm;
                    const u32x2 w = *(const u32x2*)(U + (size_t)(q * 64 + m * 16 + fr) * D + ch0);
                    const f32x4 uv = {bflo(w.x), bfhi(w.x), bflo(w.y), bfhi(w.y)};
                    const f32x4 pr = acc[ai][dir][m][0] + br, pi = acc[ai][dir][m][1] + bi;
                    f32x4 a, b;
#pragma unroll
                    for (int i = 0; i < 4; ++i) { const float rg = fsigmoid_(pr[i]), ig = fsigmoid_(pi[i]); const float la = -sp8[i] * rg;
                        a[i] = fexp_(la); b[i] = __builtin_amdgcn_sqrtf(fmaxf(1.0f - a[i] * a[i], 0.f)) * ig * uv[i]; }
#pragma unroll
                    for (int d = 1; d < 16; d <<= 1) {
                        f32x4 ap, bp; bool ok;
                        if (dir == 0) { ok = fr >= d;
#pragma unroll
                            for (int i = 0; i < 4; ++i) { ap[i] = __shfl_up(a[i], d, 16); bp[i] = __shfl_up(b[i], d, 16); } }
                        else { ok = fr + d < 16;
#pragma unroll
                            for (int i = 0; i < 4; ++i) { ap[i] = __shfl_down(a[i], d, 16); bp[i] = __shfl_down(b[i], d, 16); } }
                        if (ok) { b = a * bp + b; a = a * ap; }
                    }
                    f32x4 at, bt;
#pragma unroll
                    for (int i = 0; i < 4; ++i) { at[i] = __shfl(a[i], dir == 0 ? 15 : 0, 16); bt[i] = __shfl(b[i], dir == 0 ? 15 : 0, 16); }
                    if (PASS == 1) { const f32x4 h = a * hin + b; if (dir == 0) hsum[m] = h; else hsum[m] = hsum[m] + h; }
                    hin = at * hin + bt; Ac = Ac * at;
                    asm volatile("" ::: "memory");
                }
                if (PASS == 0) { if (fr == 0) { *(f32x4*)(agga + qo) = Ac; *(f32x4*)(aggb + qo) = hin; } }
            }
            if (PASS == 1) {
#pragma unroll
                for (int m = 0; m < 4; ++m) { const size_t off = (size_t)(q * 64 + m * 16 + fr) * D + ch0; const u32x2 w = *(const u32x2*)(Y + off);
                    const float y0 = bflo(w.x), y1 = bfhi(w.x), y2 = bflo(w.y), y3 = bfhi(w.y);
                    u32x2 o; o.x = cvt_pk_bf16(fgelu_tanh(y0) * hsum[m][0], fgelu_tanh(y1) * hsum[m][1]); o.y = cvt_pk_bf16(fgelu_tanh(y2) * hsum[m][2], fgelu_tanh(y3) * hsum[m][3]);
                    *(u32x2*)(RO + off) = o; }
            }
        }
    }
};
}

#define XB_TMO      128
#define XB_XCNT(j)  (256  + 64 * (j))
#define XB_XSUB(j)  (1280 + 64 * (j))
#define XB_XGEN(j)  (2304 + 64 * (j))
#define XB_TOP      3328
#define XB_TOPGEN   3392
#define XCD_BAR_WORDS 3456
#define XB_SPIN_CAP (1u << 18)
__device__ __forceinline__ unsigned xb_ld(unsigned* p)              { return __hip_atomic_load(p, __ATOMIC_RELAXED, __HIP_MEMORY_SCOPE_AGENT); }
__device__ __forceinline__ unsigned xb_add(unsigned* p, unsigned v) { return __hip_atomic_fetch_add(p, v, __ATOMIC_RELAXED, __HIP_MEMORY_SCOPE_AGENT); }
__device__ __forceinline__ unsigned xb_xcc_id() { return (unsigned)__builtin_amdgcn_s_getreg((3 << 11) | 20) & 0xFu; }
#define XB_SPIN(cond, bar) do { unsigned _sp = 0; while (cond) { __builtin_amdgcn_s_sleep(1); \
    if ((++_sp & 255u) == 0u) { if (xb_ld(&(bar)[XB_TMO])) break; if (_sp > XB_SPIN_CAP) { atomicAdd(&(bar)[XB_TMO], 1u); break; } } } } while (0)
struct XcdBarrier { unsigned* bar; unsigned x; volatile LAS unsigned* st; };
__device__ __forceinline__ XcdBarrier xcd_barrier_post(unsigned* bar, volatile LAS unsigned* st) {
    XcdBarrier b; b.bar = bar; b.x = xb_xcc_id(); b.st = st;
    if (threadIdx.x == 0) (void)xb_add(&bar[XB_XCNT(b.x)], 1u);
    return b;
}
__device__ __forceinline__ void xcd_barrier_complete(unsigned* bar, unsigned x, unsigned& nloc, unsigned& nx) {
    const unsigned G = gridDim.x * gridDim.y * gridDim.z;
    unsigned sum, cnt, mine, sp = 0u;
    for (;;) {
        sum = 0u; cnt = 0u; mine = 0u;
#pragma unroll
        for (unsigned j = 0; j < 16; ++j) { const unsigned c = xb_ld(&bar[XB_XCNT(j)]); sum += c; cnt += (c > 0u) ? 1u : 0u; mine = (j == x) ? c : mine; }
        if (sum == G) break;
        __builtin_amdgcn_s_sleep(1);
        if ((++sp & 255u) == 0u) { if (xb_ld(&bar[XB_TMO])) break; if (sp > XB_SPIN_CAP) { atomicAdd(&bar[XB_TMO], 1u); break; } }
    }
    nloc = mine > 0u ? mine : 1u; nx = cnt > 0u ? cnt : 1u;
}
__device__ __forceinline__ void xcd_barrier(const XcdBarrier& b) {
    asm volatile("s_waitcnt vmcnt(0)" ::: "memory");
    __syncthreads();
    if (threadIdx.x == 0) {
        unsigned* bar = b.bar;
        __builtin_amdgcn_s_waitcnt(0);
        unsigned nloc = b.st[0], nx = b.st[1];
        if (nloc == 0u) { xcd_barrier_complete(bar, b.x, nloc, nx); b.st[0] = nloc; b.st[1] = nx; }
        const unsigned old = xb_add(&bar[XB_XSUB(b.x)], 1u);
        const unsigned gen = old / nloc;
        if (old + 1u == (gen + 1u) * nloc) {
            __builtin_amdgcn_fence(__ATOMIC_RELEASE, "agent");
            asm volatile("s_waitcnt vmcnt(0)" ::: "memory");
            const unsigned og = xb_add(&bar[XB_TOP], 1u);
            const unsigned tg = og / nx;
            if (og + 1u == (tg + 1u) * nx) xb_add(&bar[XB_TOPGEN], 1u);
            else XB_SPIN(xb_ld(&bar[XB_TOPGEN]) == tg, bar);
            __builtin_amdgcn_fence(__ATOMIC_ACQUIRE, "agent");
            xb_add(&bar[XB_XGEN(b.x)], 1u);
            asm volatile("s_waitcnt vmcnt(0)" ::: "memory");
        } else {
            XB_SPIN(xb_ld(&bar[XB_XGEN(b.x)]) == gen, bar);
            __builtin_amdgcn_fence(__ATOMIC_ACQUIRE, "agent");
            asm volatile("s_waitcnt vmcnt(0)" ::: "memory");
        }
    }
    __syncthreads();
}

struct Args { const float* in[23]; float* out; unsigned char* ws; int ph_lo, ph_hi; };
struct Frame { LAS unsigned char* lds; int tid, lane, wave, vcu, G; };

struct MapId { __device__ __forceinline__ int operator()(int s) const { return s; } };
struct MapW1 { __device__ __forceinline__ int operator()(int s) const { const int n = s >= DFF ? 1 : 0, hid = s - n * DFF, rem = hid & 127; return (hid >> 7) * 256 + (rem >> 6) * 128 + ((rem >> 4) & 3) * 32 + n * 16 + (rem & 15); } };
struct MapWG { int dir, gate; __device__ __forceinline__ int operator()(int ch) const { return (ch >> 6) * 256 + dir * 128 + ((ch >> 4) & 3) * 32 + gate * 16 + (ch & 15); } };
template <class RowMap>
__device__ __forceinline__ void transpose_item(const float* src, int ld, int item, int nblk, bf16_t* dst, int Kd, LAS float* scr, int lane, const RowMap rm) {
    const int kb = item / nblk, nb = item % nblk, k0 = 64 * kb, n0 = 32 * nb;
#pragma unroll 8
    for (int i = 0; i < 32; ++i) { const int kk = 2 * i + (lane >> 5); scr[kk * 33 + (lane & 31)] = src[(size_t)(k0 + kk) * ld + n0 + (lane & 31)]; }
    LDS_WAIT(); asm volatile("" ::: "memory");
    const int c = lane & 7;
#pragma unroll
    for (int j = 0; j < 4; ++j) { const int n = (lane >> 3) + 8 * j; const LAS float* s = scr + (8 * c) * 33 + n;
        u32x4 o; o.x = pk2(s[0 * 33], s[1 * 33]); o.y = pk2(s[2 * 33], s[3 * 33]); o.z = pk2(s[4 * 33], s[5 * 33]); o.w = pk2(s[6 * 33], s[7 * 33]);
        *(u32x4*)(dst + (size_t)rm(n0 + n) * Kd + k0 + 8 * c) = o; }
    LDS_WAIT(); asm volatile("" ::: "memory");
}

__device__ __forceinline__ void p_prologue(const Frame& F, const Args& a) {
    unsigned char* ws = a.ws;
    LAS float* scr = (LAS float*)(F.lds + F.wave * 16384);
    const int gw = F.vcu * NWAVES + F.wave, NGW = F.G * NWAVES;
    constexpr int I_W1 = (D / 64) * (2 * DFF / 32), I_W2 = (DFF / 64) * (D / 32), I_LIN = (D / 64) * (2048 / 32), I_LG = (256 / 64) * (256 / 32), I_SQ = (D / 64) * (D / 32), I_DIN = (D / 64) * (DNP / 32);
    constexpr int NITEMS = 4 * I_W1 + 4 * I_W2 + I_LIN + 16 * I_LG + I_SQ + I_DIN + I_SQ;
    for (int it = gw; it < NITEMS; it += NGW) {
        int r = it;
        if (r < 4 * I_W1) { const int w = r / I_W1; transpose_item(a.in[7] + (size_t)w * D * 2 * DFF, 2 * DFF, r % I_W1, 2 * DFF / 32, (bf16_t*)(ws + WS_W1 + ((w + 1) & 3) * W1_SZ), D, scr, F.lane, MapW1()); continue; } r -= 4 * I_W1;
        if (r < 4 * I_W2) { const int w = r / I_W2; transpose_item(a.in[8] + (size_t)w * DFF * D, D, r % I_W2, D / 32, (bf16_t*)(ws + WS_W2 + w * W2_SZ), DFF, scr, F.lane, MapId()); continue; } r -= 4 * I_W2;
        if (r < I_LIN) { transpose_item(a.in[9], 2048, r, 2048 / 32, (bf16_t*)(ws + WS_WLIN), D, scr, F.lane, MapId()); continue; } r -= I_LIN;
        if (r < 16 * I_LG) { const int j = r / I_LG, dir = j >> 3, gate = (j >> 2) & 1, head = j & 3;
            transpose_item(a.in[12] + (size_t)j * 256 * 256, 256, r % I_LG, 256 / 32, (bf16_t*)(ws + WS_WLG) + (size_t)head * 1024 * 256, 256, scr, F.lane, MapWG{dir, gate}); continue; } r -= 16 * I_LG;
        if (r < I_SQ) { transpose_item(a.in[15], D, r, D / 32, (bf16_t*)(ws + WS_WLO), D, scr, F.lane, MapId()); continue; } r -= I_SQ;
        if (r < I_DIN) { transpose_item(a.in[16], DNP, r, DNP / 32, (bf16_t*)(ws + WS_WDIN), D, scr, F.lane, MapId()); continue; } r -= I_DIN;
        transpose_item(a.in[21], D, r, D / 32, (bf16_t*)(ws + WS_WDO), D, scr, F.lane, MapId());
    }
    const size_t gt = (size_t)F.vcu * (NWAVES * 64) + F.tid, GT = (size_t)F.G * NWAVES * 64;
    { u32x4* p = (u32x4*)(ws + WS_WDIN + (size_t)DNP * D * 2); const size_t n = (size_t)(DNPP - DNP) * D * 2 / 16; for (size_t i = gt; i < n; i += GT) p[i] = (u32x4){0u, 0u, 0u, 0u}; }
    if (gt < 2 * D) ((float*)(ws + WS_SP8))[gt] = 8.0f * softplusf_(-a.in[14][gt]);
    float* MOD = (float*)(ws + WS_MOD);
    for (int it = F.vcu; it < 2 * 18 * 32; it += F.G) {
        const int l = it / (18 * 32), rem = it % (18 * 32), cb = rem >> 5, kc = rem & 31, col = cb * 512 + F.tid;
        const float* w = a.in[4] + (size_t)l * D * 9 * D + (size_t)(kc * 32) * 9 * D + col;
        float s[5] = {0.f, 0.f, 0.f, 0.f, 0.f};
#pragma unroll 4
        for (int k = 0; k < 32; ++k) { const float wv = w[(size_t)k * 9 * D]; const int kk = kc * 32 + k;
#pragma unroll
            for (int st = 0; st < 5; ++st) { const float cv = st < 4 ? a.in[1][st * D + kk] : a.in[3][kk]; s[st] += siluf_(cv) * wv; } }
        const float bias = kc == 0 ? a.in[5][l * 9 * D + col] : 0.f;
#pragma unroll
        for (int st = 0; st < 5; ++st) atomicAdd(MOD + (size_t)l * MODL + st * 9 * D + col, s[st] + bias);
    }
}

__device__ __forceinline__ void p_norm(const Frame& F, const float* xl, const float* xc, int nrows, const float* g, const float* mod, bf16_t* XN) {
    const int gw = F.vcu * NWAVES + F.wave, NGW = F.G * NWAVES;
    for (int r = gw; r < nrows; r += NGW) {
        const float* src = r < ML ? xl + (size_t)r * D : xc + (size_t)(r - ML) * D; const int set = r < ML ? (r >> 12) : 4;
        const f32x4* x4 = (const f32x4*)src + F.lane; const f32x4* g4 = (const f32x4*)g + F.lane;
        const f32x4* sh4 = (const f32x4*)(mod + (size_t)set * 9 * D) + F.lane; const f32x4* sc4 = (const f32x4*)(mod + (size_t)set * 9 * D + D) + F.lane;
        f32x4 v[4]; float ss = 0.f;
#pragma unroll
        for (int j = 0; j < 4; ++j) { v[j] = x4[64 * j]; ss += (v[j].x * v[j].x + v[j].y * v[j].y) + (v[j].z * v[j].z + v[j].w * v[j].w); }
        const float rstd = 1.0f / sqrtf(wave_sum(ss) * (1.0f / D) + EPS);
        u32x2* o8 = (u32x2*)(XN + (size_t)r * D) + F.lane;
#pragma unroll
        for (int j = 0; j < 4; ++j) { const f32x4 y = v[j] * rstd * g4[64 * j] * (sc4[64 * j] + 1.0f) + sh4[64 * j]; u32x2 w; w.x = pk2(y.x, y.y); w.y = pk2(y.z, y.w); o8[64 * j] = w; }
    }
}
__device__ __forceinline__ void p_final(const Frame& F, float* x, const float* g) {
    const int gw = F.vcu * NWAVES + F.wave, NGW = F.G * NWAVES;
    for (int r = gw; r < ML; r += NGW) {
        f32x4* x4 = (f32x4*)(x + (size_t)r * D) + F.lane; const f32x4* g4 = (const f32x4*)g + F.lane;
        f32x4 v[4]; float ss = 0.f;
#pragma unroll
        for (int j = 0; j < 4; ++j) { v[j] = x4[64 * j]; ss += (v[j].x * v[j].x + v[j].y * v[j].y) + (v[j].z * v[j].z + v[j].w * v[j].w); }
        const float rstd = 1.0f / sqrtf(wave_sum(ss) * (1.0f / D) + EPS);
#pragma unroll
        for (int j = 0; j < 4; ++j) x4[64 * j] = v[j] * rstd * g4[64 * j];
    }
}
__device__ __forceinline__ void p_lru_conv(const Frame& F, const bf16_t* UP, const float* cw, const float* cb, bf16_t* U) {
    const size_t gt = (size_t)F.vcu * (NWAVES * 64) + F.tid, GT = (size_t)F.G * NWAVES * 64;
    for (size_t idx = gt; idx < (size_t)MT * 128; idx += GT) {
        const int r = (int)(idx >> 7), c8 = (int)(idx & 127) * 8;
        int pos, len; if (r < ML) { pos = r & (SEQ - 1); len = SEQ; } else { pos = (r - ML) & (CTXL - 1); len = CTXL; }
        float o[8];
#pragma unroll
        for (int i = 0; i < 8; ++i) o[i] = cb[c8 + i];
#pragma unroll
        for (int j = 0; j < 4; ++j) { const int p = pos + j - 2; if (p < 0 || p >= len) continue;
            const u32x4 w = *(const u32x4*)(UP + (size_t)(r + j - 2) * D + c8); const float* cwj = cw + j * D + c8;
            o[0] += bflo(w.x) * cwj[0]; o[1] += bfhi(w.x) * cwj[1]; o[2] += bflo(w.y) * cwj[2]; o[3] += bfhi(w.y) * cwj[3];
            o[4] += bflo(w.z) * cwj[4]; o[5] += bfhi(w.z) * cwj[5]; o[6] += bflo(w.w) * cwj[6]; o[7] += bfhi(w.w) * cwj[7]; }
        u32x4 ov; ov.x = pk2(o[0], o[1]); ov.y = pk2(o[2], o[3]); ov.z = pk2(o[4], o[5]); ov.w = pk2(o[6], o[7]);
        *(u32x4*)(U + (size_t)r * D + c8) = ov;
    }
}
__device__ __forceinline__ void p_lru_carry(const Frame& F, const float* agga, const float* aggb, float* carry) {
    const int idx = F.vcu * (NWAVES * 64) + F.tid;
    if (idx >= NB * 2 * D) return;
    const int ch = idx & (D - 1), dir = (idx >> 10) & 1, b = idx >> 11;
    float st = 0.f;
    for (int n = 0; n < 68; ++n) {
        int q; if (n < 4) q = 256 + 4 * b + (dir == 0 ? n : 3 - n); else q = 64 * b + (dir == 0 ? n - 4 : 63 - (n - 4));
        const size_t o = ((size_t)dir * NQ + q) * D + ch;
        carry[o] = st; st = agga[o] * st + aggb[o];
    }
}
typedef float f32x16 __attribute__((ext_vector_type(16)));
__device__ __forceinline__ int kperm(int s, int hh, int j) { return 16 * s + 8 * (j >> 2) + 4 * hh + (j & 3); }
__device__ __forceinline__ int crow(int reg, int hh) { return (reg & 3) + 8 * (reg >> 2) + 4 * hh; }
__device__ __forceinline__ size_t dn_frag_off(int q, int h, int seg, int f, int l) {
    return ((size_t)(64 * q + 4 * f + (l >> 4)) * 3072 + seg * 1024 + h * 128) * 2 + (size_t)(l & 15) * 16;
}
__device__ __forceinline__ bf16x8 pack8(const f32x16& v, int s) {
    u32x4 w; w.x = pg8::cvt_pk_bf16(v[8 * s + 0], v[8 * s + 1]); w.y = pg8::cvt_pk_bf16(v[8 * s + 2], v[8 * s + 3]); w.z = pg8::cvt_pk_bf16(v[8 * s + 4], v[8 * s + 5]); w.w = pg8::cvt_pk_bf16(v[8 * s + 6], v[8 * s + 7]);
    return __builtin_bit_cast(bf16x8, w);
}
#define MFMA32(a, b, c) __builtin_amdgcn_mfma_f32_32x32x16_bf16((a), (b), (c), 0, 0, 0)

constexpr int PL_KS = 0, PL_QS = 17408, PL_VS = 34816, PL_AP = 0, PL_KK = 52224, PL_QK = 68864, PL_TS = 85504, PL_GC = 103936, PL_BETA = 104448, PL_G = 104960;
__device__ __forceinline__ void p_dn_prep(const Frame& F, unsigned char* ws, const float* cw, const float* a_log, const float* dt_bias) {
    bf16_t* QKV = (bf16_t*)(ws + WS_QKV); const bf16_t* HALO = (const bf16_t*)(ws + WS_HALO); const float* AB = (const float*)(ws + WS_AB);
    const int tid = F.tid, lane = F.lane, wave = F.wave;
    { const size_t gt = (size_t)F.vcu * (NWAVES * 64) + tid, GT = (size_t)F.G * NWAVES * 64; u32x4* p = (u32x4*)(ws + WS_O); const size_t n = (size_t)ML * D * 4 / 16; for (size_t i = gt; i < n; i += GT) p[i] = (u32x4){0u, 0u, 0u, 0u}; }
    LAS bf16_t* Ks = (LAS bf16_t*)(F.lds + PL_KS); LAS bf16_t* Qs = (LAS bf16_t*)(F.lds + PL_QS); LAS bf16_t* Vs = (LAS bf16_t*)(F.lds + PL_VS);
    LAS float* Ap = (LAS float*)(F.lds + PL_AP); LAS float* KKs = (LAS float*)(F.lds + PL_KK); LAS float* QKs = (LAS float*)(F.lds + PL_QK);
    LAS bf16_t* Ts = (LAS bf16_t*)(F.lds + PL_TS); LAS float* gcb = (LAS float*)(F.lds + PL_GC); LAS float* betab = (LAS float*)(F.lds + PL_BETA); LAS float* Gs = (LAS float*)(F.lds + PL_G);
    for (int it = F.vcu; it < NQ * 8; it += F.G) {
        const int q = it >> 3, h = it & 7;
        int cpos, nch; if (q < 256) { cpos = q & 63; nch = 64; } else { cpos = (q - 256) & 3; nch = 4; }
#ifndef PREP_SKIP
#define PREP_SKIP 0
#endif
        if (!(PREP_SKIP & 1)) {
            const int tok = tid >> 3, c0 = (tid & 7) * 16;
#pragma unroll
            for (int seg = 0; seg < 3; ++seg) {
                float x[16];
#pragma unroll
                for (int i = 0; i < 16; ++i) x[i] = 0.f;
#pragma unroll
                for (int j = 0; j < 4; ++j) {
                    const int tt = tok + j - 2; const bf16_t* rp = nullptr;
                    if (tt >= 0 && tt < 64) rp = QKV + (size_t)(64 * q + tt) * 3072;
                    else if (tt < 0) { if (cpos > 0) rp = HALO + ((size_t)(q - 1) * 3 + (tt + 3)) * 3072; }
                    else { if (cpos + 1 < nch) rp = HALO + ((size_t)(q + 1) * 3 + 0) * 3072; }
                    if (rp) { const u32x4 w0 = *(const u32x4*)(rp + seg * 1024 + h * 128 + c0), w1 = *(const u32x4*)(rp + seg * 1024 + h * 128 + c0 + 8);
                        const float* cwj = cw + j * 3072 + seg * 1024 + h * 128 + c0;
                        x[0] += bflo(w0.x) * cwj[0]; x[1] += bfhi(w0.x) * cwj[1]; x[2] += bflo(w0.y) * cwj[2]; x[3] += bfhi(w0.y) * cwj[3];
                        x[4] += bflo(w0.z) * cwj[4]; x[5] += bfhi(w0.z) * cwj[5]; x[6] += bflo(w0.w) * cwj[6]; x[7] += bfhi(w0.w) * cwj[7];
                        x[8] += bflo(w1.x) * cwj[8]; x[9] += bfhi(w1.x) * cwj[9]; x[10] += bflo(w1.y) * cwj[10]; x[11] += bfhi(w1.y) * cwj[11];
                        x[12] += bflo(w1.z) * cwj[12]; x[13] += bfhi(w1.z) * cwj[13]; x[14] += bflo(w1.w) * cwj[14]; x[15] += bfhi(w1.w) * cwj[15]; }
                }
                float ss = 0.f;
#pragma unroll
                for (int i = 0; i < 16; ++i) { x[i] = siluf_(x[i]); ss += x[i] * x[i]; }
                float sc = 1.0f;
                if (seg < 2) { ss += __shfl_xor(ss, 1); ss += __shfl_xor(ss, 2); ss += __shfl_xor(ss, 4); sc = (seg == 0 ? 0.08838834764831845f : 1.0f) / sqrtf(ss + EPS); }
                u32x4 o0, o1;
                o0.x = pk2(x[0] * sc, x[1] * sc); o0.y = pk2(x[2] * sc, x[3] * sc); o0.z = pk2(x[4] * sc, x[5] * sc); o0.w = pk2(x[6] * sc, x[7] * sc);
                o1.x = pk2(x[8] * sc, x[9] * sc); o1.y = pk2(x[10] * sc, x[11] * sc); o1.z = pk2(x[12] * sc, x[13] * sc); o1.w = pk2(x[14] * sc, x[15] * sc);
                LAS bf16_t* dst = (seg == 0 ? Qs : (seg == 1 ? Ks : Vs)) + tok * 136 + c0;
                *(LAS u32x4*)dst = o0; *(LAS u32x4*)(dst + 8) = o1;
            }
            if (tid < 128) {
                const int dir = tid >> 6, n = tid & 63; const float* abr = AB + (size_t)(64 * q + n) * 32;
                const float g = -expf(a_log[dir * 8 + h]) * softplusf_(abr[dir * 8 + h] + dt_bias[dir * 8 + h]);
                const float bet = sigmoidf_(abr[16 + dir * 8 + h]);
                float c = g;
#pragma unroll
                for (int d = 1; d < 64; d <<= 1) { const float o = dir == 0 ? __shfl_up(c, d, 64) : __shfl_down(c, d, 64); if (dir == 0 ? (n >= d) : (n + d < 64)) c += o; }
                gcb[dir * 64 + n] = c; betab[dir * 64 + n] = bet;
                if (n == (dir == 0 ? 63 : 0)) Gs[dir] = c;
            }
        }
        __syncthreads();
        if (!(PREP_SKIP & 2)) {
            const int r = lane & 31, hh = lane >> 5, mi = (wave >> 1) & 1, mj = wave & 1;
            const LAS bf16_t* Xa = (wave < 4 ? Ks : Qs) + (32 * mi + r) * 136 + 8 * hh; const LAS bf16_t* Xb = Ks + (32 * mj + r) * 136 + 8 * hh;
            f32x16 acc;
#pragma unroll
            for (int i = 0; i < 16; ++i) acc[i] = 0.f;
#pragma unroll
            for (int ks = 0; ks < 8; ++ks) { const bf16x8 a = *(const LAS bf16x8*)(Xa + 16 * ks), b = *(const LAS bf16x8*)(Xb + 16 * ks); acc = MFMA32(a, b, acc); }
            LAS float* dst = (wave < 4 ? KKs : QKs) + 32 * mj + r;
#pragma unroll
            for (int reg = 0; reg < 16; ++reg) dst[(32 * mi + crow(reg, hh)) * 65] = acc[reg];
#pragma unroll 1
            for (int e = 0; e < 6; ++e) {
                const int idx = tid + 512 * e, f = idx >> 6, l = idx & 63, fr_ = l & 31, fh = l >> 5; u32x4 w; int seg, ff;
                if (f < 32) { ff = f & 15; seg = f < 16 ? 1 : 0; const int mt = ff >> 3, t = (ff >> 1) & 3, s2 = ff & 1;
                    const LAS bf16_t* src = (f < 16 ? Ks : Qs) + (32 * mt + fr_) * 136 + 32 * t + 16 * s2 + 4 * fh;
                    const u32x2 lo = *(const LAS u32x2*)src, hi = *(const LAS u32x2*)(src + 8); w.x = lo.x; w.y = lo.y; w.z = hi.x; w.w = hi.y; }
                else { ff = f - 32; seg = 2; const int t = ff >> 2, mt = (ff >> 1) & 1, s2 = ff & 1; unsigned short v8[8];
#pragma unroll
                    for (int j = 0; j < 8; ++j) v8[j] = Ks[(32 * mt + kperm(s2, fh, j)) * 136 + 32 * t + fr_];
                    w.x = v8[0] | ((unsigned)v8[1] << 16); w.y = v8[2] | ((unsigned)v8[3] << 16); w.z = v8[4] | ((unsigned)v8[5] << 16); w.w = v8[6] | ((unsigned)v8[7] << 16); }
                *(u32x4*)((unsigned char*)QKV + dn_frag_off(q, h, seg, ff, l)) = w;
            }
            { const int blk = wave, dvq = blk >> 1, mt = blk & 1, c = lane & 31; unsigned short v16[16];
#pragma unroll
                for (int reg = 0; reg < 16; ++reg) v16[reg] = Vs[(32 * mt + crow(reg, hh)) * 136 + 32 * dvq + c];
                u32x4 w0, w1; w0.x = v16[0] | ((unsigned)v16[1] << 16); w0.y = v16[2] | ((unsigned)v16[3] << 16); w0.z = v16[4] | ((unsigned)v16[5] << 16); w0.w = v16[6] | ((unsigned)v16[7] << 16);
                w1.x = v16[8] | ((unsigned)v16[9] << 16); w1.y = v16[10] | ((unsigned)v16[11] << 16); w1.z = v16[12] | ((unsigned)v16[13] << 16); w1.w = v16[14] | ((unsigned)v16[15] << 16);
                u32x4* vp = (u32x4*)(ws + WS_VC + ((size_t)(it * 4 + dvq) * 2 + mt) * 2048 + lane * 32); vp[0] = w0; vp[1] = w1; }
        }
        __syncthreads();
        if (!(PREP_SKIP & 4)) {
#pragma unroll 2
            for (int e = 0; e < 16; ++e) { const int idx = tid + 512 * e, dir = idx >> 12, ip = (idx >> 6) & 63, jp = idx & 63, n = dir ? 63 - ip : ip, m = dir ? 63 - jp : jp;
                Ap[idx] = jp < ip ? betab[dir * 64 + n] * KKs[n * 65 + m] * fexp_(gcb[dir * 64 + n] - gcb[dir * 64 + m]) : 0.f; }
#pragma unroll 1
            for (int e = 0; e < 2; ++e) { const int idx = tid + 512 * e; if (idx < 768) { const int dir = idx / 384, rem = idx % 384, fb = rem >> 6, l = rem & 63, blk = fb >> 1, s2 = fb & 1, fr_ = l & 31, fh = l >> 5;
                const int mi = blk == 0 ? 0 : (blk == 1 ? 1 : (dir == 0 ? 1 : 0)), mj = blk == 0 ? 0 : (blk == 1 ? 1 : (dir == 0 ? 0 : 1));
                const int n = 32 * mi + fr_; float pv[8];
#pragma unroll
                for (int j = 0; j < 8; ++j) { const int m = 32 * mj + kperm(s2, fh, j); const bool ok = dir == 0 ? (m <= n) : (m >= n);
                    pv[j] = ok ? QKs[n * 65 + m] * fexp_(gcb[dir * 64 + n] - gcb[dir * 64 + m]) : 0.f; }
                u32x4 w; w.x = pk2(pv[0], pv[1]); w.y = pk2(pv[2], pv[3]); w.z = pk2(pv[4], pv[5]); w.w = pk2(pv[6], pv[7]);
                *(u32x4*)(ws + WS_P + ((size_t)(it * 2 + dir) * 6 + fb) * 1024 + l * 16) = w; } }
            if (tid < 128) { const int dir = tid >> 6, n = tid & 63; float* rec = (float*)(ws + WS_GC + (size_t)(it * 2 + dir) * 1024);
                rec[n] = gcb[dir * 64 + n]; rec[64 + n] = betab[dir * 64 + n]; if (n == 0) rec[128] = Gs[dir]; }
        }
        __syncthreads();
        if (!(PREP_SKIP & 8) && wave < 2) {
            const LAS float* Arow = Ap + wave * 4096; float Tc[64];
#pragma unroll
            for (int i = 0; i < 64; ++i) {
                float acc = (i == lane) ? 1.f : 0.f;
#pragma unroll
                for (int j4 = 0; j4 < (i + 3) / 4; ++j4) { const f32x4 a = *(const LAS f32x4*)(Arow + i * 64 + 4 * j4);
#pragma unroll
                    for (int jj = 0; jj < 4; ++jj) if (4 * j4 + jj < i) acc -= a[jj] * Tc[4 * j4 + jj]; }
                Tc[i] = acc;
            }
            const int m = wave ? 63 - lane : lane;
#pragma unroll
            for (int i = 0; i < 64; ++i) { const int n = wave ? 63 - i : i; Ts[(wave * 64 + n) * 72 + m] = (bf16_t)f2bf(Tc[i]); }
        }
        __syncthreads();
        {
#pragma unroll 1
            for (int e = 0; e < 2; ++e) { const int idx = tid + 512 * e; if (idx < 768) { const int dir = idx / 384, rem = idx % 384, fb = rem >> 6, l = rem & 63, blk = fb >> 1, s2 = fb & 1, fr_ = l & 31, fh = l >> 5;
                const int mi = blk == 0 ? 0 : (blk == 1 ? 1 : (dir == 0 ? 1 : 0)), mj = blk == 0 ? 0 : (blk == 1 ? 1 : (dir == 0 ? 0 : 1));
                const LAS bf16_t* src = Ts + (dir * 64 + 32 * mi + fr_) * 72 + 32 * mj + 16 * s2 + 4 * fh;
                const u32x2 lo = *(const LAS u32x2*)src, hi = *(const LAS u32x2*)(src + 8); u32x4 w; w.x = lo.x; w.y = lo.y; w.z = hi.x; w.w = hi.y;
                *(u32x4*)(ws + WS_T + ((size_t)(it * 2 + dir) * 6 + fb) * 1024 + l * 16) = w; } }
        }
        __syncthreads();
    }
}

constexpr int CH_BUF = 62464;
__device__ __forceinline__ void p_dn_chain(const Frame& F, const unsigned char* ws, float* O) {
    const int lane = F.lane, wave = F.wave, hh = lane >> 5;
    for (int item = blockIdx.x; item < 64; item += F.G) {
        const int b = item >> 4, h = (item >> 1) & 7, dir = item & 1, dvq = wave & 3;
        f32x16 S[4];
#pragma unroll
        for (int t = 0; t < 4; ++t)
#pragma unroll
            for (int i = 0; i < 16; ++i) S[t][i] = 0.f;
        u32x4 Vn_[2][2], Vc_[2][2];
#define CH_Q(n) ((n) < 4 ? 256 + 4 * b + (dir ? 3 - (n) : (n)) : 64 * b + (dir ? 63 - ((n) - 4) : (n) - 4))
#define CH_ISSUE(n, bufi) do { const int q_ = CH_Q(n); const size_t it2_ = (size_t)(q_ * 8 + h) * 2 + dir; \
            for (int f = wave; f < 61; f += 8) { const unsigned char* src_; \
                if (f < 48) { const int seg_ = f < 16 ? 1 : (f < 32 ? 0 : 2); src_ = ws + WS_QKV + dn_frag_off(q_, h, seg_, f & 15, lane); } \
                else if (f < 54) src_ = ws + WS_T + (it2_ * 6 + (f - 48)) * 1024 + lane * 16; \
                else if (f < 60) src_ = ws + WS_P + (it2_ * 6 + (f - 54)) * 1024 + lane * 16; \
                else src_ = ws + WS_GC + it2_ * 1024 + lane * 16; \
                __builtin_amdgcn_global_load_lds((const unsigned*)src_, (LAS unsigned*)(F.lds + (bufi) * CH_BUF + f * 1024), 16, 0, 0); } \
            if (wave < 4) { const u32x4* vp_ = (const u32x4*)(ws + WS_VC + ((size_t)((q_ * 8 + h) * 4 + dvq) * 2) * 2048 + lane * 32); \
                Vn_[0][0] = vp_[0]; Vn_[0][1] = vp_[1]; Vn_[1][0] = vp_[128]; Vn_[1][1] = vp_[129]; } } while (0)
        CH_ISSUE(0, 0);
        for (int n = 0; n < 68; ++n) {
            const int buf = n & 1;
            asm volatile("s_waitcnt vmcnt(0)" ::: "memory");
            __syncthreads();
            Vc_[0][0] = Vn_[0][0]; Vc_[0][1] = Vn_[0][1]; Vc_[1][0] = Vn_[1][0]; Vc_[1][1] = Vn_[1][1];
            if (n + 1 < 68) CH_ISSUE(n + 1, buf ^ 1);
            if (wave < 4) {
                const LAS unsigned char* B = F.lds + buf * CH_BUF;
#define CH_FRAG(f) (*(const LAS bf16x8*)(B + (f) * 1024 + lane * 16))
                const LAS float* gcp = (const LAS float*)(B + 60 * 1024); const float G = gcp[128];
                f32x16 KS[2], QS[2];
#pragma unroll
                for (int mt = 0; mt < 2; ++mt)
#pragma unroll
                    for (int i = 0; i < 16; ++i) { KS[mt][i] = 0.f; QS[mt][i] = 0.f; }
                {
                    bf16x8 Sb[4][2];
#pragma unroll
                    for (int t = 0; t < 4; ++t) { Sb[t][0] = pack8(S[t], 0); Sb[t][1] = pack8(S[t], 1); }
#pragma unroll
                    for (int mt = 0; mt < 2; ++mt)
#pragma unroll
                        for (int t = 0; t < 4; ++t)
#pragma unroll
                            for (int s = 0; s < 2; ++s) { KS[mt] = MFMA32(CH_FRAG((mt * 4 + t) * 2 + s), Sb[t][s], KS[mt]); QS[mt] = MFMA32(CH_FRAG(16 + (mt * 4 + t) * 2 + s), Sb[t][s], QS[mt]); }
                }
#pragma unroll
                for (int mt = 0; mt < 2; ++mt)
#pragma unroll
                    for (int g4 = 0; g4 < 4; ++g4) { const f32x4 gv = *(const LAS f32x4*)(gcp + 32 * mt + 8 * g4 + 4 * hh), bv = *(const LAS f32x4*)(gcp + 64 + 32 * mt + 8 * g4 + 4 * hh);
                        const unsigned w0 = Vc_[mt][g4 >> 1][(g4 & 1) * 2], w1 = Vc_[mt][g4 >> 1][(g4 & 1) * 2 + 1]; const float vv[4] = {bflo(w0), bfhi(w0), bflo(w1), bfhi(w1)};
#pragma unroll
                        for (int i = 0; i < 4; ++i) { const float eg = fexp_(gv[i]); KS[mt][4 * g4 + i] = bv[i] * (vv[i] - eg * KS[mt][4 * g4 + i]); QS[mt][4 * g4 + i] *= eg; } }
                f32x16 VN[2];
#pragma unroll
                for (int mt = 0; mt < 2; ++mt)
#pragma unroll
                    for (int i = 0; i < 16; ++i) VN[mt][i] = 0.f;
                {
                    bf16x8 Rb[2][2];
#pragma unroll
                    for (int mt = 0; mt < 2; ++mt) { Rb[mt][0] = pack8(KS[mt], 0); Rb[mt][1] = pack8(KS[mt], 1); }
#pragma unroll
                    for (int s = 0; s < 2; ++s) { VN[0] = MFMA32(CH_FRAG(48 + s), Rb[0][s], VN[0]); VN[1] = MFMA32(CH_FRAG(50 + s), Rb[1][s], VN[1]); }
                    if (dir == 0) {
#pragma unroll
                        for (int s = 0; s < 2; ++s) VN[1] = MFMA32(CH_FRAG(52 + s), Rb[0][s], VN[1]);
                    } else {
#pragma unroll
                        for (int s = 0; s < 2; ++s) VN[0] = MFMA32(CH_FRAG(52 + s), Rb[1][s], VN[0]);
                    }
                }
                {
                    bf16x8 Vb[2][2];
#pragma unroll
                    for (int mt = 0; mt < 2; ++mt) { Vb[mt][0] = pack8(VN[mt], 0); Vb[mt][1] = pack8(VN[mt], 1); }
#pragma unroll
                    for (int s = 0; s < 2; ++s) { QS[0] = MFMA32(CH_FRAG(54 + s), Vb[0][s], QS[0]); QS[1] = MFMA32(CH_FRAG(56 + s), Vb[1][s], QS[1]); }
                    if (dir == 0) {
#pragma unroll
                        for (int s = 0; s < 2; ++s) QS[1] = MFMA32(CH_FRAG(58 + s), Vb[0][s], QS[1]);
                    } else {
#pragma unroll
                        for (int s = 0; s < 2; ++s) QS[0] = MFMA32(CH_FRAG(58 + s), Vb[1][s], QS[0]);
                    }
                }
                if (n >= 4) {
                    const int c = dir ? 63 - (n - 4) : n - 4; float* ob = O + ((size_t)b * SEQ + c) * D + h * 128 + dvq * 32 + (lane & 31);
#pragma unroll
                    for (int mt = 0; mt < 2; ++mt)
#pragma unroll
                        for (int reg = 0; reg < 16; ++reg) atomicAdd(ob + (size_t)(32 * mt + crow(reg, hh)) * 64 * D, QS[mt][reg]);
                }
                {
                    bf16x8 Wb[2][2];
#pragma unroll
                    for (int mt = 0; mt < 2; ++mt) {
#pragma unroll
                        for (int g4 = 0; g4 < 4; ++g4) { const f32x4 gv = *(const LAS f32x4*)(gcp + 32 * mt + 8 * g4 + 4 * hh);
#pragma unroll
                            for (int i = 0; i < 4; ++i) VN[mt][4 * g4 + i] *= fexp_(G - gv[i]); }
                        Wb[mt][0] = pack8(VN[mt], 0); Wb[mt][1] = pack8(VN[mt], 1); }
                    const float eG = fexp_(G);
#pragma unroll
                    for (int t = 0; t < 4; ++t) {
#pragma unroll
                        for (int i = 0; i < 16; ++i) S[t][i] *= eG;
#pragma unroll
                        for (int mt = 0; mt < 2; ++mt)
#pragma unroll
                            for (int s = 0; s < 2; ++s) S[t] = MFMA32(CH_FRAG(32 + (t * 2 + mt) * 2 + s), Wb[mt][s], S[t]);
                    }
                }
#undef CH_FRAG
            }
        }
#undef CH_ISSUE
#undef CH_Q
        asm volatile("s_waitcnt vmcnt(0)" ::: "memory");
        __syncthreads();
    }
}
__device__ __forceinline__ void p_dn_ro(const Frame& F, const float* O, const bf16_t* Z, const float* gn, bf16_t* RO) {
    const int gw = F.vcu * NWAVES + F.wave, NGW = F.G * NWAVES;
    for (int r = gw; r < ML; r += NGW) {
        const int s = r & (SEQ - 1), sr = (r & ~(SEQ - 1)) + ((s & 63) << 6) + (s >> 6);
        const f32x4* o4 = (const f32x4*)(O + (size_t)r * D + F.lane * 16);
        f32x4 v[4]; float ss = 0.f;
#pragma unroll
        for (int j = 0; j < 4; ++j) { v[j] = o4[j]; ss += (v[j].x * v[j].x + v[j].y * v[j].y) + (v[j].z * v[j].z + v[j].w * v[j].w); }
        ss += __shfl_xor(ss, 1); ss += __shfl_xor(ss, 2); ss += __shfl_xor(ss, 4);
        const float rstd = 1.0f / sqrtf(ss * (1.0f / 128.0f) + EPS);
        const u32x4* z4 = (const u32x4*)(Z + (size_t)sr * D + F.lane * 16);
        const f32x4* g4 = (const f32x4*)(gn + (F.lane & 7) * 16);
        u32x4 ov[2];
#pragma unroll
        for (int hh = 0; hh < 2; ++hh) { const u32x4 zw = z4[hh]; const f32x4 a = v[2 * hh] * rstd * g4[2 * hh], c = v[2 * hh + 1] * rstd * g4[2 * hh + 1];
            ov[hh].x = pk2(a.x * siluf_(bflo(zw.x)), a.y * siluf_(bfhi(zw.x))); ov[hh].y = pk2(a.z * siluf_(bflo(zw.y)), a.w * siluf_(bfhi(zw.y)));
            ov[hh].z = pk2(c.x * siluf_(bflo(zw.z)), c.y * siluf_(bfhi(zw.z))); ov[hh].w = pk2(c.z * siluf_(bflo(zw.w)), c.w * siluf_(bfhi(zw.w))); }
        u32x4* op = (u32x4*)(RO + (size_t)r * D + F.lane * 16); op[0] = ov[0]; op[1] = ov[1];
    }
}

constexpr int N_PHASES = 27;
__global__ void __launch_bounds__(NWAVES * 64, 2) trunk_fwd(Args args) {
    extern __shared__ __attribute__((aligned(16))) unsigned char lds_raw[];
    Frame F;
    F.lds = (LAS unsigned char*)lds_raw;
    F.tid = threadIdx.x; F.lane = F.tid & 63; F.wave = __builtin_amdgcn_readfirstlane(F.tid >> 6);
    F.G = gridDim.x; { const int bx = blockIdx.x; F.vcu = (F.G % 8 == 0) ? (bx % 8) * (F.G / 8) + bx / 8 : bx; }
    unsigned char* ws = args.ws;
    unsigned* ctl = (unsigned*)(ws + WS_CTL);
    for (int u = F.tid; u < (LDS_BYTES - LDSCTL_OFF) / 4; u += NWAVES * 64) ((LAS unsigned*)(F.lds + LDSCTL_OFF))[u] = 0u;
    __syncthreads();
    XcdBarrier bar; bar.bar = ctl + CW_BAR; bar.x = 0; bar.st = nullptr;
    if (!MK_PER_PHASE) bar = xcd_barrier_post(ctl + CW_BAR, (volatile LAS unsigned*)(F.lds + MISC_OFF) + 8);
    const int lo = args.ph_lo, hi = args.ph_hi;
#ifndef MK_PHMASK
#define MK_PHMASK 0xffffffffu
#endif
#define IN(k) ((((unsigned)MK_PHMASK >> (k)) & 1u) && lo <= (k) && (k) < hi)
#ifndef MK_REPMASK
#define MK_REPMASK 0u
#endif
#define REP(k) ((((unsigned)MK_REPMASK >> (k)) & 1u) ? 2 : 1)
#define SEAM(k) do { if (IN(k) && IN((k) + 1)) xcd_barrier(bar); } while (0)

    float* MOD = (float*)(ws + WS_MOD);
    float* XL = args.out; float* XC = (float*)(ws + WS_XC);
    bf16_t* XN = (bf16_t*)(ws + WS_XN); bf16_t* HB = (bf16_t*)(ws + WS_H);
    const float* g_sub = args.in[6];
    const int bid = (int)blockIdx.x;

#define PH_FFN1(k, w, MROWS) if (IN(k)) { pg8::Gemm g{XN, (const bf16_t*)(ws + WS_W1 + (((w) + 1) & 3) * W1_SZ), MROWS, 2 * DFF, D, D, 0}; pg8::StaticOrder S; S.init(MROWS, 2 * DFF, F.G, bid, REP(k)); \
        pg8::EpiSwiglu E{HB}; pg8::gemm_phase<pg8::EpiSwiglu, pg8::StaticOrder>(F.lds, g, S, E); } SEAM(k);
#define PH_FFN2(k, w, MROWS, BL, BC, GATE) if (IN(k)) { pg8::Gemm g{HB, (const bf16_t*)(ws + WS_W2 + (w) * W2_SZ), MROWS, D, DFF, DFF, 0}; pg8::StaticOrder S; S.init(MROWS, D, F.G, bid, REP(k)); \
        pg8::EpiResid E{BL, BC, XL, XC, GATE, 0.5f}; pg8::gemm_phase<pg8::EpiResid, pg8::StaticOrder>(F.lds, g, S, E); } SEAM(k);
#define PH_NORM(k, SRCL, SRCC, NROWS, l, sub) if (IN(k)) { for (int rp = 0; rp < REP(k); ++rp) p_norm(F, SRCL, SRCC, NROWS, g_sub + ((l) * 3 + (sub)) * D, MOD + (size_t)(l) * MODL + (sub) * 3 * D, XN); } SEAM(k);

    if (IN(0)) { p_prologue(F, args); } SEAM(0);
    PH_NORM(1, args.in[0], args.in[2], MT, 0, 0)
    PH_FFN1(2, 0, MT)
    PH_FFN2(3, 0, MT, args.in[0], args.in[2], MOD + 0 * MODL + 2 * D)
    PH_NORM(4, XL, XC, MT, 0, 1)
    if (IN(5)) { pg8::Gemm g{XN, (const bf16_t*)(ws + WS_WLIN), MT, 2048, D, D, 0}; pg8::StaticOrder S; S.init(MT, 2048, F.G, bid, REP(5));
        pg8::EpiBf16 E{(bf16_t*)(ws + WS_Y), D, D, (size_t)(WS_UP - WS_Y) / 2}; pg8::gemm_phase<pg8::EpiBf16, pg8::StaticOrder>(F.lds, g, S, E); } SEAM(5);
    if (IN(6)) { p_lru_conv(F, (const bf16_t*)(ws + WS_UP), args.in[10], args.in[11], (bf16_t*)(ws + WS_U)); } SEAM(6);
    if (IN(7)) { pg8::Gemm g{(const bf16_t*)(ws + WS_U), (const bf16_t*)(ws + WS_WLG), MT, 4096, 256, D, 4}; pg8::StaticOrder S; S.init(MT, 4096, F.G, bid, REP(7));
        pg8::EpiGates<0> E{(const bf16_t*)(ws + WS_U), (const bf16_t*)(ws + WS_Y), XN, args.in[13], (const float*)(ws + WS_SP8), (float*)(ws + WS_AGGA), (float*)(ws + WS_AGGB), (const float*)(ws + WS_CARRY)};
        pg8::gemm_phase<pg8::EpiGates<0>, pg8::StaticOrder>(F.lds, g, S, E); } SEAM(7);
    if (IN(8)) { p_lru_carry(F, (const float*)(ws + WS_AGGA), (const float*)(ws + WS_AGGB), (float*)(ws + WS_CARRY)); } SEAM(8);
    if (IN(9)) { pg8::Gemm g{(const bf16_t*)(ws + WS_U), (const bf16_t*)(ws + WS_WLG), MT, 4096, 256, D, 4}; pg8::StaticOrder S; S.init(MT, 4096, F.G, bid, REP(9));
        pg8::EpiGates<1> E{(const bf16_t*)(ws + WS_U), (const bf16_t*)(ws + WS_Y), XN, args.in[13], (const float*)(ws + WS_SP8), (float*)(ws + WS_AGGA), (float*)(ws + WS_AGGB), (const float*)(ws + WS_CARRY)};
        pg8::gemm_phase<pg8::EpiGates<1>, pg8::StaticOrder>(F.lds, g, S, E); } SEAM(9);
    if (IN(10)) { pg8::Gemm g{XN, (const bf16_t*)(ws + WS_WLO), MT, D, D, D, 0}; pg8::StaticOrder S; S.init(MT, D, F.G, bid, REP(10));
        pg8::EpiResid E{XL, XC, XL, XC, MOD + 0 * MODL + 5 * D, 1.0f}; pg8::gemm_phase<pg8::EpiResid, pg8::StaticOrder>(F.lds, g, S, E); } SEAM(10);
    PH_NORM(11, XL, XC, MT, 0, 2)
    PH_FFN1(12, 1, MT)
    PH_FFN2(13, 1, MT, XL, XC, MOD + 0 * MODL + 8 * D)
    PH_NORM(14, XL, XC, MT, 1, 0)
    PH_FFN1(15, 2, MT)
    PH_FFN2(16, 2, MT, XL, XC, MOD + 1 * MODL + 2 * D)
    PH_NORM(17, XL, XC, MT, 1, 1)
    if (IN(18)) { pg8::Gemm g{XN, (const bf16_t*)(ws + WS_WDIN), MT, DNPP, D, D, 0}; pg8::StaticOrder S; S.init(MT, DNPP, F.G, bid, REP(18));
        pg8::EpiDnIn E{(bf16_t*)(ws + WS_QKV), (bf16_t*)(ws + WS_Z), (float*)(ws + WS_AB), (bf16_t*)(ws + WS_HALO)}; pg8::gemm_phase<pg8::EpiDnIn, pg8::StaticOrder>(F.lds, g, S, E); } SEAM(18);
    if (IN(19)) { p_dn_prep(F, ws, args.in[17], args.in[18], args.in[19]); } SEAM(19);
    if (IN(20)) { p_dn_chain(F, ws, (float*)(ws + WS_O)); } SEAM(20);
    if (IN(21)) { p_dn_ro(F, (const float*)(ws + WS_O), (const bf16_t*)(ws + WS_Z), args.in[20], (bf16_t*)(ws + WS_RO2)); } SEAM(21);
    if (IN(22)) { pg8::Gemm g{(const bf16_t*)(ws + WS_RO2), (const bf16_t*)(ws + WS_WDO), ML, D, D, D, 0}; pg8::StaticOrder S; S.init(ML, D, F.G, bid, REP(22));
        pg8::EpiResid E{XL, XC, XL, XC, MOD + 1 * MODL + 5 * D, 1.0f}; pg8::gemm_phase<pg8::EpiResid, pg8::StaticOrder>(F.lds, g, S, E); } SEAM(22);
    PH_NORM(23, XL, XC, ML, 1, 2)
    PH_FFN1(24, 3, ML)
    PH_FFN2(25, 3, ML, XL, XC, MOD + 1 * MODL + 8 * D)
    if (IN(26)) { p_final(F, XL, args.in[22]); }
#undef IN
#undef SEAM
#undef PH_FFN1
#undef PH_FFN2
#undef PH_NORM
}

extern "C" void kernel_launch(void* const* d_in, const int* in_sizes, int n_in, void* d_out, int out_size, void* d_ws, size_t ws_size, hipStream_t stream) {
    static int grid = 0;
    if (grid == 0) {
        if (n_in != 23 || in_sizes[0] != ML * D || out_size != ML * D || ws_size < WS_END) { fprintf(stderr, "kernel_launch: unexpected problem shape (n_in %d, in0 %d, out %d, ws %zu); nothing launched\n", n_in, n_in > 0 ? in_sizes[0] : -1, out_size, ws_size); grid = -1; return; }
        int dev = 0, cus = 0;
        if (hipGetDevice(&dev) != hipSuccess || hipDeviceGetAttribute(&cus, hipDeviceAttributeMultiprocessorCount, dev) != hipSuccess) { grid = -1; return; }
        if (hipFuncSetAttribute((const void*)trunk_fwd, hipFuncAttributeMaxDynamicSharedMemorySize, LDS_BYTES) != hipSuccess) { fprintf(stderr, "kernel_launch: hipFuncSetAttribute failed\n"); grid = -1; return; }
        (void)hipGetLastError();
        grid = cus;
    }
    if (grid < 0) return;
    if (hipMemsetAsync((char*)d_ws + WS_CTL, 0, CTL_ZERO_BYTES, stream) != hipSuccess) return;
    Args a{};
    for (int i = 0; i < 23; ++i) a.in[i] = (const float*)d_in[i];
    a.out = (float*)d_out; a.ws = (unsigned char*)d_ws;
#if MK_PER_PHASE
    for (int p = 0; p < N_PHASES; ++p) { a.ph_lo = p; a.ph_hi = p + 1; hipLaunchKernelGGL(trunk_fwd, dim3(grid), dim3(NWAVES * 64), LDS_BYTES, stream, a); }
#else
    a.ph_lo = 0; a.ph_hi = N_PHASES;
    hipLaunchKernelGGL(trunk_fwd, dim3(grid), dim3(NWAVES * 64), LDS_BYTES, stream, a);
#endif
}
```

```cpp
#include <hip/hip_runtime.h>
#include <cstdio>
#include <cstdint>

#ifndef MK_PER_PHASE
#define MK_PER_PHASE 0
#endif

#define LAS __attribute__((address_space(3)))
typedef unsigned short bf16_t;
typedef short bf16x8 __attribute__((ext_vector_type(8)));
typedef float f32x4 __attribute__((ext_vector_type(4)));
typedef float f32x2 __attribute__((ext_vector_type(2)));
typedef unsigned u32x4 __attribute__((ext_vector_type(4)));
typedef unsigned u32x2 __attribute__((ext_vector_type(2)));

constexpr int D = 1024, NB = 4, SEQ = 4096, CTXL = 256, DFF = 2816;
constexpr int ML = NB * SEQ, MC = NB * CTXL, MT = ML + MC;
constexpr int NQ = MT / 64;
constexpr int MODL = 5 * 9 * D;
constexpr int DNP = 4128, DNPP = 4352;
constexpr float EPS = 1e-6f;

constexpr size_t MiB = 1u << 20;
constexpr size_t WS_CTL = 0, CTL_ZERO_BYTES = 2 * MiB;
constexpr size_t WS_MOD = 1 * MiB;
constexpr size_t WS_W1 = 2 * MiB, W1_SZ = (size_t)2 * DFF * D * 2;
constexpr size_t WS_W2 = 46 * MiB, W2_SZ = (size_t)D * DFF * 2;
constexpr size_t WS_WLIN = 68 * MiB, WS_WLG = 72 * MiB, WS_WLO = 74 * MiB, WS_WDIN = 76 * MiB, WS_WDO = 85 * MiB;
constexpr size_t WS_SP8 = 84 * MiB + 768 * 1024;
constexpr size_t WS_XC = 87 * MiB;
constexpr size_t WS_XN = 91 * MiB;
constexpr size_t WS_H = 125 * MiB;
constexpr size_t WS_PART = 240 * MiB;
constexpr size_t WS_Y = 125 * MiB, WS_UP = 159 * MiB, WS_U = 193 * MiB, WS_AGGA = 227 * MiB, WS_AGGB = 230 * MiB, WS_CARRY = 233 * MiB;
constexpr size_t WS_Z = 13 * MiB;
constexpr size_t WS_GC = 48 * MiB;
constexpr size_t WS_HALO = 53 * MiB;
constexpr size_t WS_O = 91 * MiB;
constexpr size_t WS_QKV = 155 * MiB;
constexpr size_t WS_VC = 257 * MiB;
constexpr size_t WS_T = 291 * MiB, WS_P = 317 * MiB;
constexpr size_t WS_AB = 343 * MiB, WS_END = 346 * MiB;
constexpr size_t WS_RO2 = WS_QKV;
static_assert(WS_W1 + 4 * W1_SZ <= WS_W2 && WS_W2 + 4 * W2_SZ <= WS_WLIN && WS_WDIN + (size_t)DNPP * D * 2 <= WS_WDO, "weights map");
static_assert(WS_XN + (size_t)MT * D * 2 <= WS_H && WS_H + (size_t)MT * DFF * 2 <= WS_AGGA, "activation map");
static_assert(WS_Z >= WS_W1 + W1_SZ && WS_Z + (size_t)MT * D * 2 <= WS_GC && WS_GC + (size_t)4352 * 1024 <= WS_HALO && WS_HALO + (size_t)NQ * 3 * 3072 * 2 <= WS_W2 + 3 * W2_SZ, "DeltaNet records over dead weights");
static_assert(WS_O + (size_t)2 * ML * D * 2 <= WS_QKV && WS_QKV + (size_t)MT * 3072 * 2 <= WS_VC && WS_VC + (size_t)2176 * 16384 <= WS_T && WS_T + (size_t)4352 * 6144 <= WS_P && WS_P + (size_t)4352 * 6144 <= WS_AB && WS_AB + (size_t)MT * 32 * 4 <= WS_END, "DeltaNet map");
constexpr int CW_BAR = 4096;

constexpr int RING_BYTES = 131072, LDS_BYTES = 147456, LDSCTL_OFF = LDS_BYTES - 1024, MISC_OFF = LDSCTL_OFF + 320;
constexpr int NWAVES = 8;

#define RLX_AGENT __ATOMIC_RELAXED, __HIP_MEMORY_SCOPE_AGENT
#define LDS_WAIT() asm volatile("s_waitcnt lgkmcnt(0)" ::: "memory")
__device__ __forceinline__ unsigned f2bf(float f) { unsigned u = __builtin_bit_cast(unsigned, f); return (u + 0x7fffu + ((u >> 16) & 1u)) >> 16; }
__device__ __forceinline__ unsigned pk2(float lo, float hi) { return f2bf(lo) | (f2bf(hi) << 16); }
__device__ __forceinline__ float bflo(unsigned w) { return __builtin_bit_cast(float, w << 16); }
__device__ __forceinline__ float bfhi(unsigned w) { return __builtin_bit_cast(float, w & 0xffff0000u); }
__device__ __forceinline__ float sigmoidf_(float x) { return 1.0f / (1.0f + expf(-x)); }
__device__ __forceinline__ float siluf_(float x) { return x / (1.0f + expf(-x)); }
__device__ __forceinline__ float softplusf_(float x) { return fmaxf(x, 0.f) + log1pf(expf(-fabsf(x))); }
__device__ __forceinline__ float fexp_(float x) { return __builtin_amdgcn_exp2f(x * 1.4426950408889634f); }
__device__ __forceinline__ float fsigmoid_(float x) { return __builtin_amdgcn_rcpf(1.0f + fexp_(-x)); }
__device__ __forceinline__ float fgelu_tanh(float x) { const float z = 0.7978845608028654f * (x + 0.044715f * x * x * x); const float t = 1.0f - 2.0f * __builtin_amdgcn_rcpf(1.0f + fexp_(2.0f * z)); return 0.5f * x * (1.0f + t); }
__device__ __forceinline__ float gelu_tanh(float x) { const float t = tanhf(0.7978845608028654f * (x + 0.044715f * x * x * x)); return 0.5f * x * (1.0f + t); }
template <int CTRL> __device__ __forceinline__ float dpp_keep(float v, float keep) { return __builtin_bit_cast(float, __builtin_amdgcn_update_dpp(__builtin_bit_cast(int, keep), __builtin_bit_cast(int, v), CTRL, 0xf, 0xf, false)); }
__device__ __forceinline__ float wave_sum(float v) {
#pragma unroll
    for (int o = 1; o < 64; o <<= 1) v += __shfl_xor(v, o);
    return v;
}

namespace pg8 {
constexpr int BM = 256, BK = 64, HALF = 128, HTB = HALF * BK * 2, STAGE_BYTES = 8 * HTB, NXCD = 8, WGM = 8;
__host__ __device__ __forceinline__ int lds_byte(int r, int c) { const int st = (r >> 4) * 2 + (c >> 5), rr = r & 15, cc = c & 31, ob = rr * 64 + cc * 2; return st * 1024 + (ob ^ (((ob >> 9) & 1) << 5)); }
__host__ __device__ __forceinline__ void stage_rc(int b, int& R, int& C) { const int st = b / 1024, sb = b % 1024, swz = sb ^ (((sb >> 9) & 1) << 5); R = (st >> 1) * 16 + swz / 64; C = (st & 1) * 32 + (swz % 64) / 2; }
__host__ __device__ __forceinline__ int perm32(int rho) { const int n = rho >> 4, i = rho & 15; return 8 * (i >> 2) + 4 * n + (i & 3); }

struct Unit { int pm, pn, r, kb, nt, at; };
struct Gemm { const bf16_t* A; const bf16_t* Bt; int M, N, K, lda, hdiv, ldb; };

struct StaticOrder {
    int nM, nN, nwg, G, c, rep;
    __host__ __device__ void init(int M, int N, int G_, int c_, int rep_ = 1) { nM = M / BM; nN = N / BM; nwg = nM * nN; G = G_; c = c_; rep = rep_; }
    __host__ __device__ bool next(int i, Unit& u) const {
        const int nc = c < nwg ? (nwg - c + G - 1) / G : 0;
        if (i >= nc * rep) return false;
        u.r = i / nc; u.kb = 0; u.nt = 0; u.at = 0; const long L = (long)(i % nc) * G + c;
        int wgid = (int)L; { const int q = nwg / NXCD, r = nwg % NXCD, xcd = wgid % NXCD, off = wgid / NXCD; wgid = (xcd < r ? xcd * (q + 1) : r * (q + 1) + (xcd - r) * q) + off; }
        const int nig = WGM * nN, gid = wgid / nig, fm = gid * WGM, gsz = (nM - fm) < WGM ? (nM - fm) : WGM;
        u.pm = fm + ((wgid % nig) % gsz); u.pn = (wgid % nig) / gsz; return true;
    }
    __device__ __forceinline__ void a_ready(const Unit&) const {}
    __device__ __forceinline__ void done(const Unit&) const {}
};

struct ResidOrder {
    int nlat, nsub, sk, G, c, rep;
    __host__ __device__ void init(int M, int K, int G_, int c_, int rep_ = 1) { nlat = (ML / BM) * (D / BM); sk = K / 256; nsub = M > ML ? 16 * sk : 0; G = G_; c = c_; rep = rep_; }
    __host__ __device__ bool next(int i, Unit& u) const {
        const int tot = nlat + nsub, nc = c < tot ? (tot - c + G - 1) / G : 0;
        if (i >= nc * rep) return false;
        const int L = (i % nc) * G + c;
        if (L < nlat) { int wgid = L; { const int q = nlat / NXCD, r = nlat % NXCD, xcd = wgid % NXCD, off = wgid / NXCD; wgid = (xcd < r ? xcd * (q + 1) : r * (q + 1) + (xcd - r) * q) + off; }
            const int nM = ML / BM, nN = D / BM, nig = WGM * nN, gid = wgid / nig, fm = gid * WGM, gsz = (nM - fm) < WGM ? (nM - fm) : WGM;
            u.pm = fm + ((wgid % nig) % gsz); u.pn = (wgid % nig) / gsz; u.r = i / nc; u.kb = 0; u.nt = 0; u.at = 0; return true; }
        const int j = L - nlat, tile = j / sk, sl = j % sk;
        u.pm = ML / BM + (tile >> 2); u.pn = tile & 3; u.r = i / nc; u.kb = sl * 256; u.nt = 4; u.at = 1; return true;
    }
    __device__ __forceinline__ void a_ready(const Unit&) const {}
    __device__ __forceinline__ void done(const Unit&) const {}
};

__device__ __forceinline__ unsigned cvt_pk_bf16(float lo, float hi) { unsigned r; asm volatile("v_cvt_pk_bf16_f32 %0, %1, %2" : "=v"(r) : "v"(lo), "v"(hi)); return r; }

template <class Epi, class Sched, bool ALIGN_EPI = true, bool SP2 = true>
__device__ __forceinline__ void gemm_phase(LAS unsigned char* lds, const Gemm g, const Sched& S, const Epi& E) {
    const int tid = threadIdx.x, wid = __builtin_amdgcn_readfirstlane(tid >> 6), lane = tid & 63, wr = wid >> 2, wc = wid & 3, fr = lane & 15, fq = lane >> 4;
    const int K = g.K, lda = g.lda, ldb = g.ldb;
    unsigned voffA[2], voffB[2];
#pragma unroll
    for (int i = 0; i < 2; ++i) { int R, C; stage_rc(tid * 16 + i * 8192, R, C); const int Rb = Epi::PERM ? ((R & ~31) + perm32(R & 31)) : R;
        voffA[i] = (unsigned)(R * lda + C) * 2u; voffB[i] = (unsigned)(Rb * ldb + C) * 2u; }
    const size_t kstep = (size_t)(BK * 2);
    const size_t hstepA = (size_t)HALF * lda * 2, hstepB = (size_t)HALF * ldb * 2;
    const size_t tstepA = 2 * hstepA, tstepB = 2 * hstepB;
    const unsigned ldsw = (unsigned)wid * 1024u;
    const int aoff = lds_byte(wr * 64 + fr, fq * 8), boff = lds_byte(wc * 32 + fr, fq * 8);
#define PG8_SA(b, h) (((b) * 2 + (h)) * HTB)
#define PG8_SB(b, h) ((4 + (b) * 2 + (h)) * HTB)
#define PG8_STAGE(bufoff, gbase, voff) do { _Pragma("unroll") for (int _i = 0; _i < 2; ++_i) \
        __builtin_amdgcn_global_load_lds((const unsigned*)((const char*)(gbase) + (voff)[_i]), (LAS unsigned*)(lds + (bufoff) + ldsw + _i * 8192), 16, 0, 0); } while (0)
#define PG8_LDA(dst, b, h) do { _Pragma("unroll") for (int m = 0; m < 4; ++m) _Pragma("unroll") for (int k = 0; k < 2; ++k) dst[m][k] = *(const LAS bf16x8*)(lds + PG8_SA(b, h) + aoff + m * 2048 + k * 1024); } while (0)
#define PG8_LDB(dst, b, h) do { _Pragma("unroll") for (int n = 0; n < 2; ++n) _Pragma("unroll") for (int k = 0; k < 2; ++k) dst[n][k] = *(const LAS bf16x8*)(lds + PG8_SB(b, h) + boff + n * 2048 + k * 1024); } while (0)
#define PG8_MMA(ai, bj, At, Bt) do { __builtin_amdgcn_s_setprio(1); _Pragma("unroll") for (int m = 0; m < 4; ++m) _Pragma("unroll") for (int n = 0; n < 2; ++n) _Pragma("unroll") for (int k = 0; k < 2; ++k) \
        acc[ai][bj][m][n] = __builtin_amdgcn_mfma_f32_16x16x32_bf16(Bt[n][k], At[m][k], acc[ai][bj][m][n], 0, 0, 0); __builtin_amdgcn_s_setprio(0); } while (0)
#define PG8_WAIT_V(n) asm volatile("s_waitcnt vmcnt(" #n ")" ::: "memory")
#define PG8_WAIT_L(n) asm volatile("s_waitcnt lgkmcnt(" #n ")" ::: "memory")
#define PG8_BAR __builtin_amdgcn_s_barrier()
#define PG8_SCHED __builtin_amdgcn_sched_barrier(0)
#define PG8_ABASE(u) ((const char*)g.A + (size_t)(u).pm * tstepA + (g.hdiv ? (size_t)((u).pn / g.hdiv) * (size_t)K * 2 : (size_t)0) + (size_t)(u).kb * 2)
#define PG8_BBASE(u) ((const char*)g.Bt + (size_t)(u).pn * tstepB + (size_t)(u).kb * 2)
    Unit cur, nxt; int ui = 0;
    if (!S.next(0, cur)) return;
    f32x4 acc[2][2][4][2];
#pragma unroll
    for (int a = 0; a < 2; ++a)
#pragma unroll
        for (int b = 0; b < 2; ++b)
#pragma unroll
            for (int m = 0; m < 4; ++m)
#pragma unroll
                for (int n = 0; n < 2; ++n) acc[a][b][m][n] = (f32x4){0.f, 0.f, 0.f, 0.f};
    bf16x8 At[4][2], B0[2][2], B1[2][2];
    const char* cA = PG8_ABASE(cur); const char* cB = PG8_BBASE(cur); int nt = cur.nt ? cur.nt : K / BK;
    S.a_ready(cur);
    if constexpr (SP2) {
        PG8_STAGE(PG8_SB(0, 0), cB, voffB); PG8_STAGE(PG8_SB(0, 1), cB + hstepB, voffB); PG8_STAGE(PG8_SA(0, 0), cA, voffA); PG8_STAGE(PG8_SA(0, 1), cA + hstepA, voffA);
        if (wr == 1) PG8_BAR;
        PG8_WAIT_V(2); PG8_BAR;
        PG8_STAGE(PG8_SB(1, 0), cB + kstep, voffB); PG8_STAGE(PG8_SA(1, 0), cA + kstep, voffA); PG8_STAGE(PG8_SB(1, 1), cB + hstepB + kstep, voffB);
        PG8_WAIT_V(6); PG8_BAR;
    } else {
        PG8_STAGE(PG8_SB(0, 0), cB, voffB); PG8_STAGE(PG8_SA(0, 0), cA, voffA); PG8_STAGE(PG8_SB(0, 1), cB + hstepB, voffB); PG8_STAGE(PG8_SA(0, 1), cA + hstepA, voffA);
        if (wr == 1) PG8_BAR;
        PG8_WAIT_V(4); PG8_BAR;
        PG8_STAGE(PG8_SB(1, 0), cB + kstep, voffB); PG8_STAGE(PG8_SA(1, 0), cA + kstep, voffA); PG8_STAGE(PG8_SB(1, 1), cB + hstepB + kstep, voffB);
        PG8_WAIT_V(6); PG8_BAR;
    }
    for (;;) {
        const bool has_next = S.next(ui + 1, nxt);
        const char* nA = has_next ? PG8_ABASE(nxt) : cA; const char* nB = has_next ? PG8_BBASE(nxt) : cB;
        for (int t = 0; t < nt; t += 2) {
            const bool last = (t == nt - 2);
            const char* a1 = cA + (size_t)(t + 1) * kstep;
            const char* a2 = last ? nA : cA + (size_t)(t + 2) * kstep; const char* b2 = last ? nB : cB + (size_t)(t + 2) * kstep;
            const char* a3 = a2 + kstep; const char* b3 = b2 + kstep;
            if (last && has_next) S.a_ready(nxt);
            if constexpr (SP2) {
            PG8_LDB(B0, 0, 0); PG8_LDB(B1, 0, 1); PG8_SCHED; PG8_LDA(At, 0, 0); PG8_STAGE(PG8_SA(1, 1), a1 + hstepA, voffA);
            PG8_WAIT_V(8); PG8_WAIT_L(0); PG8_BAR; PG8_MMA(0, 0, At, B0); PG8_MMA(0, 1, At, B1); PG8_BAR; PG8_SCHED;
            PG8_LDA(At, 0, 1); PG8_STAGE(PG8_SB(0, 0), b2, voffB); PG8_STAGE(PG8_SB(0, 1), b2 + hstepB, voffB); PG8_STAGE(PG8_SA(0, 0), a2, voffA);
            PG8_WAIT_V(8); PG8_WAIT_L(0); PG8_BAR; PG8_MMA(1, 0, At, B0); PG8_MMA(1, 1, At, B1); PG8_BAR; PG8_SCHED;
            PG8_LDB(B0, 1, 0); PG8_LDB(B1, 1, 1); PG8_SCHED; PG8_LDA(At, 1, 0); PG8_STAGE(PG8_SA(0, 1), a2 + hstepA, voffA);
            PG8_WAIT_V(8); PG8_WAIT_L(0); PG8_BAR; PG8_MMA(0, 0, At, B0); PG8_MMA(0, 1, At, B1); PG8_BAR; PG8_SCHED;
            PG8_LDA(At, 1, 1); PG8_STAGE(PG8_SB(1, 0), b3, voffB); PG8_STAGE(PG8_SB(1, 1), b3 + hstepB, voffB); PG8_STAGE(PG8_SA(1, 0), a3, voffA);
            PG8_WAIT_V(8); PG8_WAIT_L(0); PG8_BAR; PG8_MMA(1, 0, At, B0); PG8_MMA(1, 1, At, B1); PG8_BAR; PG8_SCHED;
            } else {
            PG8_LDB(B0, 0, 0); PG8_SCHED; PG8_LDA(At, 0, 0); PG8_STAGE(PG8_SA(1, 1), a1 + hstepA, voffA);
            PG8_WAIT_L(8); PG8_BAR; PG8_WAIT_L(0); PG8_MMA(0, 0, At, B0); PG8_BAR; PG8_SCHED;
            PG8_LDB(B1, 0, 1); PG8_STAGE(PG8_SB(0, 0), b2, voffB);
            PG8_BAR; PG8_WAIT_L(0); PG8_MMA(0, 1, At, B1); PG8_BAR;
            PG8_LDA(At, 0, 1); PG8_STAGE(PG8_SA(0, 0), a2, voffA);
            PG8_BAR; PG8_WAIT_L(0); PG8_MMA(1, 0, At, B0); PG8_BAR; PG8_SCHED;
            PG8_STAGE(PG8_SB(0, 1), b2 + hstepB, voffB);
            PG8_WAIT_V(6); PG8_BAR; PG8_MMA(1, 1, At, B1); PG8_BAR;
            PG8_LDB(B0, 1, 0); PG8_SCHED; PG8_LDA(At, 1, 0); PG8_STAGE(PG8_SA(0, 1), a2 + hstepA, voffA);
            PG8_WAIT_L(8); PG8_BAR; PG8_WAIT_L(0); PG8_MMA(0, 0, At, B0); PG8_BAR; PG8_SCHED;
            PG8_LDB(B1, 1, 1); PG8_STAGE(PG8_SB(1, 0), b3, voffB);
            PG8_BAR; PG8_WAIT_L(0); PG8_MMA(0, 1, At, B1); PG8_BAR;
            PG8_LDA(At, 1, 1); PG8_STAGE(PG8_SA(1, 0), a3, voffA);
            PG8_BAR; PG8_WAIT_L(0); PG8_MMA(1, 0, At, B0); PG8_BAR; PG8_SCHED;
            PG8_STAGE(PG8_SB(1, 1), b3 + hstepB, voffB);
            PG8_WAIT_V(6); PG8_BAR; PG8_MMA(1, 1, At, B1); PG8_BAR;
            }
        }
        if constexpr (ALIGN_EPI) { if (wr == 0) PG8_BAR; }
        E(acc, cur, wr, wc, fr, fq); S.done(cur);
        if (!has_next) break;
#pragma unroll
        for (int a = 0; a < 2; ++a)
#pragma unroll
            for (int b = 0; b < 2; ++b)
#pragma unroll
                for (int m = 0; m < 4; ++m)
#pragma unroll
                    for (int n = 0; n < 2; ++n) acc[a][b][m][n] = (f32x4){0.f, 0.f, 0.f, 0.f};
        cur = nxt; cA = nA; cB = nB; ++ui; nt = cur.nt ? cur.nt : K / BK;
        if constexpr (ALIGN_EPI) { if (wr == 1) PG8_BAR; }
    }
    PG8_WAIT_V(0);
    if constexpr (!ALIGN_EPI) { if (wr == 0) PG8_BAR; }
    PG8_BAR;
#undef PG8_SA
#undef PG8_SB
#undef PG8_STAGE
#undef PG8_LDA
#undef PG8_LDB
#undef PG8_MMA
#undef PG8_WAIT_V
#undef PG8_WAIT_L
#undef PG8_BAR
#undef PG8_SCHED
#undef PG8_ABASE
#undef PG8_BBASE
}

struct EpiBf16 {
    static constexpr bool PERM = true;
    bf16_t* O; int ldc; int split_cols; size_t split_stride;
    __device__ __forceinline__ void operator()(const f32x4 (&acc)[2][2][4][2], const Unit& u, int wr, int wc, int fr, int fq) const {
        const int row0 = u.pm * BM + wr * 64 + fr; int colt = u.pn * BM; bf16_t* base = O;
        if (split_cols) { const int t = colt / split_cols; base += (size_t)t * split_stride; colt -= t * split_cols; }
        const int col0 = colt + wc * 32 + 8 * fq;
#pragma unroll
        for (int ai = 0; ai < 2; ++ai)
#pragma unroll
            for (int m = 0; m < 4; ++m) { bf16_t* rowp = base + (size_t)(row0 + ai * HALF + m * 16) * ldc + col0;
#pragma unroll
                for (int bj = 0; bj < 2; ++bj) { const f32x4 v0 = acc[ai][bj][m][0], v1 = acc[ai][bj][m][1];
                    u32x4 w; w.x = cvt_pk_bf16(v0[0], v0[1]); w.y = cvt_pk_bf16(v0[2], v0[3]); w.z = cvt_pk_bf16(v1[0], v1[1]); w.w = cvt_pk_bf16(v1[2], v1[3]);
                    *(u32x4*)(rowp + bj * HALF) = w; } }
    }
};
struct EpiSwiglu {
    static constexpr bool PERM = false;
    bf16_t* Hout;
    __device__ __forceinline__ void operator()(const f32x4 (&acc)[2][2][4][2], const Unit& u, int wr, int wc, int fr, int fq) const {
        const int row0 = u.pm * BM + wr * 64 + fr, col0 = u.pn * 128 + wc * 16 + 4 * fq;
#pragma unroll
        for (int ai = 0; ai < 2; ++ai)
#pragma unroll
            for (int m = 0; m < 4; ++m) { bf16_t* rowp = Hout + (size_t)(row0 + ai * HALF + m * 16) * DFF + col0;
#pragma unroll
                for (int bj = 0; bj < 2; ++bj) { const f32x4 gt = acc[ai][bj][m][0], up = acc[ai][bj][m][1]; float h[4];
#pragma unroll
                    for (int i = 0; i < 4; ++i) h[i] = gt[i] / (1.0f + __expf(-gt[i])) * up[i];
                    u32x2 w; w.x = cvt_pk_bf16(h[0], h[1]); w.y = cvt_pk_bf16(h[2], h[3]);
                    *(u32x2*)(rowp + bj * 64) = w; } }
    }
};
struct EpiResid {
    static constexpr bool PERM = false;
    const float* base_lat; const float* base_ctx; float* out_lat; float* out_ctx; const float* gate; float gs; float* part;
    __device__ __forceinline__ void operator()(const f32x4 (&acc)[2][2][4][2], const Unit& u, int wr, int wc, int fr, int fq) const {
        const bool lat = u.pm < ML / BM; const int set = lat ? (u.pm >> 4) : 4;
        const float* bp = lat ? base_lat + (size_t)u.pm * BM * D : base_ctx + (size_t)(u.pm - ML / BM) * BM * D;
        float* op = lat ? out_lat + (size_t)u.pm * BM * D : out_ctx + (size_t)(u.pm - ML / BM) * BM * D;
        const int col0 = u.pn * BM + wc * 32 + 4 * fq;
        f32x4 gv[2][2];
#pragma unroll
        for (int bj = 0; bj < 2; ++bj)
#pragma unroll
            for (int n = 0; n < 2; ++n) gv[bj][n] = *(const f32x4*)(gate + (size_t)set * 9 * D + col0 + bj * HALF + n * 16) * ((u.r && !u.at) ? 0.f : gs);
#pragma unroll
        for (int ai = 0; ai < 2; ++ai)
#pragma unroll
            for (int m = 0; m < 4; ++m) { const size_t off = (size_t)(wr * 64 + fr + ai * HALF + m * 16) * D + col0;
#pragma unroll
                for (int bj = 0; bj < 2; ++bj)
#pragma unroll
                    for (int n = 0; n < 2; ++n) {
                        if (u.at) { *(f32x4*)(part + (size_t)(u.kb >> 8) * MC * D + (size_t)(u.pm - ML / BM) * BM * D + off + bj * HALF + n * 16) = gv[bj][n] * acc[ai][bj][m][n]; }
                        else { const f32x4 bs = *(const f32x4*)(bp + off + bj * HALF + n * 16); *(f32x4*)(op + off + bj * HALF + n * 16) = bs + gv[bj][n] * acc[ai][bj][m][n]; } }
                if (m & 1) asm volatile("" ::: "memory"); }
    }
};
struct EpiDnIn {
    static constexpr bool PERM = true;
    bf16_t* QKVP; bf16_t* Z; float* AB; bf16_t* HALO;
    __device__ __forceinline__ void operator()(const f32x4 (&acc)[2][2][4][2], const Unit& u, int wr, int wc, int fr, int fq) const {
#pragma unroll
        for (int ai = 0; ai < 2; ++ai)
#pragma unroll
            for (int m = 0; m < 4; ++m) {
                const int r = u.pm * BM + ai * HALF + wr * 64 + m * 16 + fr; int sr = r;
                if (r < ML) { const int s = r & (SEQ - 1); sr = (r & ~(SEQ - 1)) + ((s & 63) << 6) + (s >> 6); }
                if (u.pn < 16) {
                    bf16_t* rowp = (u.pn < 12) ? QKVP + (size_t)sr * 3072 + u.pn * BM : Z + (size_t)sr * D + (u.pn - 12) * BM;
                    rowp += wc * 32 + 8 * fq;
#pragma unroll
                    for (int bj = 0; bj < 2; ++bj) { const f32x4 v0 = acc[ai][bj][m][0], v1 = acc[ai][bj][m][1];
                        u32x4 w; w.x = cvt_pk_bf16(v0[0], v0[1]); w.y = cvt_pk_bf16(v0[2], v0[3]); w.z = cvt_pk_bf16(v1[0], v1[1]); w.w = cvt_pk_bf16(v1[2], v1[3]);
                        *(u32x4*)(rowp + bj * HALF) = w;
                        if (u.pn < 12) { const int p63 = sr & 63; if (p63 == 0 || p63 >= 62) *(u32x4*)(HALO + ((size_t)(sr >> 6) * 3 + (p63 == 0 ? 0 : p63 - 61)) * 3072 + u.pn * BM + wc * 32 + 8 * fq + bj * HALF) = w; } }
                } else if (wc == 0) {
                    float* rowp = AB + (size_t)sr * 32 + 8 * fq;
                    *(f32x4*)(rowp) = acc[ai][0][m][0]; *(f32x4*)(rowp + 4) = acc[ai][0][m][1];
                }
            }
    }
};
template <int PASS> struct EpiGates {
    static constexpr bool PERM = false;
    const bf16_t* U; const bf16_t* Y; bf16_t* RO; const float* bgate; const float* lam; float* agga; float* aggb; const float* carry;
    __device__ __forceinline__ void operator()(const f32x4 (&acc)[2][2][4][2], const Unit& u, int wr, int wc, int fr, int fq) const {
        const int ch0 = (u.pn >> 2) * 256 + (u.pn & 3) * 64 + wc * 16 + fq * 4;
#pragma unroll
        for (int ai = 0; ai < 2; ++ai) {
            const int q = u.pm * 4 + ai * 2 + wr;
            f32x4 hsum[4];
#pragma unroll
            for (int dir = 0; dir < 2; ++dir) {
                const f32x4 br = *(const f32x4*)(bgate + (dir * 2 + 0) * D + ch0), bi = *(const f32x4*)(bgate + (dir * 2 + 1) * D + ch0);
                const f32x4 sp8 = *(const f32x4*)(lam + dir * D + ch0);
                const size_t qo = ((size_t)dir * NQ + q) * D + ch0;
                f32x4 hin, Ac = {1.f, 1.f, 1.f, 1.f};
                if (PASS == 0) hin = (f32x4){0.f, 0.f, 0.f, 0.f}; else hin = *(const f32x4*)(carry + qo);
#pragma unroll
                for (int mm = 0; mm < 4; ++mm) {
                    const int m = dir == 0 ? mm : 3 - mm;
                    const u32x2 w = *(const u32x2*)(U + (size_t)(q * 64 + m * 16 + fr) * D + ch0);
                    const f32x4 uv = {bflo(w.x), bfhi(w.x), bflo(w.y), bfhi(w.y)};
                    const f32x4 pr = acc[ai][dir][m][0] + br, pi = acc[ai][dir][m][1] + bi;
                    f32x4 a, b;
#pragma unroll
                    for (int i = 0; i < 4; ++i) { const float rg = fsigmoid_(pr[i]), ig = fsigmoid_(pi[i]); const float la = -sp8[i] * rg;
                        a[i] = fexp_(la); b[i] = __builtin_amdgcn_sqrtf(fmaxf(1.0f - a[i] * a[i], 0.f)) * ig * uv[i]; }
#define GS_STEP(dd) do { f32x4 ap, bp; _Pragma("unroll") for (int i = 0; i < 4; ++i) { \
                        if (dir == 0) { ap[i] = dpp_keep<0x110 + (dd)>(a[i], 1.0f); bp[i] = dpp_keep<0x110 + (dd)>(b[i], 0.0f); } \
                        else          { ap[i] = dpp_keep<0x100 + (dd)>(a[i], 1.0f); bp[i] = dpp_keep<0x100 + (dd)>(b[i], 0.0f); } } \
                        b = a * bp + b; a = a * ap; } while (0)
                    GS_STEP(1); GS_STEP(2); GS_STEP(4); GS_STEP(8);
#undef GS_STEP
                    f32x4 at, bt;
#pragma unroll
                    for (int i = 0; i < 4; ++i) { at[i] = __shfl(a[i], dir == 0 ? 15 : 0, 16); bt[i] = __shfl(b[i], dir == 0 ? 15 : 0, 16); }
                    if (PASS == 1) { const f32x4 h = a * hin + b; if (dir == 0) hsum[m] = h; else hsum[m] = hsum[m] + h; }
                    hin = at * hin + bt; Ac = Ac * at;
                    asm volatile("" ::: "memory");
                }
                if (PASS == 0) { if (fr == 0) { *(f32x4*)(agga + qo) = Ac; *(f32x4*)(aggb + qo) = hin; } }
            }
            if (PASS == 1) {
#pragma unroll
                for (int m = 0; m < 4; ++m) { const size_t off = (size_t)(q * 64 + m * 16 + fr) * D + ch0; const u32x2 w = *(const u32x2*)(Y + off);
                    const float y0 = bflo(w.x), y1 = bfhi(w.x), y2 = bflo(w.y), y3 = bfhi(w.y);
                    u32x2 o; o.x = cvt_pk_bf16(fgelu_tanh(y0) * hsum[m][0], fgelu_tanh(y1) * hsum[m][1]); o.y = cvt_pk_bf16(fgelu_tanh(y2) * hsum[m][2], fgelu_tanh(y3) * hsum[m][3]);
                    *(u32x2*)(RO + off) = o; }
            }
        }
    }
};
}

#define XB_TMO      128
#define XB_XCNT(j)  (256  + 64 * (j))
#define XB_XSUB(j)  (1280 + 64 * (j))
#define XB_XGEN(j)  (2304 + 64 * (j))
#define XB_TOP      3328
#define XB_TOPGEN   3392
#define XCD_BAR_WORDS 3456
#define XB_SPIN_CAP (1u << 18)
__device__ __forceinline__ unsigned xb_ld(unsigned* p)              { return __hip_atomic_load(p, __ATOMIC_RELAXED, __HIP_MEMORY_SCOPE_AGENT); }
__device__ __forceinline__ unsigned xb_add(unsigned* p, unsigned v) { return __hip_atomic_fetch_add(p, v, __ATOMIC_RELAXED, __HIP_MEMORY_SCOPE_AGENT); }
__device__ __forceinline__ unsigned xb_xcc_id() { return (unsigned)__builtin_amdgcn_s_getreg((3 << 11) | 20) & 0xFu; }
#define XB_SPIN(cond, bar) do { unsigned _sp = 0; while (cond) { __builtin_amdgcn_s_sleep(1); \
    if ((++_sp & 255u) == 0u) { if (xb_ld(&(bar)[XB_TMO])) break; if (_sp > XB_SPIN_CAP) { atomicAdd(&(bar)[XB_TMO], 1u); break; } } } } while (0)
struct XcdBarrier { unsigned* bar; unsigned x; volatile LAS unsigned* st; };
__device__ __forceinline__ XcdBarrier xcd_barrier_post(unsigned* bar, volatile LAS unsigned* st) {
    XcdBarrier b; b.bar = bar; b.x = xb_xcc_id(); b.st = st;
    if (threadIdx.x == 0) (void)xb_add(&bar[XB_XCNT(b.x)], 1u);
    return b;
}
__device__ __forceinline__ void xcd_barrier_complete(unsigned* bar, unsigned x, unsigned& nloc, unsigned& nx) {
    const unsigned G = gridDim.x * gridDim.y * gridDim.z;
    unsigned sum, cnt, mine, sp = 0u;
    for (;;) {
        sum = 0u; cnt = 0u; mine = 0u;
#pragma unroll
        for (unsigned j = 0; j < 16; ++j) { const unsigned c = xb_ld(&bar[XB_XCNT(j)]); sum += c; cnt += (c > 0u) ? 1u : 0u; mine = (j == x) ? c : mine; }
        if (sum == G) break;
        __builtin_amdgcn_s_sleep(1);
        if ((++sp & 255u) == 0u) { if (xb_ld(&bar[XB_TMO])) break; if (sp > XB_SPIN_CAP) { atomicAdd(&bar[XB_TMO], 1u); break; } }
    }
    nloc = mine > 0u ? mine : 1u; nx = cnt > 0u ? cnt : 1u;
}
__device__ __forceinline__ void xcd_barrier(const XcdBarrier& b) {
    asm volatile("s_waitcnt vmcnt(0)" ::: "memory");
    __syncthreads();
    if (threadIdx.x == 0) {
        unsigned* bar = b.bar;
        __builtin_amdgcn_s_waitcnt(0);
        unsigned nloc = b.st[0], nx = b.st[1];
        if (nloc == 0u) { xcd_barrier_complete(bar, b.x, nloc, nx); b.st[0] = nloc; b.st[1] = nx; }
        const unsigned old = xb_add(&bar[XB_XSUB(b.x)], 1u);
        const unsigned gen = old / nloc;
        if (old + 1u == (gen + 1u) * nloc) {
            __builtin_amdgcn_fence(__ATOMIC_RELEASE, "agent");
            asm volatile("s_waitcnt vmcnt(0)" ::: "memory");
            const unsigned og = xb_add(&bar[XB_TOP], 1u);
            const unsigned tg = og / nx;
            if (og + 1u == (tg + 1u) * nx) xb_add(&bar[XB_TOPGEN], 1u);
            else XB_SPIN(xb_ld(&bar[XB_TOPGEN]) == tg, bar);
            __builtin_amdgcn_fence(__ATOMIC_ACQUIRE, "agent");
            xb_add(&bar[XB_XGEN(b.x)], 1u);
            asm volatile("s_waitcnt vmcnt(0)" ::: "memory");
        } else {
            XB_SPIN(xb_ld(&bar[XB_XGEN(b.x)]) == gen, bar);
            __builtin_amdgcn_fence(__ATOMIC_ACQUIRE, "agent");
            asm volatile("s_waitcnt vmcnt(0)" ::: "memory");
        }
    }
    __syncthreads();
}

struct Args { const float* in[23]; float* out; unsigned char* ws; int ph_lo, ph_hi; };
struct Frame { LAS unsigned char* lds; int tid, lane, wave, vcu, G; };

struct MapId { __device__ __forceinline__ int operator()(int s) const { return s; } };
struct MapW1 { __device__ __forceinline__ int operator()(int s) const { const int n = s >= DFF ? 1 : 0, hid = s - n * DFF, rem = hid & 127; return (hid >> 7) * 256 + (rem >> 6) * 128 + ((rem >> 4) & 3) * 32 + n * 16 + (rem & 15); } };
struct MapWG { int dir, gate; __device__ __forceinline__ int operator()(int ch) const { return (ch >> 6) * 256 + dir * 128 + ((ch >> 4) & 3) * 32 + gate * 16 + (ch & 15); } };
template <class RowMap>
__device__ __forceinline__ void transpose_item(const float* src, int ld, int item, int nblk, bf16_t* dst, int Kd, LAS float* scr, int lane, const RowMap rm) {
    const int kb = item / nblk, nb = item % nblk, k0 = 64 * kb, n0 = 32 * nb;
#pragma unroll 8
    for (int i = 0; i < 32; ++i) { const int kk = 2 * i + (lane >> 5); scr[kk * 33 + (lane & 31)] = src[(size_t)(k0 + kk) * ld + n0 + (lane & 31)]; }
    LDS_WAIT(); asm volatile("" ::: "memory");
    const int c = lane & 7;
#pragma unroll
    for (int j = 0; j < 4; ++j) { const int n = (lane >> 3) + 8 * j; const LAS float* s = scr + (8 * c) * 33 + n;
        u32x4 o; o.x = pk2(s[0 * 33], s[1 * 33]); o.y = pk2(s[2 * 33], s[3 * 33]); o.z = pk2(s[4 * 33], s[5 * 33]); o.w = pk2(s[6 * 33], s[7 * 33]);
        *(u32x4*)(dst + (size_t)rm(n0 + n) * Kd + k0 + 8 * c) = o; }
    LDS_WAIT(); asm volatile("" ::: "memory");
}

__device__ __forceinline__ void p_prologue(const Frame& F, const Args& a, int reps) {
    unsigned char* ws = a.ws;
    LAS float* scr = (LAS float*)(F.lds + F.wave * 16384);
    const int gw = F.vcu * NWAVES + F.wave, NGW = F.G * NWAVES;
    constexpr int I_W1 = (D / 64) * (2 * DFF / 32), I_W2 = (DFF / 64) * (D / 32), I_LIN = (D / 64) * (2048 / 32), I_LG = (256 / 64) * (256 / 32), I_SQ = (D / 64) * (D / 32), I_DIN = (D / 64) * (DNP / 32);
    constexpr int NITEMS = 4 * I_W1 + 4 * I_W2 + I_LIN + 16 * I_LG + I_SQ + I_DIN + I_SQ;
    for (int rp_ = 0; rp_ < reps; ++rp_)
    for (int it = gw; it < NITEMS; it += NGW) {
        int r = it;
        if (r < 4 * I_W1) { const int w = r / I_W1; transpose_item(a.in[7] + (size_t)w * D * 2 * DFF, 2 * DFF, r % I_W1, 2 * DFF / 32, (bf16_t*)(ws + WS_W1 + ((w + 1) & 3) * W1_SZ), D, scr, F.lane, MapW1()); continue; } r -= 4 * I_W1;
        if (r < 4 * I_W2) { const int w = r / I_W2; transpose_item(a.in[8] + (size_t)w * DFF * D, D, r % I_W2, D / 32, (bf16_t*)(ws + WS_W2 + w * W2_SZ), DFF, scr, F.lane, MapId()); continue; } r -= 4 * I_W2;
        if (r < I_LIN) { transpose_item(a.in[9], 2048, r, 2048 / 32, (bf16_t*)(ws + WS_WLIN), D, scr, F.lane, MapId()); continue; } r -= I_LIN;
        if (r < 16 * I_LG) { const int j = r / I_LG, dir = j >> 3, gate = (j >> 2) & 1, head = j & 3;
            transpose_item(a.in[12] + (size_t)j * 256 * 256, 256, r % I_LG, 256 / 32, (bf16_t*)(ws + WS_WLG) + (size_t)head * 1024 * 256, 256, scr, F.lane, MapWG{dir, gate}); continue; } r -= 16 * I_LG;
        if (r < I_SQ) { transpose_item(a.in[15], D, r, D / 32, (bf16_t*)(ws + WS_WLO), D, scr, F.lane, MapId()); continue; } r -= I_SQ;
        if (r < I_DIN) { transpose_item(a.in[16], DNP, r, DNP / 32, (bf16_t*)(ws + WS_WDIN), D, scr, F.lane, MapId()); continue; } r -= I_DIN;
        transpose_item(a.in[21], D, r, D / 32, (bf16_t*)(ws + WS_WDO), D, scr, F.lane, MapId());
    }
    const size_t gt = (size_t)F.vcu * (NWAVES * 64) + F.tid, GT = (size_t)F.G * NWAVES * 64;
    { u32x4* p = (u32x4*)(ws + WS_WDIN + (size_t)DNP * D * 2); const size_t n = (size_t)(DNPP - DNP) * D * 2 / 16; for (size_t i = gt; i < n; i += GT) p[i] = (u32x4){0u, 0u, 0u, 0u}; }
    if (gt < 2 * D) ((float*)(ws + WS_SP8))[gt] = 8.0f * softplusf_(-a.in[14][gt]);
    float* MOD = (float*)(ws + WS_MOD);
    for (int it = F.vcu; it < 2 * 18 * 32; it += F.G) {
        const int l = it / (18 * 32), rem = it % (18 * 32), cb = rem >> 5, kc = rem & 31, col = cb * 512 + F.tid;
        const float* w = a.in[4] + (size_t)l * D * 9 * D + (size_t)(kc * 32) * 9 * D + col;
        float s[5] = {0.f, 0.f, 0.f, 0.f, 0.f};
#pragma unroll 4
        for (int k = 0; k < 32; ++k) { const float wv = w[(size_t)k * 9 * D]; const int kk = kc * 32 + k;
#pragma unroll
            for (int st = 0; st < 5; ++st) { const float cv = st < 4 ? a.in[1][st * D + kk] : a.in[3][kk]; s[st] += siluf_(cv) * wv; } }
        const float bias = kc == 0 ? a.in[5][l * 9 * D + col] : 0.f;
#pragma unroll
        for (int st = 0; st < 5; ++st) atomicAdd(MOD + (size_t)l * MODL + st * 9 * D + col, s[st] + bias);
    }
}

__device__ __forceinline__ void p_norm(const Frame& F, const float* xl, const float* xc, int nrows, const float* g, const float* mod, bf16_t* XN, const float* part, int nparts, float* xc_out) {
    const int gw = F.vcu * NWAVES + F.wave, NGW = F.G * NWAVES;
    for (int r = gw; r < nrows; r += NGW) {
        const float* src = r < ML ? xl + (size_t)r * D : xc + (size_t)(r - ML) * D; const int set = r < ML ? (r >> 12) : 4;
        const f32x4* x4 = (const f32x4*)src + F.lane; const f32x4* g4 = (const f32x4*)g + F.lane;
        const f32x4* sh4 = (const f32x4*)(mod + (size_t)set * 9 * D) + F.lane; const f32x4* sc4 = (const f32x4*)(mod + (size_t)set * 9 * D + D) + F.lane;
        f32x4 v[4]; float ss = 0.f;
#pragma unroll
        for (int j = 0; j < 4; ++j) v[j] = x4[64 * j];
        if (r >= ML && nparts > 0) {
            for (int p = 0; p < nparts; ++p) { const f32x4* p4 = (const f32x4*)(part + (size_t)p * MC * D + (size_t)(r - ML) * D) + F.lane;
#pragma unroll
                for (int j = 0; j < 4; ++j) v[j] = v[j] + p4[64 * j]; }
            f32x4* o4 = (f32x4*)(xc_out + (size_t)(r - ML) * D) + F.lane;
#pragma unroll
            for (int j = 0; j < 4; ++j) o4[64 * j] = v[j];
        }
#pragma unroll
        for (int j = 0; j < 4; ++j) ss += (v[j].x * v[j].x + v[j].y * v[j].y) + (v[j].z * v[j].z + v[j].w * v[j].w);
        const float rstd = 1.0f / sqrtf(wave_sum(ss) * (1.0f / D) + EPS);
        u32x2* o8 = (u32x2*)(XN + (size_t)r * D) + F.lane;
#pragma unroll
        for (int j = 0; j < 4; ++j) { const f32x4 y = v[j] * rstd * g4[64 * j] * (sc4[64 * j] + 1.0f) + sh4[64 * j]; u32x2 w; w.x = pk2(y.x, y.y); w.y = pk2(y.z, y.w); o8[64 * j] = w; }
    }
}
__device__ __forceinline__ void p_final(const Frame& F, float* x, const float* g) {
    const int gw = F.vcu * NWAVES + F.wave, NGW = F.G * NWAVES;
    for (int r = gw; r < ML; r += NGW) {
        f32x4* x4 = (f32x4*)(x + (size_t)r * D) + F.lane; const f32x4* g4 = (const f32x4*)g + F.lane;
        f32x4 v[4]; float ss = 0.f;
#pragma unroll
        for (int j = 0; j < 4; ++j) { v[j] = x4[64 * j]; ss += (v[j].x * v[j].x + v[j].y * v[j].y) + (v[j].z * v[j].z + v[j].w * v[j].w); }
        const float rstd = 1.0f / sqrtf(wave_sum(ss) * (1.0f / D) + EPS);
#pragma unroll
        for (int j = 0; j < 4; ++j) x4[64 * j] = v[j] * rstd * g4[64 * j];
    }
}
__device__ __forceinline__ void p_lru_conv(const Frame& F, const bf16_t* UP, const float* cw, const float* cb, bf16_t* U) {
    const size_t gt = (size_t)F.vcu * (NWAVES * 64) + F.tid, GT = (size_t)F.G * NWAVES * 64;
    for (size_t idx = gt; idx < (size_t)MT * 128; idx += GT) {
        const int r = (int)(idx >> 7), c8 = (int)(idx & 127) * 8;
        int pos, len; if (r < ML) { pos = r & (SEQ - 1); len = SEQ; } else { pos = (r - ML) & (CTXL - 1); len = CTXL; }
        float o[8];
#pragma unroll
        for (int i = 0; i < 8; ++i) o[i] = cb[c8 + i];
#pragma unroll
        for (int j = 0; j < 4; ++j) { const int p = pos + j - 2; if (p < 0 || p >= len) continue;
            const u32x4 w = *(const u32x4*)(UP + (size_t)(r + j - 2) * D + c8); const float* cwj = cw + j * D + c8;
            o[0] += bflo(w.x) * cwj[0]; o[1] += bfhi(w.x) * cwj[1]; o[2] += bflo(w.y) * cwj[2]; o[3] += bfhi(w.y) * cwj[3];
            o[4] += bflo(w.z) * cwj[4]; o[5] += bfhi(w.z) * cwj[5]; o[6] += bflo(w.w) * cwj[6]; o[7] += bfhi(w.w) * cwj[7]; }
        u32x4 ov; ov.x = pk2(o[0], o[1]); ov.y = pk2(o[2], o[3]); ov.z = pk2(o[4], o[5]); ov.w = pk2(o[6], o[7]);
        *(u32x4*)(U + (size_t)r * D + c8) = ov;
    }
}
__device__ __forceinline__ void p_lru_carry(const Frame& F, const float* agga, const float* aggb, float* carry) {
    const int idx = F.vcu * (NWAVES * 64) + F.tid;
    if (idx >= NB * 2 * D) return;
    const int ch = idx & (D - 1), dir = (idx >> 10) & 1, b = idx >> 11;
    float st = 0.f;
    for (int n = 0; n < 68; ++n) {
        int q; if (n < 4) q = 256 + 4 * b + (dir == 0 ? n : 3 - n); else q = 64 * b + (dir == 0 ? n - 4 : 63 - (n - 4));
        const size_t o = ((size_t)dir * NQ + q) * D + ch;
        carry[o] = st; st = agga[o] * st + aggb[o];
    }
}
typedef float f32x16 __attribute__((ext_vector_type(16)));
__device__ __forceinline__ int kperm(int s, int hh, int j) { return 16 * s + 8 * (j >> 2) + 4 * hh + (j & 3); }
__device__ __forceinline__ int crow(int reg, int hh) { return (reg & 3) + 8 * (reg >> 2) + 4 * hh; }
__device__ __forceinline__ size_t dn_frag_off(int q, int h, int seg, int f, int l) {
    return ((size_t)(64 * q + 4 * f + (l >> 4)) * 3072 + seg * 1024 + h * 128) * 2 + (size_t)(l & 15) * 16;
}
__device__ __forceinline__ bf16x8 pack8(const f32x16& v, int s) {
    u32x4 w; w.x = pg8::cvt_pk_bf16(v[8 * s + 0], v[8 * s + 1]); w.y = pg8::cvt_pk_bf16(v[8 * s + 2], v[8 * s + 3]); w.z = pg8::cvt_pk_bf16(v[8 * s + 4], v[8 * s + 5]); w.w = pg8::cvt_pk_bf16(v[8 * s + 6], v[8 * s + 7]);
    return __builtin_bit_cast(bf16x8, w);
}
#define MFMA32(a, b, c) __builtin_amdgcn_mfma_f32_32x32x16_bf16((a), (b), (c), 0, 0, 0)

constexpr int PL_KS = 0, PL_QS = 17408, PL_VS = 34816, PL_AP = 0, PL_KK = 52224, PL_QK = 68864, PL_TS = 85504, PL_GC = 103936, PL_BETA = 104448, PL_G = 104960;
__device__ __forceinline__ void p_dn_prep(const Frame& F, unsigned char* ws, const float* cw, const float* a_log, const float* dt_bias) {
    bf16_t* QKV = (bf16_t*)(ws + WS_QKV); const bf16_t* HALO = (const bf16_t*)(ws + WS_HALO); const float* AB = (const float*)(ws + WS_AB);
    const int tid = F.tid, lane = F.lane, wave = F.wave;
    LAS bf16_t* Ks = (LAS bf16_t*)(F.lds + PL_KS); LAS bf16_t* Qs = (LAS bf16_t*)(F.lds + PL_QS); LAS bf16_t* Vs = (LAS bf16_t*)(F.lds + PL_VS);
    LAS float* Ap = (LAS float*)(F.lds + PL_AP); LAS float* KKs = (LAS float*)(F.lds + PL_KK); LAS float* QKs = (LAS float*)(F.lds + PL_QK);
    LAS bf16_t* Ts = (LAS bf16_t*)(F.lds + PL_TS); LAS float* gcb = (LAS float*)(F.lds + PL_GC); LAS float* betab = (LAS float*)(F.lds + PL_BETA); LAS float* Gs = (LAS float*)(F.lds + PL_G);
    for (int it = F.vcu; it < NQ * 8; it += F.G) {
        const int q = it >> 3, h = it & 7;
        int cpos, nch; if (q < 256) { cpos = q & 63; nch = 64; } else { cpos = (q - 256) & 3; nch = 4; }
#ifndef PREP_SKIP
#define PREP_SKIP 0
#endif
        if (!(PREP_SKIP & 1)) {
            const int tok = tid >> 3, c0 = (tid & 7) * 16;
#pragma unroll
            for (int seg = 0; seg < 3; ++seg) {
                float x[16];
#pragma unroll
                for (int i = 0; i < 16; ++i) x[i] = 0.f;
#pragma unroll
                for (int j = 0; j < 4; ++j) {
                    const int tt = tok + j - 2; const bf16_t* rp = nullptr;
                    if (tt >= 0 && tt < 64) rp = QKV + (size_t)(64 * q + tt) * 3072;
                    else if (tt < 0) { if (cpos > 0) rp = HALO + ((size_t)(q - 1) * 3 + (tt + 3)) * 3072; }
                    else { if (cpos + 1 < nch) rp = HALO + ((size_t)(q + 1) * 3 + 0) * 3072; }
                    if (rp) { const u32x4 w0 = *(const u32x4*)(rp + seg * 1024 + h * 128 + c0), w1 = *(const u32x4*)(rp + seg * 1024 + h * 128 + c0 + 8);
                        const float* cwj = cw + j * 3072 + seg * 1024 + h * 128 + c0;
                        x[0] += bflo(w0.x) * cwj[0]; x[1] += bfhi(w0.x) * cwj[1]; x[2] += bflo(w0.y) * cwj[2]; x[3] += bfhi(w0.y) * cwj[3];
                        x[4] += bflo(w0.z) * cwj[4]; x[5] += bfhi(w0.z) * cwj[5]; x[6] += bflo(w0.w) * cwj[6]; x[7] += bfhi(w0.w) * cwj[7];
                        x[8] += bflo(w1.x) * cwj[8]; x[9] += bfhi(w1.x) * cwj[9]; x[10] += bflo(w1.y) * cwj[10]; x[11] += bfhi(w1.y) * cwj[11];
                        x[12] += bflo(w1.z) * cwj[12]; x[13] += bfhi(w1.z) * cwj[13]; x[14] += bflo(w1.w) * cwj[14]; x[15] += bfhi(w1.w) * cwj[15]; }
                }
                float ss = 0.f;
#pragma unroll
                for (int i = 0; i < 16; ++i) { x[i] = x[i] * fsigmoid_(x[i]); ss += x[i] * x[i]; }
                float sc = 1.0f;
                if (seg < 2) { ss += __shfl_xor(ss, 1); ss += __shfl_xor(ss, 2); ss += __shfl_xor(ss, 4); sc = (seg == 0 ? 0.08838834764831845f : 1.0f) / sqrtf(ss + EPS); }
                u32x4 o0, o1;
                o0.x = pk2(x[0] * sc, x[1] * sc); o0.y = pk2(x[2] * sc, x[3] * sc); o0.z = pk2(x[4] * sc, x[5] * sc); o0.w = pk2(x[6] * sc, x[7] * sc);
                o1.x = pk2(x[8] * sc, x[9] * sc); o1.y = pk2(x[10] * sc, x[11] * sc); o1.z = pk2(x[12] * sc, x[13] * sc); o1.w = pk2(x[14] * sc, x[15] * sc);
                LAS bf16_t* dst = (seg == 0 ? Qs : (seg == 1 ? Ks : Vs)) + tok * 136 + c0;
                *(LAS u32x4*)dst = o0; *(LAS u32x4*)(dst + 8) = o1;
            }
            if (tid < 128) {
                const int dir = tid >> 6, n = tid & 63; const float* abr = AB + (size_t)(64 * q + n) * 32;
                const float g = -expf(a_log[dir * 8 + h]) * softplusf_(abr[dir * 8 + h] + dt_bias[dir * 8 + h]);
                const float bet = sigmoidf_(abr[16 + dir * 8 + h]);
                float c = g;
#pragma unroll
                for (int d = 1; d < 64; d <<= 1) { const float o = dir == 0 ? __shfl_up(c, d, 64) : __shfl_down(c, d, 64); if (dir == 0 ? (n >= d) : (n + d < 64)) c += o; }
                gcb[dir * 64 + n] = c; betab[dir * 64 + n] = bet;
                if (n == (dir == 0 ? 63 : 0)) Gs[dir] = c;
            }
        }
        __syncthreads();
        if (!(PREP_SKIP & 2)) {
            const int r = lane & 31, hh = lane >> 5, mi = (wave >> 1) & 1, mj = wave & 1;
            const LAS bf16_t* Xa = (wave < 4 ? Ks : Qs) + (32 * mi + r) * 136 + 8 * hh; const LAS bf16_t* Xb = Ks + (32 * mj + r) * 136 + 8 * hh;
            f32x16 acc;
#pragma unroll
            for (int i = 0; i < 16; ++i) acc[i] = 0.f;
#pragma unroll
            for (int ks = 0; ks < 8; ++ks) { const bf16x8 a = *(const LAS bf16x8*)(Xa + 16 * ks), b = *(const LAS bf16x8*)(Xb + 16 * ks); acc = MFMA32(a, b, acc); }
            LAS float* dst = (wave < 4 ? KKs : QKs) + 32 * mj + r;
#pragma unroll
            for (int reg = 0; reg < 16; ++reg) dst[(32 * mi + crow(reg, hh)) * 65] = acc[reg];
#pragma unroll 1
            for (int e = 0; e < 6; ++e) {
                const int idx = tid + 512 * e, f = idx >> 6, l = idx & 63, fr_ = l & 31, fh = l >> 5; u32x4 w; int seg, ff;
                if (f < 32) { ff = f & 15; seg = f < 16 ? 1 : 0; const int mt = ff >> 3, t = (ff >> 1) & 3, s2 = ff & 1;
                    const LAS bf16_t* src = (f < 16 ? Ks : Qs) + (32 * mt + fr_) * 136 + 32 * t + 16 * s2 + 4 * fh;
                    const u32x2 lo = *(const LAS u32x2*)src, hi = *(const LAS u32x2*)(src + 8); w.x = lo.x; w.y = lo.y; w.z = hi.x; w.w = hi.y; }
                else { ff = f - 32; seg = 2; const int t = ff >> 2, mt = (ff >> 1) & 1, s2 = ff & 1; unsigned short v8[8];
#pragma unroll
                    for (int j = 0; j < 8; ++j) v8[j] = Ks[(32 * mt + kperm(s2, fh, j)) * 136 + 32 * t + fr_];
                    w.x = v8[0] | ((unsigned)v8[1] << 16); w.y = v8[2] | ((unsigned)v8[3] << 16); w.z = v8[4] | ((unsigned)v8[5] << 16); w.w = v8[6] | ((unsigned)v8[7] << 16); }
                *(u32x4*)((unsigned char*)QKV + dn_frag_off(q, h, seg, ff, l)) = w;
            }
            { const int blk = wave, dvq = blk >> 1, mt = blk & 1, c = lane & 31; unsigned short v16[16];
#pragma unroll
                for (int reg = 0; reg < 16; ++reg) v16[reg] = Vs[(32 * mt + crow(reg, hh)) * 136 + 32 * dvq + c];
                u32x4 w0, w1; w0.x = v16[0] | ((unsigned)v16[1] << 16); w0.y = v16[2] | ((unsigned)v16[3] << 16); w0.z = v16[4] | ((unsigned)v16[5] << 16); w0.w = v16[6] | ((unsigned)v16[7] << 16);
                w1.x = v16[8] | ((unsigned)v16[9] << 16); w1.y = v16[10] | ((unsigned)v16[11] << 16); w1.z = v16[12] | ((unsigned)v16[13] << 16); w1.w = v16[14] | ((unsigned)v16[15] << 16);
                u32x4* vp = (u32x4*)(ws + WS_VC + ((size_t)(it * 4 + dvq) * 2 + mt) * 2048 + lane * 32); vp[0] = w0; vp[1] = w1; }
        }
        __syncthreads();
        if (!(PREP_SKIP & 4)) {
#pragma unroll 2
            for (int e = 0; e < 16; ++e) { const int idx = tid + 512 * e, dir = idx >> 12, ip = (idx >> 6) & 63, jp = idx & 63, n = dir ? 63 - ip : ip, m = dir ? 63 - jp : jp;
                Ap[idx] = jp < ip ? betab[dir * 64 + n] * KKs[n * 65 + m] * fexp_(gcb[dir * 64 + n] - gcb[dir * 64 + m]) : 0.f; }
#pragma unroll 1
            for (int e = 0; e < 2; ++e) { const int idx = tid + 512 * e; if (idx < 768) { const int dir = idx / 384, rem = idx % 384, fb = rem >> 6, l = rem & 63, blk = fb >> 1, s2 = fb & 1, fr_ = l & 31, fh = l >> 5;
                const int mi = blk == 0 ? 0 : (blk == 1 ? 1 : (dir == 0 ? 1 : 0)), mj = blk == 0 ? 0 : (blk == 1 ? 1 : (dir == 0 ? 0 : 1));
                const int n = 32 * mi + fr_; float pv[8];
#pragma unroll
                for (int j = 0; j < 8; ++j) { const int m = 32 * mj + kperm(s2, fh, j); const bool ok = dir == 0 ? (m <= n) : (m >= n);
                    pv[j] = ok ? QKs[n * 65 + m] * fexp_(gcb[dir * 64 + n] - gcb[dir * 64 + m]) : 0.f; }
                u32x4 w; w.x = pk2(pv[0], pv[1]); w.y = pk2(pv[2], pv[3]); w.z = pk2(pv[4], pv[5]); w.w = pk2(pv[6], pv[7]);
                *(u32x4*)(ws + WS_P + ((size_t)(it * 2 + dir) * 6 + fb) * 1024 + l * 16) = w; } }
            if (tid < 128) { const int dir = tid >> 6, n = tid & 63; float* rec = (float*)(ws + WS_GC + (size_t)(it * 2 + dir) * 1024);
                rec[n] = gcb[dir * 64 + n]; rec[64 + n] = betab[dir * 64 + n]; if (n == 0) rec[128] = Gs[dir]; }
        }
        __syncthreads();
        if (!(PREP_SKIP & 8) && wave < 2) {
            const LAS float* Arow = Ap + wave * 4096; float Tc[64];
#pragma unroll
            for (int i = 0; i < 64; ++i) {
                f32x4 av = {(i == lane) ? 1.f : 0.f, 0.f, 0.f, 0.f};
#pragma unroll
                for (int j4 = 0; j4 < (i + 3) / 4; ++j4) { const f32x4 a = *(const LAS f32x4*)(Arow + i * 64 + 4 * j4);
                    av[0] -= a[0] * Tc[4 * j4]; if (4 * j4 + 1 < i) av[1] -= a[1] * Tc[4 * j4 + 1]; if (4 * j4 + 2 < i) av[2] -= a[2] * Tc[4 * j4 + 2]; if (4 * j4 + 3 < i) av[3] -= a[3] * Tc[4 * j4 + 3]; }
                Tc[i] = (av[0] + av[1]) + (av[2] + av[3]);
            }
            const int m = wave ? 63 - lane : lane;
#pragma unroll
            for (int i = 0; i < 64; ++i) { const int n = wave ? 63 - i : i; Ts[(wave * 64 + n) * 72 + m] = (bf16_t)f2bf(Tc[i]); }
        }
        __syncthreads();
        {
#pragma unroll 1
            for (int e = 0; e < 2; ++e) { const int idx = tid + 512 * e; if (idx < 768) { const int dir = idx / 384, rem = idx % 384, fb = rem >> 6, l = rem & 63, blk = fb >> 1, s2 = fb & 1, fr_ = l & 31, fh = l >> 5;
                const int mi = blk == 0 ? 0 : (blk == 1 ? 1 : (dir == 0 ? 1 : 0)), mj = blk == 0 ? 0 : (blk == 1 ? 1 : (dir == 0 ? 0 : 1));
                const LAS bf16_t* src = Ts + (dir * 64 + 32 * mi + fr_) * 72 + 32 * mj + 16 * s2 + 4 * fh;
                const u32x2 lo = *(const LAS u32x2*)src, hi = *(const LAS u32x2*)(src + 8); u32x4 w; w.x = lo.x; w.y = lo.y; w.z = hi.x; w.w = hi.y;
                *(u32x4*)(ws + WS_T + ((size_t)(it * 2 + dir) * 6 + fb) * 1024 + l * 16) = w; } }
        }
        __syncthreads();
    }
}

constexpr int CH_BUF = 62464;
template <int VAR> __device__ __forceinline__ void p_dn_chain(const Frame& F, const unsigned char* ws, bf16_t* O) {
    const int lane = F.lane, wave = F.wave, hh = lane >> 5;
    for (int item = blockIdx.x; item < 64; item += F.G) {
        const int b = item >> 4, h = (item >> 1) & 7, dir = item & 1, dvq = wave & 3;
        f32x16 S[4];
#pragma unroll
        for (int t = 0; t < 4; ++t)
#pragma unroll
            for (int i = 0; i < 16; ++i) S[t][i] = 0.f;
        u32x4 Vn_[2][2], Vc_[2][2];
#define CH_Q(n) ((n) < 4 ? 256 + 4 * b + (dir ? 3 - (n) : (n)) : 64 * b + (dir ? 63 - ((n) - 4) : (n) - 4))
#define CH_ISSUE(n, bufi) do { const int q_ = CH_Q(n); const size_t it2_ = (size_t)(q_ * 8 + h) * 2 + dir; \
            for (int f = wave; f < 61; f += 8) { const unsigned char* srcu_; unsigned lo_; \
                if (f < 48) { const int seg_ = f < 16 ? 1 : (f < 32 ? 0 : 2); srcu_ = ws + WS_QKV + ((size_t)(64 * q_ + 4 * (f & 15)) * 3072 + seg_ * 1024 + h * 128) * 2; lo_ = lane_qkv; } \
                else if (f < 54) { srcu_ = ws + WS_T + (it2_ * 6 + (f - 48)) * 1024; lo_ = lane16; } \
                else if (f < 60) { srcu_ = ws + WS_P + (it2_ * 6 + (f - 54)) * 1024; lo_ = lane16; } \
                else { srcu_ = ws + WS_GC + it2_ * 1024; lo_ = lane16; } \
                __builtin_amdgcn_global_load_lds((const unsigned*)(srcu_ + lo_), (LAS unsigned*)(F.lds + (bufi) * CH_BUF + f * 1024), 16, 0, 0); } \
            if (wave < 4) { const unsigned char* vu_ = ws + WS_VC + ((size_t)((q_ * 8 + h) * 4 + dvq) * 2) * 2048; \
                Vn_[0][0] = *(const u32x4*)(vu_ + lane32); Vn_[0][1] = *(const u32x4*)(vu_ + lane32 + 16); Vn_[1][0] = *(const u32x4*)(vu_ + lane32 + 2048); Vn_[1][1] = *(const u32x4*)(vu_ + lane32 + 2064); } } while (0)
        const unsigned lane_qkv = (unsigned)((lane >> 4) * 6144 + (lane & 15) * 16), lane16 = (unsigned)lane * 16u, lane32 = (unsigned)lane * 32u;
        CH_ISSUE(0, 0);
        for (int n = 0; n < 68; ++n) {
            const int buf = n & 1;
            asm volatile("s_waitcnt vmcnt(0)" ::: "memory");
            __syncthreads();
            Vc_[0][0] = Vn_[0][0]; Vc_[0][1] = Vn_[0][1]; Vc_[1][0] = Vn_[1][0]; Vc_[1][1] = Vn_[1][1];
            if (n + 1 < 68 && !(VAR & 2)) CH_ISSUE(n + 1, buf ^ 1);
            if (wave < 4 && !(VAR & 4)) {
                const LAS unsigned char* B = F.lds + buf * CH_BUF;
#define CH_FRAG(f) (*(const LAS bf16x8*)(B + (f) * 1024 + lane * 16))
#define CH_EA(i) ((((((i) >> 2) & 1) * 4 + ((i) >> 3)) * 2 + (((i) >> 1) & 1)) + (((i) & 1) ? 16 : 0))
#define CH_E(i) ((i) < 32 ? CH_EA(i) : ((i) < 44 ? 48 + ((i) - 32) : 32 + ((i) - 44)))
#define CH_LD(i) do { if ((i) < 60) ring[(i) % 4] = CH_FRAG(CH_E(i)); } while (0)
                bf16x8 ring[4];
#pragma unroll
                for (int i = 0; i < 4; ++i) CH_LD(i);
                const LAS float* gcp = (const LAS float*)(B + 60 * 1024); const float G = gcp[128];
                f32x16 KS[2], QS[2];
#pragma unroll
                for (int mt = 0; mt < 2; ++mt)
#pragma unroll
                    for (int i = 0; i < 16; ++i) { KS[mt][i] = 0.f; QS[mt][i] = 0.f; }
#pragma unroll
                for (int t = 0; t < 4; ++t) {
                    bf16x8 Sb[2]; Sb[0] = pack8(S[t], 0); Sb[1] = pack8(S[t], 1);
#pragma unroll
                    for (int k = 0; k < 8; ++k) { const int i = 8 * t + k, mt = (k >> 2) & 1, s = (k >> 1) & 1;
                        if (k & 1) QS[mt] = MFMA32(ring[i % 4], Sb[s], QS[mt]); else KS[mt] = MFMA32(ring[i % 4], Sb[s], KS[mt]);
                        CH_LD(i + 4); __builtin_amdgcn_sched_barrier(0); }
                }
#pragma unroll
                for (int mt = 0; mt < 2; ++mt)
#pragma unroll
                    for (int g4 = 0; g4 < 4; ++g4) { const f32x4 gv = *(const LAS f32x4*)(gcp + 32 * mt + 8 * g4 + 4 * hh), bv = *(const LAS f32x4*)(gcp + 64 + 32 * mt + 8 * g4 + 4 * hh);
                        const unsigned w0 = Vc_[mt][g4 >> 1][(g4 & 1) * 2], w1 = Vc_[mt][g4 >> 1][(g4 & 1) * 2 + 1]; const float vv[4] = {bflo(w0), bfhi(w0), bflo(w1), bfhi(w1)};
#pragma unroll
                        for (int i = 0; i < 4; ++i) { const float eg = fexp_(gv[i]); KS[mt][4 * g4 + i] = bv[i] * (vv[i] - eg * KS[mt][4 * g4 + i]); QS[mt][4 * g4 + i] *= eg; } }
                f32x16 VN[2];
#pragma unroll
                for (int mt = 0; mt < 2; ++mt)
#pragma unroll
                    for (int i = 0; i < 16; ++i) VN[mt][i] = 0.f;
                {
                    bf16x8 Rb[2][2];
#pragma unroll
                    for (int mt = 0; mt < 2; ++mt) { Rb[mt][0] = pack8(KS[mt], 0); Rb[mt][1] = pack8(KS[mt], 1); }
#pragma unroll
                    for (int i = 32; i < 38; ++i) { const int blk = (i - 32) >> 1, s = (i - 32) & 1;
                        if (blk == 0) VN[0] = MFMA32(ring[i % 4], Rb[0][s], VN[0]);
                        else if (blk == 1) VN[1] = MFMA32(ring[i % 4], Rb[1][s], VN[1]);
                        else { if (dir == 0) VN[1] = MFMA32(ring[i % 4], Rb[0][s], VN[1]); else VN[0] = MFMA32(ring[i % 4], Rb[1][s], VN[0]); }
                        CH_LD(i + 4); __builtin_amdgcn_sched_barrier(0); }
                }
                {
                    bf16x8 Vb[2][2];
#pragma unroll
                    for (int mt = 0; mt < 2; ++mt) { Vb[mt][0] = pack8(VN[mt], 0); Vb[mt][1] = pack8(VN[mt], 1); }
#pragma unroll
                    for (int i = 38; i < 44; ++i) { const int blk = (i - 38) >> 1, s = (i - 38) & 1;
                        if (blk == 0) QS[0] = MFMA32(ring[i % 4], Vb[0][s], QS[0]);
                        else if (blk == 1) QS[1] = MFMA32(ring[i % 4], Vb[1][s], QS[1]);
                        else { if (dir == 0) QS[1] = MFMA32(ring[i % 4], Vb[0][s], QS[1]); else QS[0] = MFMA32(ring[i % 4], Vb[1][s], QS[0]); }
                        CH_LD(i + 4); __builtin_amdgcn_sched_barrier(0); }
                }
                bf16x8 Wb[2][2];
#pragma unroll
                for (int mt = 0; mt < 2; ++mt) {
#pragma unroll
                    for (int g4 = 0; g4 < 4; ++g4) { const f32x4 gv = *(const LAS f32x4*)(gcp + 32 * mt + 8 * g4 + 4 * hh);
#pragma unroll
                        for (int i = 0; i < 4; ++i) VN[mt][4 * g4 + i] *= fexp_(G - gv[i]); }
                    Wb[mt][0] = pack8(VN[mt], 0); Wb[mt][1] = pack8(VN[mt], 1); }
                {
                    const float eG = fexp_(G);
#pragma unroll
                    for (int t = 0; t < 4; ++t)
#pragma unroll
                        for (int i = 0; i < 16; ++i) S[t][i] *= eG;
#pragma unroll
                    for (int i = 44; i < 60; ++i) { const int j = i - 44, t = j >> 2, mt = (j >> 1) & 1, s = j & 1;
                        S[t] = MFMA32(ring[i % 4], Wb[mt][s], S[t]);
                        CH_LD(i + 4); __builtin_amdgcn_sched_barrier(0); }
                }
                if (n >= 4 && !(VAR & 1)) {
                    LAS bf16_t* ot = (LAS bf16_t*)(F.lds + 2 * CH_BUF + wave * 4096);
#pragma unroll
                    for (int mt = 0; mt < 2; ++mt)
#pragma unroll
                        for (int reg = 0; reg < 16; ++reg) ot[(32 * mt + crow(reg, hh)) * 32 + (lane & 31)] = (bf16_t)f2bf(QS[mt][reg]);
                    LDS_WAIT();
                    const int c = dir ? 63 - (n - 4) : n - 4; unsigned char* obu = (unsigned char*)(O + (size_t)dir * ML * D + ((size_t)b * SEQ + c) * D + h * 128 + dvq * 32);
                    const unsigned olane = (unsigned)((lane & 3) * 16 + (lane >> 2) * (64 * D * 2));
#pragma unroll
                    for (int k = 0; k < 4; ++k) { const int tok = (lane >> 2) + 16 * k; const u32x4 w = *(const LAS u32x4*)(ot + tok * 32 + (lane & 3) * 8); *(u32x4*)(obu + olane + (unsigned)k * (16u * 64u * D * 2u)) = w; }
                }
#undef CH_LD
#undef CH_E
#undef CH_EA
#undef CH_FRAG
            }
        }
#undef CH_ISSUE
#undef CH_Q
        asm volatile("s_waitcnt vmcnt(0)" ::: "memory");
        __syncthreads();
    }
}
__device__ __forceinline__ void p_dn_ro(const Frame& F, const bf16_t* O, const bf16_t* Z, const float* gn, bf16_t* RO) {
    const int gw = F.vcu * NWAVES + F.wave, NGW = F.G * NWAVES;
    for (int r = gw; r < ML; r += NGW) {
        const int s = r & (SEQ - 1), sr = (r & ~(SEQ - 1)) + ((s & 63) << 6) + (s >> 6);
        const u32x4* of4 = (const u32x4*)(O + (size_t)r * D + F.lane * 16); const u32x4* ob4 = (const u32x4*)(O + (size_t)ML * D + (size_t)r * D + F.lane * 16);
        float v[16]; float ss = 0.f;
#pragma unroll
        for (int j = 0; j < 2; ++j) { const u32x4 a = of4[j], b = ob4[j];
            v[8 * j + 0] = bflo(a.x) + bflo(b.x); v[8 * j + 1] = bfhi(a.x) + bfhi(b.x); v[8 * j + 2] = bflo(a.y) + bflo(b.y); v[8 * j + 3] = bfhi(a.y) + bfhi(b.y);
            v[8 * j + 4] = bflo(a.z) + bflo(b.z); v[8 * j + 5] = bfhi(a.z) + bfhi(b.z); v[8 * j + 6] = bflo(a.w) + bflo(b.w); v[8 * j + 7] = bfhi(a.w) + bfhi(b.w); }
#pragma unroll
        for (int i = 0; i < 16; ++i) ss += v[i] * v[i];
        ss += __shfl_xor(ss, 1); ss += __shfl_xor(ss, 2); ss += __shfl_xor(ss, 4);
        const float rstd = 1.0f / sqrtf(ss * (1.0f / 128.0f) + EPS);
        const u32x4* z4 = (const u32x4*)(Z + (size_t)sr * D + F.lane * 16);
        const float* g1 = gn + (F.lane & 7) * 16;
        u32x4 ov[2];
#pragma unroll
        for (int hh = 0; hh < 2; ++hh) { const u32x4 zw = z4[hh]; const float* vv = v + 8 * hh; const float* gg = g1 + 8 * hh;
            ov[hh].x = pk2(vv[0] * rstd * gg[0] * siluf_(bflo(zw.x)), vv[1] * rstd * gg[1] * siluf_(bfhi(zw.x))); ov[hh].y = pk2(vv[2] * rstd * gg[2] * siluf_(bflo(zw.y)), vv[3] * rstd * gg[3] * siluf_(bfhi(zw.y)));
            ov[hh].z = pk2(vv[4] * rstd * gg[4] * siluf_(bflo(zw.z)), vv[5] * rstd * gg[5] * siluf_(bfhi(zw.z))); ov[hh].w = pk2(vv[6] * rstd * gg[6] * siluf_(bflo(zw.w)), vv[7] * rstd * gg[7] * siluf_(bfhi(zw.w))); }
        u32x4* op = (u32x4*)(RO + (size_t)r * D + F.lane * 16); op[0] = ov[0]; op[1] = ov[1];
    }
}

constexpr int N_PHASES = 27;
__global__ void __launch_bounds__(NWAVES * 64, 2) trunk_fwd(Args args) {
    extern __shared__ __attribute__((aligned(16))) unsigned char lds_raw[];
    Frame F;
    F.lds = (LAS unsigned char*)lds_raw;
    F.tid = threadIdx.x; F.lane = F.tid & 63; F.wave = __builtin_amdgcn_readfirstlane(F.tid >> 6);
    F.G = gridDim.x; { const int bx = blockIdx.x; F.vcu = (F.G % 8 == 0) ? (bx % 8) * (F.G / 8) + bx / 8 : bx; }
    unsigned char* ws = args.ws;
    unsigned* ctl = (unsigned*)(ws + WS_CTL);
    for (int u = F.tid; u < (LDS_BYTES - LDSCTL_OFF) / 4; u += NWAVES * 64) ((LAS unsigned*)(F.lds + LDSCTL_OFF))[u] = 0u;
    __syncthreads();
    XcdBarrier bar; bar.bar = ctl + CW_BAR; bar.x = 0; bar.st = nullptr;
    if (!MK_PER_PHASE) bar = xcd_barrier_post(ctl + CW_BAR, (volatile LAS unsigned*)(F.lds + MISC_OFF) + 8);
    const int lo = args.ph_lo, hi = args.ph_hi;
#ifndef MK_PHMASK
#define MK_PHMASK 0xffffffffu
#endif
#define IN(k) ((((unsigned)MK_PHMASK >> (k)) & 1u) && lo <= (k) && (k) < hi)
#ifndef MK_REPMASK
#define MK_REPMASK 0u
#endif
#define REP(k) ((((unsigned)MK_REPMASK >> (k)) & 1u) ? 2 : 1)
#ifndef MK_BARREP
#define MK_BARREP 1
#endif
#define SEAM(k) do { if (IN(k) && IN((k) + 1)) { for (int br_ = 0; br_ < MK_BARREP; ++br_) xcd_barrier(bar); } } while (0)

    float* MOD = (float*)(ws + WS_MOD);
    float* XL = args.out; float* XC = (float*)(ws + WS_XC);
    bf16_t* XN = (bf16_t*)(ws + WS_XN); bf16_t* HB = (bf16_t*)(ws + WS_H);
    const float* g_sub = args.in[6];
    const int bid = (int)blockIdx.x;

#define PH_FFN1(k, w, MROWS) if (IN(k)) { pg8::Gemm g{XN, (const bf16_t*)(ws + WS_W1 + (((w) + 1) & 3) * W1_SZ), MROWS, 2 * DFF, D, D, 0, D}; pg8::StaticOrder S; S.init(MROWS, 2 * DFF, F.G, bid, REP(k)); \
        pg8::EpiSwiglu E{HB}; pg8::gemm_phase<pg8::EpiSwiglu, pg8::StaticOrder>(F.lds, g, S, E); } SEAM(k);
#define PH_FFN2(k, w, MROWS, BL, BC, GATE) if (IN(k)) { pg8::Gemm g{HB, (const bf16_t*)(ws + WS_W2 + (w) * W2_SZ), MROWS, D, DFF, DFF, 0, DFF}; pg8::ResidOrder S; S.init(MROWS, DFF, F.G, bid, REP(k)); \
        pg8::EpiResid E{BL, BC, XL, XC, GATE, 0.5f, (float*)(ws + WS_PART)}; pg8::gemm_phase<pg8::EpiResid, pg8::ResidOrder>(F.lds, g, S, E); } SEAM(k);
#define PH_NORM(k, SRCL, SRCC, NROWS, l, sub, NPARTS) if (IN(k)) { for (int rp = 0; rp < REP(k); ++rp) p_norm(F, SRCL, SRCC, NROWS, g_sub + ((l) * 3 + (sub)) * D, MOD + (size_t)(l) * MODL + (sub) * 3 * D, XN, (const float*)(ws + WS_PART), rp ? 0 : (NPARTS), XC); } SEAM(k);

    if (IN(0)) { p_prologue(F, args, REP(0)); } SEAM(0);
    PH_NORM(1, args.in[0], args.in[2], MT, 0, 0, 0)
    PH_FFN1(2, 0, MT)
    PH_FFN2(3, 0, MT, args.in[0], args.in[2], MOD + 0 * MODL + 2 * D)
    PH_NORM(4, XL, args.in[2], MT, 0, 1, 11)
    if (IN(5)) { pg8::Gemm g{XN, (const bf16_t*)(ws + WS_WLIN), MT, 2048, D, D, 0, D}; pg8::StaticOrder S; S.init(MT, 2048, F.G, bid, REP(5));
        pg8::EpiBf16 E{(bf16_t*)(ws + WS_Y), D, D, (size_t)(WS_UP - WS_Y) / 2}; pg8::gemm_phase<pg8::EpiBf16, pg8::StaticOrder>(F.lds, g, S, E); } SEAM(5);
    if (IN(6)) { for (int rp = 0; rp < REP(6); ++rp) p_lru_conv(F, (const bf16_t*)(ws + WS_UP), args.in[10], args.in[11], (bf16_t*)(ws + WS_U)); } SEAM(6);
    if (IN(7)) { pg8::Gemm g{(const bf16_t*)(ws + WS_U), (const bf16_t*)(ws + WS_WLG), MT, 4096, 256, D, 4, 256}; pg8::StaticOrder S; S.init(MT, 4096, F.G, bid, REP(7));
        pg8::EpiGates<0> E{(const bf16_t*)(ws + WS_U), (const bf16_t*)(ws + WS_Y), XN, args.in[13], (const float*)(ws + WS_SP8), (float*)(ws + WS_AGGA), (float*)(ws + WS_AGGB), (const float*)(ws + WS_CARRY)};
        pg8::gemm_phase<pg8::EpiGates<0>, pg8::StaticOrder>(F.lds, g, S, E); } SEAM(7);
    if (IN(8)) { for (int rp = 0; rp < REP(8); ++rp) p_lru_carry(F, (const float*)(ws + WS_AGGA), (const float*)(ws + WS_AGGB), (float*)(ws + WS_CARRY)); } SEAM(8);
    if (IN(9)) { pg8::Gemm g{(const bf16_t*)(ws + WS_U), (const bf16_t*)(ws + WS_WLG), MT, 4096, 256, D, 4, 256}; pg8::StaticOrder S; S.init(MT, 4096, F.G, bid, REP(9));
        pg8::EpiGates<1> E{(const bf16_t*)(ws + WS_U), (const bf16_t*)(ws + WS_Y), XN, args.in[13], (const float*)(ws + WS_SP8), (float*)(ws + WS_AGGA), (float*)(ws + WS_AGGB), (const float*)(ws + WS_CARRY)};
        pg8::gemm_phase<pg8::EpiGates<1>, pg8::StaticOrder>(F.lds, g, S, E); } SEAM(9);
    if (IN(10)) { pg8::Gemm g{XN, (const bf16_t*)(ws + WS_WLO), MT, D, D, D, 0, D}; pg8::ResidOrder S; S.init(MT, D, F.G, bid, REP(10));
        pg8::EpiResid E{XL, XC, XL, XC, MOD + 0 * MODL + 5 * D, 1.0f, (float*)(ws + WS_PART)}; pg8::gemm_phase<pg8::EpiResid, pg8::ResidOrder>(F.lds, g, S, E); } SEAM(10);
    PH_NORM(11, XL, XC, MT, 0, 2, 4)
    PH_FFN1(12, 1, MT)
    PH_FFN2(13, 1, MT, XL, XC, MOD + 0 * MODL + 8 * D)
    PH_NORM(14, XL, XC, MT, 1, 0, 11)
    PH_FFN1(15, 2, MT)
    PH_FFN2(16, 2, MT, XL, XC, MOD + 1 * MODL + 2 * D)
    PH_NORM(17, XL, XC, MT, 1, 1, 11)
    if (IN(18)) { pg8::Gemm g{XN, (const bf16_t*)(ws + WS_WDIN), MT, DNPP, D, D, 0, D}; pg8::StaticOrder S; S.init(MT, DNPP, F.G, bid, REP(18));
        pg8::EpiDnIn E{(bf16_t*)(ws + WS_QKV), (bf16_t*)(ws + WS_Z), (float*)(ws + WS_AB), (bf16_t*)(ws + WS_HALO)}; pg8::gemm_phase<pg8::EpiDnIn, pg8::StaticOrder>(F.lds, g, S, E); } SEAM(18);
    if (IN(19)) { p_dn_prep(F, ws, args.in[17], args.in[18], args.in[19]); } SEAM(19);
    #ifndef MK_CHVAR
#define MK_CHVAR 0
#endif
    if (IN(20)) { p_dn_chain<0>(F, ws, (bf16_t*)(ws + WS_O)); if (REP(20) > 1) p_dn_chain<MK_CHVAR>(F, ws, (bf16_t*)(ws + WS_O)); } SEAM(20);
    if (IN(21)) { for (int rp = 0; rp < REP(21); ++rp) p_dn_ro(F, (const bf16_t*)(ws + WS_O), (const bf16_t*)(ws + WS_Z), args.in[20], (bf16_t*)(ws + WS_RO2)); } SEAM(21);
    if (IN(22)) { pg8::Gemm g{(const bf16_t*)(ws + WS_RO2), (const bf16_t*)(ws + WS_WDO), ML, D, D, D, 0, D}; pg8::StaticOrder S; S.init(ML, D, F.G, bid, REP(22));
        pg8::EpiResid E{XL, XC, XL, XC, MOD + 1 * MODL + 5 * D, 1.0f, (float*)(ws + WS_PART)}; pg8::gemm_phase<pg8::EpiResid, pg8::StaticOrder>(F.lds, g, S, E); } SEAM(22);
    PH_NORM(23, XL, XC, ML, 1, 2, 0)
    PH_FFN1(24, 3, ML)
    PH_FFN2(25, 3, ML, XL, XC, MOD + 1 * MODL + 8 * D)
    if (IN(26)) { p_final(F, XL, args.in[22]); }
#undef IN
#undef SEAM
#undef PH_FFN1
#undef PH_FFN2
#undef PH_NORM
}

extern "C" void kernel_launch(void* const* d_in, const int* in_sizes, int n_in, void* d_out, int out_size, void* d_ws, size_t ws_size, hipStream_t stream) {
    static int grid = 0;
    if (grid == 0) {
        if (n_in != 23 || in_sizes[0] != ML * D || out_size != ML * D || ws_size < WS_END) { fprintf(stderr, "kernel_launch: unexpected problem shape (n_in %d, in0 %d, out %d, ws %zu); nothing launched\n", n_in, n_in > 0 ? in_sizes[0] : -1, out_size, ws_size); grid = -1; return; }
        int dev = 0, cus = 0;
        if (hipGetDevice(&dev) != hipSuccess || hipDeviceGetAttribute(&cus, hipDeviceAttributeMultiprocessorCount, dev) != hipSuccess) { grid = -1; return; }
        if (hipFuncSetAttribute((const void*)trunk_fwd, hipFuncAttributeMaxDynamicSharedMemorySize, LDS_BYTES) != hipSuccess) { fprintf(stderr, "kernel_launch: hipFuncSetAttribute failed\n"); grid = -1; return; }
        (void)hipGetLastError();
        grid = cus;
    }
    if (grid < 0) return;
    if (hipMemsetAsync((char*)d_ws + WS_CTL, 0, CTL_ZERO_BYTES, stream) != hipSuccess) return;
    Args a{};
    for (int i = 0; i < 23; ++i) a.in[i] = (const float*)d_in[i];
    a.out = (float*)d_out; a.ws = (unsigned char*)d_ws;
#if MK_PER_PHASE
    for (int p = 0; p < N_PHASES; ++p) { a.ph_lo = p; a.ph_hi = p + 1; hipLaunchKernelGGL(trunk_fwd, dim3(grid), dim3(NWAVES * 64), LDS_BYTES, stream, a); }
#else
    a.ph_lo = 0; a.ph_hi = N_PHASES;
    hipLaunchKernelGGL(trunk_fwd, dim3(grid), dim3(NWAVES * 64), LDS_BYTES, stream, a);
#endif
}
```

```cpp
#include <hip/hip_runtime.h>
#include <cstdio>
#include <cstdint>

#ifndef MK_PER_PHASE
#define MK_PER_PHASE 0
#endif

#define LAS __attribute__((address_space(3)))
typedef unsigned short bf16_t;
typedef short bf16x8 __attribute__((ext_vector_type(8)));
typedef float f32x4 __attribute__((ext_vector_type(4)));
typedef float f32x2 __attribute__((ext_vector_type(2)));
typedef unsigned u32x4 __attribute__((ext_vector_type(4)));
typedef unsigned u32x2 __attribute__((ext_vector_type(2)));

constexpr int D = 1024, NB = 4, SEQ = 4096, CTXL = 256, DFF = 2816;
constexpr int ML = NB * SEQ, MC = NB * CTXL, MT = ML + MC;
constexpr int NQ = MT / 64;
constexpr int MODL = 5 * 9 * D;
constexpr int DNP = 4128, DNPP = 4352;
constexpr float EPS = 1e-6f;

constexpr size_t MiB = 1u << 20;
constexpr size_t WS_CTL = 0, CTL_ZERO_BYTES = 2 * MiB;
constexpr size_t WS_MOD = 1 * MiB;
constexpr size_t WS_W1 = 2 * MiB, W1_SZ = (size_t)2 * DFF * D * 2;
constexpr size_t WS_W2 = 46 * MiB, W2_SZ = (size_t)D * DFF * 2;
constexpr size_t WS_WLIN = 68 * MiB, WS_WLG = 72 * MiB, WS_WLO = 74 * MiB, WS_WDIN = 76 * MiB, WS_WDO = 85 * MiB;
constexpr size_t WS_SP8 = 84 * MiB + 768 * 1024;
constexpr size_t WS_XC = 87 * MiB;
constexpr size_t WS_XN = 91 * MiB;
constexpr size_t WS_H = 125 * MiB;
constexpr size_t WS_PART = 240 * MiB;
constexpr size_t WS_Y = 125 * MiB, WS_UP = 159 * MiB, WS_U = 193 * MiB, WS_AGGA = 227 * MiB, WS_AGGB = 230 * MiB, WS_CARRY = 233 * MiB;
constexpr size_t WS_Z = 13 * MiB;
constexpr size_t WS_GC = 48 * MiB;
constexpr size_t WS_HALO = 53 * MiB;
constexpr size_t WS_O = 91 * MiB;
constexpr size_t WS_QKV = 155 * MiB;
constexpr size_t WS_VC = 257 * MiB;
constexpr size_t WS_T = 291 * MiB, WS_P = 317 * MiB;
constexpr size_t WS_AB = 343 * MiB, WS_END = 346 * MiB;
constexpr size_t WS_RO2 = WS_QKV;
static_assert(WS_W1 + 4 * W1_SZ <= WS_W2 && WS_W2 + 4 * W2_SZ <= WS_WLIN && WS_WDIN + (size_t)DNPP * D * 2 <= WS_WDO, "weights map");
static_assert(WS_XN + (size_t)MT * D * 2 <= WS_H && WS_H + (size_t)MT * DFF * 2 <= WS_AGGA, "activation map");
static_assert(WS_Z >= WS_W1 + W1_SZ && WS_Z + (size_t)MT * D * 2 <= WS_GC && WS_GC + (size_t)4352 * 1024 <= WS_HALO && WS_HALO + (size_t)NQ * 3 * 3072 * 2 <= WS_W2 + 3 * W2_SZ, "DeltaNet records over dead weights");
static_assert(WS_O + (size_t)2 * ML * D * 2 <= WS_QKV && WS_QKV + (size_t)MT * 3072 * 2 <= WS_VC && WS_VC + (size_t)2176 * 16384 <= WS_T && WS_T + (size_t)4352 * 6144 <= WS_P && WS_P + (size_t)4352 * 6144 <= WS_AB && WS_AB + (size_t)MT * 32 * 4 <= WS_END, "DeltaNet map");
constexpr int CW_BAR = 4096;

constexpr int RING_BYTES = 131072, LDS_BYTES = 147456, LDSCTL_OFF = LDS_BYTES - 1024, MISC_OFF = LDSCTL_OFF + 320;
constexpr int NWAVES = 8;

#define RLX_AGENT __ATOMIC_RELAXED, __HIP_MEMORY_SCOPE_AGENT
#define LDS_WAIT() asm volatile("s_waitcnt lgkmcnt(0)" ::: "memory")
__device__ __forceinline__ unsigned f2bf(float f) { unsigned u = __builtin_bit_cast(unsigned, f); return (u + 0x7fffu + ((u >> 16) & 1u)) >> 16; }
__device__ __forceinline__ unsigned pk2(float lo, float hi) { return f2bf(lo) | (f2bf(hi) << 16); }
__device__ __forceinline__ float bflo(unsigned w) { return __builtin_bit_cast(float, w << 16); }
__device__ __forceinline__ float bfhi(unsigned w) { return __builtin_bit_cast(float, w & 0xffff0000u); }
__device__ __forceinline__ float sigmoidf_(float x) { return 1.0f / (1.0f + expf(-x)); }
__device__ __forceinline__ float siluf_(float x) { return x / (1.0f + expf(-x)); }
__device__ __forceinline__ float softplusf_(float x) { return fmaxf(x, 0.f) + log1pf(expf(-fabsf(x))); }
__device__ __forceinline__ float fexp_(float x) { return __builtin_amdgcn_exp2f(x * 1.4426950408889634f); }
__device__ __forceinline__ float fsigmoid_(float x) { return __builtin_amdgcn_rcpf(1.0f + fexp_(-x)); }
__device__ __forceinline__ float fgelu_tanh(float x) { const float z = 0.7978845608028654f * (x + 0.044715f * x * x * x); const float t = 1.0f - 2.0f * __builtin_amdgcn_rcpf(1.0f + fexp_(2.0f * z)); return 0.5f * x * (1.0f + t); }
__device__ __forceinline__ float gelu_tanh(float x) { const float t = tanhf(0.7978845608028654f * (x + 0.044715f * x * x * x)); return 0.5f * x * (1.0f + t); }
template <int CTRL> __device__ __forceinline__ float dpp_keep(float v, float keep) { return __builtin_bit_cast(float, __builtin_amdgcn_update_dpp(__builtin_bit_cast(int, keep), __builtin_bit_cast(int, v), CTRL, 0xf, 0xf, false)); }
__device__ __forceinline__ float wave_sum(float v) {
#pragma unroll
    for (int o = 1; o < 64; o <<= 1) v += __shfl_xor(v, o);
    return v;
}

namespace pg8 {
constexpr int BM = 256, BK = 64, HALF = 128, HTB = HALF * BK * 2, STAGE_BYTES = 8 * HTB, NXCD = 8, WGM = 8;
__host__ __device__ __forceinline__ int lds_byte(int r, int c) { const int st = (r >> 4) * 2 + (c >> 5), rr = r & 15, cc = c & 31, ob = rr * 64 + cc * 2; return st * 1024 + (ob ^ (((ob >> 9) & 1) << 5)); }
__host__ __device__ __forceinline__ void stage_rc(int b, int& R, int& C) { const int st = b / 1024, sb = b % 1024, swz = sb ^ (((sb >> 9) & 1) << 5); R = (st >> 1) * 16 + swz / 64; C = (st & 1) * 32 + (swz % 64) / 2; }
__host__ __device__ __forceinline__ int perm32(int rho) { const int n = rho >> 4, i = rho & 15; return 8 * (i >> 2) + 4 * n + (i & 3); }

struct Unit { int pm, pn, r, kb, nt, at; };
struct Gemm { const bf16_t* A; const bf16_t* Bt; int M, N, K, lda, hdiv, ldb; };

struct StaticOrder {
    int nM, nN, nwg, G, c, rep;
    __host__ __device__ void init(int M, int N, int G_, int c_, int rep_ = 1) { nM = M / BM; nN = N / BM; nwg = nM * nN; G = G_; c = c_; rep = rep_; }
    __host__ __device__ bool next(int i, Unit& u) const {
        const int nc = c < nwg ? (nwg - c + G - 1) / G : 0;
        if (i >= nc * rep) return false;
        u.r = i / nc; u.kb = 0; u.nt = 0; u.at = 0; const long L = (long)(i % nc) * G + c;
        int wgid = (int)L; { const int q = nwg / NXCD, r = nwg % NXCD, xcd = wgid % NXCD, off = wgid / NXCD; wgid = (xcd < r ? xcd * (q + 1) : r * (q + 1) + (xcd - r) * q) + off; }
        const int nig = WGM * nN, gid = wgid / nig, fm = gid * WGM, gsz = (nM - fm) < WGM ? (nM - fm) : WGM;
        u.pm = fm + ((wgid % nig) % gsz); u.pn = (wgid % nig) / gsz; return true;
    }
    __device__ __forceinline__ void a_ready(const Unit&) const {}
    __device__ __forceinline__ void done(const Unit&) const {}
};

struct ResidOrder {
    int nlat, nsub, sk, G, c, rep;
    __host__ __device__ void init(int M, int K, int G_, int c_, int rep_ = 1) { nlat = (ML / BM) * (D / BM); sk = K / 256; nsub = M > ML ? 16 * sk : 0; G = G_; c = c_; rep = rep_; }
    __host__ __device__ bool next(int i, Unit& u) const {
        const int tot = nlat + nsub, nc = c < tot ? (tot - c + G - 1) / G : 0;
        if (i >= nc * rep) return false;
        const int L = (i % nc) * G + c;
        if (L < nlat) { int wgid = L; { const int q = nlat / NXCD, r = nlat % NXCD, xcd = wgid % NXCD, off = wgid / NXCD; wgid = (xcd < r ? xcd * (q + 1) : r * (q + 1) + (xcd - r) * q) + off; }
            const int nM = ML / BM, nN = D / BM, nig = WGM * nN, gid = wgid / nig, fm = gid * WGM, gsz = (nM - fm) < WGM ? (nM - fm) : WGM;
            u.pm = fm + ((wgid % nig) % gsz); u.pn = (wgid % nig) / gsz; u.r = i / nc; u.kb = 0; u.nt = 0; u.at = 0; return true; }
        const int j = L - nlat, tile = j / sk, sl = j % sk;
        u.pm = ML / BM + (tile >> 2); u.pn = tile & 3; u.r = i / nc; u.kb = sl * 256; u.nt = 4; u.at = 1; return true;
    }
    __device__ __forceinline__ void a_ready(const Unit&) const {}
    __device__ __forceinline__ void done(const Unit&) const {}
};

__device__ __forceinline__ unsigned cvt_pk_bf16(float lo, float hi) { unsigned r; asm volatile("v_cvt_pk_bf16_f32 %0, %1, %2" : "=v"(r) : "v"(lo), "v"(hi)); return r; }

template <class Epi, class Sched, bool ALIGN_EPI = true, bool SP2 = true>
__device__ __forceinline__ void gemm_phase(LAS unsigned char* lds, const Gemm g, const Sched& S, const Epi& E) {
    const int tid = threadIdx.x, wid = __builtin_amdgcn_readfirstlane(tid >> 6), lane = tid & 63, wr = wid >> 2, wc = wid & 3, fr = lane & 15, fq = lane >> 4;
    const int K = g.K, lda = g.lda, ldb = g.ldb;
    unsigned voffA[2], voffB[2];
#pragma unroll
    for (int i = 0; i < 2; ++i) { int R, C; stage_rc(tid * 16 + i * 8192, R, C); const int Rb = Epi::PERM ? ((R & ~31) + perm32(R & 31)) : R;
        voffA[i] = (unsigned)(R * lda + C) * 2u; voffB[i] = (unsigned)(Rb * ldb + C) * 2u; }
    const size_t kstep = (size_t)(BK * 2);
    const size_t hstepA = (size_t)HALF * lda * 2, hstepB = (size_t)HALF * ldb * 2;
    const size_t tstepA = 2 * hstepA, tstepB = 2 * hstepB;
    const unsigned ldsw = (unsigned)wid * 1024u;
    const int aoff = lds_byte(wr * 64 + fr, fq * 8), boff = lds_byte(wc * 32 + fr, fq * 8);
#define PG8_SA(b, h) (((b) * 2 + (h)) * HTB)
#define PG8_SB(b, h) ((4 + (b) * 2 + (h)) * HTB)
#define PG8_STAGE(bufoff, gbase, voff) do { _Pragma("unroll") for (int _i = 0; _i < 2; ++_i) \
        __builtin_amdgcn_global_load_lds((const unsigned*)((const char*)(gbase) + (voff)[_i]), (LAS unsigned*)(lds + (bufoff) + ldsw + _i * 8192), 16, 0, 0); } while (0)
#define PG8_LDA(dst, b, h) do { _Pragma("unroll") for (int m = 0; m < 4; ++m) _Pragma("unroll") for (int k = 0; k < 2; ++k) dst[m][k] = *(const LAS bf16x8*)(lds + PG8_SA(b, h) + aoff + m * 2048 + k * 1024); } while (0)
#define PG8_LDB(dst, b, h) do { _Pragma("unroll") for (int n = 0; n < 2; ++n) _Pragma("unroll") for (int k = 0; k < 2; ++k) dst[n][k] = *(const LAS bf16x8*)(lds + PG8_SB(b, h) + boff + n * 2048 + k * 1024); } while (0)
#define PG8_MMA(ai, bj, At, Bt) do { __builtin_amdgcn_s_setprio(1); _Pragma("unroll") for (int m = 0; m < 4; ++m) _Pragma("unroll") for (int n = 0; n < 2; ++n) _Pragma("unroll") for (int k = 0; k < 2; ++k) \
        acc[ai][bj][m][n] = __builtin_amdgcn_mfma_f32_16x16x32_bf16(Bt[n][k], At[m][k], acc[ai][bj][m][n], 0, 0, 0); __builtin_amdgcn_s_setprio(0); } while (0)
#define PG8_WAIT_V(n) asm volatile("s_waitcnt vmcnt(" #n ")" ::: "memory")
#define PG8_WAIT_L(n) asm volatile("s_waitcnt lgkmcnt(" #n ")" ::: "memory")
#define PG8_BAR __builtin_amdgcn_s_barrier()
#define PG8_SCHED __builtin_amdgcn_sched_barrier(0)
#define PG8_ABASE(u) ((const char*)g.A + (size_t)(u).pm * tstepA + (g.hdiv ? (size_t)((u).pn / g.hdiv) * (size_t)K * 2 : (size_t)0) + (size_t)(u).kb * 2)
#define PG8_BBASE(u) ((const char*)g.Bt + (size_t)(u).pn * tstepB + (size_t)(u).kb * 2)
    Unit cur, nxt; int ui = 0;
    if (!S.next(0, cur)) return;
    f32x4 acc[2][2][4][2];
#pragma unroll
    for (int a = 0; a < 2; ++a)
#pragma unroll
        for (int b = 0; b < 2; ++b)
#pragma unroll
            for (int m = 0; m < 4; ++m)
#pragma unroll
                for (int n = 0; n < 2; ++n) acc[a][b][m][n] = (f32x4){0.f, 0.f, 0.f, 0.f};
    bf16x8 At[4][2], B0[2][2], B1[2][2];
    const char* cA = PG8_ABASE(cur); const char* cB = PG8_BBASE(cur); int nt = cur.nt ? cur.nt : K / BK;
    S.a_ready(cur);
    if constexpr (SP2) {
        PG8_STAGE(PG8_SB(0, 0), cB, voffB); PG8_STAGE(PG8_SB(0, 1), cB + hstepB, voffB); PG8_STAGE(PG8_SA(0, 0), cA, voffA); PG8_STAGE(PG8_SA(0, 1), cA + hstepA, voffA);
        if (wr == 1) PG8_BAR;
        PG8_WAIT_V(2); PG8_BAR;
        PG8_STAGE(PG8_SB(1, 0), cB + kstep, voffB); PG8_STAGE(PG8_SA(1, 0), cA + kstep, voffA); PG8_STAGE(PG8_SB(1, 1), cB + hstepB + kstep, voffB);
        PG8_WAIT_V(6); PG8_BAR;
    } else {
        PG8_STAGE(PG8_SB(0, 0), cB, voffB); PG8_STAGE(PG8_SA(0, 0), cA, voffA); PG8_STAGE(PG8_SB(0, 1), cB + hstepB, voffB); PG8_STAGE(PG8_SA(0, 1), cA + hstepA, voffA);
        if (wr == 1) PG8_BAR;
        PG8_WAIT_V(4); PG8_BAR;
        PG8_STAGE(PG8_SB(1, 0), cB + kstep, voffB); PG8_STAGE(PG8_SA(1, 0), cA + kstep, voffA); PG8_STAGE(PG8_SB(1, 1), cB + hstepB + kstep, voffB);
        PG8_WAIT_V(6); PG8_BAR;
    }
    for (;;) {
        const bool has_next = S.next(ui + 1, nxt);
        const char* nA = has_next ? PG8_ABASE(nxt) : cA; const char* nB = has_next ? PG8_BBASE(nxt) : cB;
        for (int t = 0; t < nt; t += 2) {
            const bool last = (t == nt - 2);
            const char* a1 = cA + (size_t)(t + 1) * kstep;
            const char* a2 = last ? nA : cA + (size_t)(t + 2) * kstep; const char* b2 = last ? nB : cB + (size_t)(t + 2) * kstep;
            const char* a3 = a2 + kstep; const char* b3 = b2 + kstep;
            if (last && has_next) S.a_ready(nxt);
            if constexpr (SP2) {
            PG8_LDB(B0, 0, 0); PG8_LDB(B1, 0, 1); PG8_SCHED; PG8_LDA(At, 0, 0); PG8_STAGE(PG8_SA(1, 1), a1 + hstepA, voffA);
            PG8_WAIT_V(8); PG8_WAIT_L(0); PG8_BAR; PG8_MMA(0, 0, At, B0); PG8_MMA(0, 1, At, B1); PG8_BAR; PG8_SCHED;
            PG8_LDA(At, 0, 1); PG8_STAGE(PG8_SB(0, 0), b2, voffB); PG8_STAGE(PG8_SB(0, 1), b2 + hstepB, voffB); PG8_STAGE(PG8_SA(0, 0), a2, voffA);
            PG8_WAIT_V(8); PG8_WAIT_L(0); PG8_BAR; PG8_MMA(1, 0, At, B0); PG8_MMA(1, 1, At, B1); PG8_BAR; PG8_SCHED;
            PG8_LDB(B0, 1, 0); PG8_LDB(B1, 1, 1); PG8_SCHED; PG8_LDA(At, 1, 0); PG8_STAGE(PG8_SA(0, 1), a2 + hstepA, voffA);
            PG8_WAIT_V(8); PG8_WAIT_L(0); PG8_BAR; PG8_MMA(0, 0, At, B0); PG8_MMA(0, 1, At, B1); PG8_BAR; PG8_SCHED;
            PG8_LDA(At, 1, 1); PG8_STAGE(PG8_SB(1, 0), b3, voffB); PG8_STAGE(PG8_SB(1, 1), b3 + hstepB, voffB); PG8_STAGE(PG8_SA(1, 0), a3, voffA);
            PG8_WAIT_V(8); PG8_WAIT_L(0); PG8_BAR; PG8_MMA(1, 0, At, B0); PG8_MMA(1, 1, At, B1); PG8_BAR; PG8_SCHED;
            } else {
            PG8_LDB(B0, 0, 0); PG8_SCHED; PG8_LDA(At, 0, 0); PG8_STAGE(PG8_SA(1, 1), a1 + hstepA, voffA);
            PG8_WAIT_L(8); PG8_BAR; PG8_WAIT_L(0); PG8_MMA(0, 0, At, B0); PG8_BAR; PG8_SCHED;
            PG8_LDB(B1, 0, 1); PG8_STAGE(PG8_SB(0, 0), b2, voffB);
            PG8_BAR; PG8_WAIT_L(0); PG8_MMA(0, 1, At, B1); PG8_BAR;
            PG8_LDA(At, 0, 1); PG8_STAGE(PG8_SA(0, 0), a2, voffA);
            PG8_BAR; PG8_WAIT_L(0); PG8_MMA(1, 0, At, B0); PG8_BAR; PG8_SCHED;
            PG8_STAGE(PG8_SB(0, 1), b2 + hstepB, voffB);
            PG8_WAIT_V(6); PG8_BAR; PG8_MMA(1, 1, At, B1); PG8_BAR;
            PG8_LDB(B0, 1, 0); PG8_SCHED; PG8_LDA(At, 1, 0); PG8_STAGE(PG8_SA(0, 1), a2 + hstepA, voffA);
            PG8_WAIT_L(8); PG8_BAR; PG8_WAIT_L(0); PG8_MMA(0, 0, At, B0); PG8_BAR; PG8_SCHED;
            PG8_LDB(B1, 1, 1); PG8_STAGE(PG8_SB(1, 0), b3, voffB);
            PG8_BAR; PG8_WAIT_L(0); PG8_MMA(0, 1, At, B1); PG8_BAR;
            PG8_LDA(At, 1, 1); PG8_STAGE(PG8_SA(1, 0), a3, voffA);
            PG8_BAR; PG8_WAIT_L(0); PG8_MMA(1, 0, At, B0); PG8_BAR; PG8_SCHED;
            PG8_STAGE(PG8_SB(1, 1), b3 + hstepB, voffB);
            PG8_WAIT_V(6); PG8_BAR; PG8_MMA(1, 1, At, B1); PG8_BAR;
            }
        }
        if constexpr (ALIGN_EPI) { if (wr == 0) PG8_BAR; }
        E(acc, cur, wr, wc, fr, fq); S.done(cur);
        if (!has_next) break;
#pragma unroll
        for (int a = 0; a < 2; ++a)
#pragma unroll
            for (int b = 0; b < 2; ++b)
#pragma unroll
                for (int m = 0; m < 4; ++m)
#pragma unroll
                    for (int n = 0; n < 2; ++n) acc[a][b][m][n] = (f32x4){0.f, 0.f, 0.f, 0.f};
        cur = nxt; cA = nA; cB = nB; ++ui; nt = cur.nt ? cur.nt : K / BK;
        if constexpr (ALIGN_EPI) { if (wr == 1) PG8_BAR; }
    }
    PG8_WAIT_V(0);
    if constexpr (!ALIGN_EPI) { if (wr == 0) PG8_BAR; }
    PG8_BAR;
#undef PG8_SA
#undef PG8_SB
#undef PG8_STAGE
#undef PG8_LDA
#undef PG8_LDB
#undef PG8_MMA
#undef PG8_WAIT_V
#undef PG8_WAIT_L
#undef PG8_BAR
#undef PG8_SCHED
#undef PG8_ABASE
#undef PG8_BBASE
}

struct EpiBf16 {
    static constexpr bool PERM = true;
    bf16_t* O; int ldc; int split_cols; size_t split_stride;
    __device__ __forceinline__ void operator()(const f32x4 (&acc)[2][2][4][2], const Unit& u, int wr, int wc, int fr, int fq) const {
        const int row0 = u.pm * BM + wr * 64 + fr; int colt = u.pn * BM; bf16_t* base = O;
        if (split_cols) { const int t = colt / split_cols; base += (size_t)t * split_stride; colt -= t * split_cols; }
        const int col0 = colt + wc * 32 + 8 * fq;
#pragma unroll
        for (int ai = 0; ai < 2; ++ai)
#pragma unroll
            for (int m = 0; m < 4; ++m) { bf16_t* rowp = base + (size_t)(row0 + ai * HALF + m * 16) * ldc + col0;
#pragma unroll
                for (int bj = 0; bj < 2; ++bj) { const f32x4 v0 = acc[ai][bj][m][0], v1 = acc[ai][bj][m][1];
                    u32x4 w; w.x = cvt_pk_bf16(v0[0], v0[1]); w.y = cvt_pk_bf16(v0[2], v0[3]); w.z = cvt_pk_bf16(v1[0], v1[1]); w.w = cvt_pk_bf16(v1[2], v1[3]);
                    *(u32x4*)(rowp + bj * HALF) = w; } }
    }
};
struct EpiSwiglu {
    static constexpr bool PERM = false;
    bf16_t* Hout;
    __device__ __forceinline__ void operator()(const f32x4 (&acc)[2][2][4][2], const Unit& u, int wr, int wc, int fr, int fq) const {
        const int row0 = u.pm * BM + wr * 64 + fr, col0 = u.pn * 128 + wc * 16 + 4 * fq;
#pragma unroll
        for (int ai = 0; ai < 2; ++ai)
#pragma unroll
            for (int m = 0; m < 4; ++m) { bf16_t* rowp = Hout + (size_t)(row0 + ai * HALF + m * 16) * DFF + col0;
#pragma unroll
                for (int bj = 0; bj < 2; ++bj) { const f32x4 gt = acc[ai][bj][m][0], up = acc[ai][bj][m][1]; float h[4];
#pragma unroll
                    for (int i = 0; i < 4; ++i) h[i] = gt[i] / (1.0f + __expf(-gt[i])) * up[i];
                    u32x2 w; w.x = cvt_pk_bf16(h[0], h[1]); w.y = cvt_pk_bf16(h[2], h[3]);
                    *(u32x2*)(rowp + bj * 64) = w; } }
    }
};
struct EpiResid {
    static constexpr bool PERM = false;
    const float* base_lat; const float* base_ctx; float* out_lat; float* out_ctx; const float* gate; float gs; float* part;
    __device__ __forceinline__ void operator()(const f32x4 (&acc)[2][2][4][2], const Unit& u, int wr, int wc, int fr, int fq) const {
        const bool lat = u.pm < ML / BM; const int set = lat ? (u.pm >> 4) : 4;
        const float* bp = lat ? base_lat + (size_t)u.pm * BM * D : base_ctx + (size_t)(u.pm - ML / BM) * BM * D;
        float* op = lat ? out_lat + (size_t)u.pm * BM * D : out_ctx + (size_t)(u.pm - ML / BM) * BM * D;
        const int col0 = u.pn * BM + wc * 32 + 4 * fq;
        f32x4 gv[2][2];
#pragma unroll
        for (int bj = 0; bj < 2; ++bj)
#pragma unroll
            for (int n = 0; n < 2; ++n) gv[bj][n] = *(const f32x4*)(gate + (size_t)set * 9 * D + col0 + bj * HALF + n * 16) * ((u.r && !u.at) ? 0.f : gs);
#pragma unroll
        for (int ai = 0; ai < 2; ++ai)
#pragma unroll
            for (int m = 0; m < 4; ++m) { const size_t off = (size_t)(wr * 64 + fr + ai * HALF + m * 16) * D + col0;
#pragma unroll
                for (int bj = 0; bj < 2; ++bj)
#pragma unroll
                    for (int n = 0; n < 2; ++n) {
                        if (u.at) { *(f32x4*)(part + (size_t)(u.kb >> 8) * MC * D + (size_t)(u.pm - ML / BM) * BM * D + off + bj * HALF + n * 16) = gv[bj][n] * acc[ai][bj][m][n]; }
                        else { const f32x4 bs = *(const f32x4*)(bp + off + bj * HALF + n * 16); *(f32x4*)(op + off + bj * HALF + n * 16) = bs + gv[bj][n] * acc[ai][bj][m][n]; } }
                if (m & 1) asm volatile("" ::: "memory"); }
    }
};
struct EpiDnIn {
    static constexpr bool PERM = true;
    bf16_t* QKVP; bf16_t* Z; float* AB; bf16_t* HALO;
    __device__ __forceinline__ void operator()(const f32x4 (&acc)[2][2][4][2], const Unit& u, int wr, int wc, int fr, int fq) const {
#pragma unroll
        for (int ai = 0; ai < 2; ++ai)
#pragma unroll
            for (int m = 0; m < 4; ++m) {
                const int r = u.pm * BM + ai * HALF + wr * 64 + m * 16 + fr; int sr = r;
                if (r < ML) { const int s = r & (SEQ - 1); sr = (r & ~(SEQ - 1)) + ((s & 63) << 6) + (s >> 6); }
                if (u.pn < 16) {
                    bf16_t* rowp = (u.pn < 12) ? QKVP + (size_t)sr * 3072 + u.pn * BM : Z + (size_t)sr * D + (u.pn - 12) * BM;
                    rowp += wc * 32 + 8 * fq;
#pragma unroll
                    for (int bj = 0; bj < 2; ++bj) { const f32x4 v0 = acc[ai][bj][m][0], v1 = acc[ai][bj][m][1];
                        u32x4 w; w.x = cvt_pk_bf16(v0[0], v0[1]); w.y = cvt_pk_bf16(v0[2], v0[3]); w.z = cvt_pk_bf16(v1[0], v1[1]); w.w = cvt_pk_bf16(v1[2], v1[3]);
                        *(u32x4*)(rowp + bj * HALF) = w;
                        if (u.pn < 12) { const int p63 = sr & 63; if (p63 == 0 || p63 >= 62) *(u32x4*)(HALO + ((size_t)(sr >> 6) * 3 + (p63 == 0 ? 0 : p63 - 61)) * 3072 + u.pn * BM + wc * 32 + 8 * fq + bj * HALF) = w; } }
                } else if (wc == 0) {
                    float* rowp = AB + (size_t)sr * 32 + 8 * fq;
                    *(f32x4*)(rowp) = acc[ai][0][m][0]; *(f32x4*)(rowp + 4) = acc[ai][0][m][1];
                }
            }
    }
};
template <int PASS> struct EpiGates {
    static constexpr bool PERM = false;
    const bf16_t* U; const bf16_t* Y; bf16_t* RO; const float* bgate; const float* lam; float* agga; float* aggb; const float* carry;
    __device__ __forceinline__ void operator()(const f32x4 (&acc)[2][2][4][2], const Unit& u, int wr, int wc, int fr, int fq) const {
        const int ch0 = (u.pn >> 2) * 256 + (u.pn & 3) * 64 + wc * 16 + fq * 4;
#pragma unroll
        for (int ai = 0; ai < 2; ++ai) {
            const int q = u.pm * 4 + ai * 2 + wr;
            f32x4 hsum[4];
#pragma unroll
            for (int dir = 0; dir < 2; ++dir) {
                const f32x4 br = *(const f32x4*)(bgate + (dir * 2 + 0) * D + ch0), bi = *(const f32x4*)(bgate + (dir * 2 + 1) * D + ch0);
                const f32x4 sp8 = *(const f32x4*)(lam + dir * D + ch0);
                const size_t qo = ((size_t)dir * NQ + q) * D + ch0;
                f32x4 hin, Ac = {1.f, 1.f, 1.f, 1.f};
                if (PASS == 0) hin = (f32x4){0.f, 0.f, 0.f, 0.f}; else hin = *(const f32x4*)(carry + qo);
#pragma unroll
                for (int mm = 0; mm < 4; ++mm) {
                    const int m = dir == 0 ? mm : 3 - mm;
                    const u32x2 w = *(const u32x2*)(U + (size_t)(q * 64 + m * 16 + fr) * D + ch0);
                    const f32x4 uv = {bflo(w.x), bfhi(w.x), bflo(w.y), bfhi(w.y)};
                    const f32x4 pr = acc[ai][dir][m][0] + br, pi = acc[ai][dir][m][1] + bi;
                    f32x4 a, b;
#pragma unroll
                    for (int i = 0; i < 4; ++i) { const float rg = fsigmoid_(pr[i]), ig = fsigmoid_(pi[i]); const float la = -sp8[i] * rg;
                        a[i] = fexp_(la); b[i] = __builtin_amdgcn_sqrtf(fmaxf(1.0f - a[i] * a[i], 0.f)) * ig * uv[i]; }
#define GS_STEP(dd) do { f32x4 ap, bp; _Pragma("unroll") for (int i = 0; i < 4; ++i) { \
                        if (dir == 0) { ap[i] = dpp_keep<0x110 + (dd)>(a[i], 1.0f); bp[i] = dpp_keep<0x110 + (dd)>(b[i], 0.0f); } \
                        else          { ap[i] = dpp_keep<0x100 + (dd)>(a[i], 1.0f); bp[i] = dpp_keep<0x100 + (dd)>(b[i], 0.0f); } } \
                        b = a * bp + b; a = a * ap; } while (0)
                    GS_STEP(1); GS_STEP(2); GS_STEP(4); GS_STEP(8);
#undef GS_STEP
                    f32x4 at, bt;
#pragma unroll
                    for (int i = 0; i < 4; ++i) { at[i] = __shfl(a[i], dir == 0 ? 15 : 0, 16); bt[i] = __shfl(b[i], dir == 0 ? 15 : 0, 16); }
                    if (PASS == 1) { const f32x4 h = a * hin + b; if (dir == 0) hsum[m] = h; else hsum[m] = hsum[m] + h; }
                    hin = at * hin + bt; Ac = Ac * at;
                    asm volatile("" ::: "memory");
                }
                if (PASS == 0) { if (fr == 0) { *(f32x4*)(agga + qo) = Ac; *(f32x4*)(aggb + qo) = hin; } }
            }
            if (PASS == 1) {
#pragma unroll
                for (int m = 0; m < 4; ++m) { const size_t off = (size_t)(q * 64 + m * 16 + fr) * D + ch0; const u32x2 w = *(const u32x2*)(Y + off);
                    const float y0 = bflo(w.x), y1 = bfhi(w.x), y2 = bflo(w.y), y3 = bfhi(w.y);
                    u32x2 o; o.x = cvt_pk_bf16(fgelu_tanh(y0) * hsum[m][0], fgelu_tanh(y1) * hsum[m][1]); o.y = cvt_pk_bf16(fgelu_tanh(y2) * hsum[m][2], fgelu_tanh(y3) * hsum[m][3]);
                    *(u32x2*)(RO + off) = o; }
            }
        }
    }
};
}

#define XB_TMO      128
#define XB_XCNT(j)  (256  + 64 * (j))
#define XB_XSUB(j)  (1280 + 64 * (j))
#define XB_XGEN(j)  (2304 + 64 * (j))
#define XB_TOP      3328
#define XB_TOPGEN   3392
#define XCD_BAR_WORDS 3456
#define XB_SPIN_CAP (1u << 18)
__device__ __forceinline__ unsigned xb_ld(unsigned* p)              { return __hip_atomic_load(p, __ATOMIC_RELAXED, __HIP_MEMORY_SCOPE_AGENT); }
__device__ __forceinline__ unsigned xb_add(unsigned* p, unsigned v) { return __hip_atomic_fetch_add(p, v, __ATOMIC_RELAXED, __HIP_MEMORY_SCOPE_AGENT); }
__device__ __forceinline__ unsigned xb_xcc_id() { return (unsigned)__builtin_amdgcn_s_getreg((3 << 11) | 20) & 0xFu; }
#define XB_SPIN(cond, bar) do { unsigned _sp = 0; while (cond) { __builtin_amdgcn_s_sleep(1); \
    if ((++_sp & 255u) == 0u) { if (xb_ld(&(bar)[XB_TMO])) break; if (_sp > XB_SPIN_CAP) { atomicAdd(&(bar)[XB_TMO], 1u); break; } } } } while (0)
struct XcdBarrier { unsigned* bar; unsigned x; volatile LAS unsigned* st; };
__device__ __forceinline__ XcdBarrier xcd_barrier_post(unsigned* bar, volatile LAS unsigned* st) {
    XcdBarrier b; b.bar = bar; b.x = xb_xcc_id(); b.st = st;
    if (threadIdx.x == 0) (void)xb_add(&bar[XB_XCNT(b.x)], 1u);
    return b;
}
__device__ __forceinline__ void xcd_barrier_complete(unsigned* bar, unsigned x, unsigned& nloc, unsigned& nx) {
    const unsigned G = gridDim.x * gridDim.y * gridDim.z;
    unsigned sum, cnt, mine, sp = 0u;
    for (;;) {
        sum = 0u; cnt = 0u; mine = 0u;
#pragma unroll
        for (unsigned j = 0; j < 16; ++j) { const unsigned c = xb_ld(&bar[XB_XCNT(j)]); sum += c; cnt += (c > 0u) ? 1u : 0u; mine = (j == x) ? c : mine; }
        if (sum == G) break;
        __builtin_amdgcn_s_sleep(1);
        if ((++sp & 255u) == 0u) { if (xb_ld(&bar[XB_TMO])) break; if (sp > XB_SPIN_CAP) { atomicAdd(&bar[XB_TMO], 1u); break; } }
    }
    nloc = mine > 0u ? mine : 1u; nx = cnt > 0u ? cnt : 1u;
}
__device__ __forceinline__ void xcd_barrier(const XcdBarrier& b) {
    asm volatile("s_waitcnt vmcnt(0)" ::: "memory");
    __syncthreads();
    if (threadIdx.x == 0) {
        unsigned* bar = b.bar;
        __builtin_amdgcn_s_waitcnt(0);
        unsigned nloc = b.st[0], nx = b.st[1];
        if (nloc == 0u) { xcd_barrier_complete(bar, b.x, nloc, nx); b.st[0] = nloc; b.st[1] = nx; }
        const unsigned old = xb_add(&bar[XB_XSUB(b.x)], 1u);
        const unsigned gen = old / nloc;
        if (old + 1u == (gen + 1u) * nloc) {
            __builtin_amdgcn_fence(__ATOMIC_RELEASE, "agent");
            asm volatile("s_waitcnt vmcnt(0)" ::: "memory");
            const unsigned og = xb_add(&bar[XB_TOP], 1u);
            const unsigned tg = og / nx;
            if (og + 1u == (tg + 1u) * nx) xb_add(&bar[XB_TOPGEN], 1u);
            else XB_SPIN(xb_ld(&bar[XB_TOPGEN]) == tg, bar);
            __builtin_amdgcn_fence(__ATOMIC_ACQUIRE, "agent");
            xb_add(&bar[XB_XGEN(b.x)], 1u);
            asm volatile("s_waitcnt vmcnt(0)" ::: "memory");
        } else {
            XB_SPIN(xb_ld(&bar[XB_XGEN(b.x)]) == gen, bar);
            __builtin_amdgcn_fence(__ATOMIC_ACQUIRE, "agent");
            asm volatile("s_waitcnt vmcnt(0)" ::: "memory");
        }
    }
    __syncthreads();
}

struct Args { const float* in[23]; float* out; unsigned char* ws; int ph_lo, ph_hi; };
struct Frame { LAS unsigned char* lds; int tid, lane, wave, vcu, G; };

struct MapId { __device__ __forceinline__ int operator()(int s) const { return s; } };
struct MapW1 { __device__ __forceinline__ int operator()(int s) const { const int n = s >= DFF ? 1 : 0, hid = s - n * DFF, rem = hid & 127; return (hid >> 7) * 256 + (rem >> 6) * 128 + ((rem >> 4) & 3) * 32 + n * 16 + (rem & 15); } };
struct MapWG { int dir, gate; __device__ __forceinline__ int operator()(int ch) const { return (ch >> 6) * 256 + dir * 128 + ((ch >> 4) & 3) * 32 + gate * 16 + (ch & 15); } };
template <class RowMap>
__device__ __forceinline__ void transpose_item(const float* src, int ld, int item, int nblk, bf16_t* dst, int Kd, LAS float* scr, int lane, const RowMap rm) {
    const int kb = item / nblk, nb = item % nblk, k0 = 64 * kb, n0 = 32 * nb;
#pragma unroll 8
    for (int i = 0; i < 32; ++i) { const int kk = 2 * i + (lane >> 5); scr[kk * 33 + (lane & 31)] = src[(size_t)(k0 + kk) * ld + n0 + (lane & 31)]; }
    LDS_WAIT(); asm volatile("" ::: "memory");
    const int c = lane & 7;
#pragma unroll
    for (int j = 0; j < 4; ++j) { const int n = (lane >> 3) + 8 * j; const LAS float* s = scr + (8 * c) * 33 + n;
        u32x4 o; o.x = pk2(s[0 * 33], s[1 * 33]); o.y = pk2(s[2 * 33], s[3 * 33]); o.z = pk2(s[4 * 33], s[5 * 33]); o.w = pk2(s[6 * 33], s[7 * 33]);
        *(u32x4*)(dst + (size_t)rm(n0 + n) * Kd + k0 + 8 * c) = o; }
    LDS_WAIT(); asm volatile("" ::: "memory");
}

__device__ __forceinline__ void p_prologue(const Frame& F, const Args& a, int reps) {
    unsigned char* ws = a.ws;
    LAS float* scr = (LAS float*)(F.lds + F.wave * 16384);
    const int gw = F.vcu * NWAVES + F.wave, NGW = F.G * NWAVES;
    constexpr int I_W1 = (D / 64) * (2 * DFF / 32), I_W2 = (DFF / 64) * (D / 32), I_LIN = (D / 64) * (2048 / 32), I_LG = (256 / 64) * (256 / 32), I_SQ = (D / 64) * (D / 32), I_DIN = (D / 64) * (DNP / 32);
    constexpr int NITEMS = 4 * I_W1 + 4 * I_W2 + I_LIN + 16 * I_LG + I_SQ + I_DIN + I_SQ;
    for (int rp_ = 0; rp_ < reps; ++rp_)
    for (int it = gw; it < NITEMS; it += NGW) {
        int r = it;
        if (r < 4 * I_W1) { const int w = r / I_W1; transpose_item(a.in[7] + (size_t)w * D * 2 * DFF, 2 * DFF, r % I_W1, 2 * DFF / 32, (bf16_t*)(ws + WS_W1 + ((w + 1) & 3) * W1_SZ), D, scr, F.lane, MapW1()); continue; } r -= 4 * I_W1;
        if (r < 4 * I_W2) { const int w = r / I_W2; transpose_item(a.in[8] + (size_t)w * DFF * D, D, r % I_W2, D / 32, (bf16_t*)(ws + WS_W2 + w * W2_SZ), DFF, scr, F.lane, MapId()); continue; } r -= 4 * I_W2;
        if (r < I_LIN) { transpose_item(a.in[9], 2048, r, 2048 / 32, (bf16_t*)(ws + WS_WLIN), D, scr, F.lane, MapId()); continue; } r -= I_LIN;
        if (r < 16 * I_LG) { const int j = r / I_LG, dir = j >> 3, gate = (j >> 2) & 1, head = j & 3;
            transpose_item(a.in[12] + (size_t)j * 256 * 256, 256, r % I_LG, 256 / 32, (bf16_t*)(ws + WS_WLG) + (size_t)head * 1024 * 256, 256, scr, F.lane, MapWG{dir, gate}); continue; } r -= 16 * I_LG;
        if (r < I_SQ) { transpose_item(a.in[15], D, r, D / 32, (bf16_t*)(ws + WS_WLO), D, scr, F.lane, MapId()); continue; } r -= I_SQ;
        if (r < I_DIN) { transpose_item(a.in[16], DNP, r, DNP / 32, (bf16_t*)(ws + WS_WDIN), D, scr, F.lane, MapId()); continue; } r -= I_DIN;
        transpose_item(a.in[21], D, r, D / 32, (bf16_t*)(ws + WS_WDO), D, scr, F.lane, MapId());
    }
    const size_t gt = (size_t)F.vcu * (NWAVES * 64) + F.tid, GT = (size_t)F.G * NWAVES * 64;
    { u32x4* p = (u32x4*)(ws + WS_WDIN + (size_t)DNP * D * 2); const size_t n = (size_t)(DNPP - DNP) * D * 2 / 16; for (size_t i = gt; i < n; i += GT) p[i] = (u32x4){0u, 0u, 0u, 0u}; }
    if (gt < 2 * D) ((float*)(ws + WS_SP8))[gt] = 8.0f * softplusf_(-a.in[14][gt]);
    float* MOD = (float*)(ws + WS_MOD);
    for (int it = F.vcu; it < 2 * 18 * 32; it += F.G) {
        const int l = it / (18 * 32), rem = it % (18 * 32), cb = rem >> 5, kc = rem & 31, col = cb * 512 + F.tid;
        const float* w = a.in[4] + (size_t)l * D * 9 * D + (size_t)(kc * 32) * 9 * D + col;
        float s[5] = {0.f, 0.f, 0.f, 0.f, 0.f};
#pragma unroll 4
        for (int k = 0; k < 32; ++k) { const float wv = w[(size_t)k * 9 * D]; const int kk = kc * 32 + k;
#pragma unroll
            for (int st = 0; st < 5; ++st) { const float cv = st < 4 ? a.in[1][st * D + kk] : a.in[3][kk]; s[st] += siluf_(cv) * wv; } }
        const float bias = kc == 0 ? a.in[5][l * 9 * D + col] : 0.f;
#pragma unroll
        for (int st = 0; st < 5; ++st) atomicAdd(MOD + (size_t)l * MODL + st * 9 * D + col, s[st] + bias);
    }
}

__device__ __forceinline__ void p_norm(const Frame& F, const float* xl, const float* xc, int nrows, const float* g, const float* mod, bf16_t* XN, const float* part, int nparts, float* xc_out) {
    const int gw = F.vcu * NWAVES + F.wave, NGW = F.G * NWAVES;
    for (int r = gw; r < nrows; r += NGW) {
        const float* src = r < ML ? xl + (size_t)r * D : xc + (size_t)(r - ML) * D; const int set = r < ML ? (r >> 12) : 4;
        const f32x4* x4 = (const f32x4*)src + F.lane; const f32x4* g4 = (const f32x4*)g + F.lane;
        const f32x4* sh4 = (const f32x4*)(mod + (size_t)set * 9 * D) + F.lane; const f32x4* sc4 = (const f32x4*)(mod + (size_t)set * 9 * D + D) + F.lane;
        f32x4 v[4]; float ss = 0.f;
#pragma unroll
        for (int j = 0; j < 4; ++j) v[j] = x4[64 * j];
        if (r >= ML && nparts > 0) {
            for (int p = 0; p < nparts; ++p) { const f32x4* p4 = (const f32x4*)(part + (size_t)p * MC * D + (size_t)(r - ML) * D) + F.lane;
#pragma unroll
                for (int j = 0; j < 4; ++j) v[j] = v[j] + p4[64 * j]; }
            f32x4* o4 = (f32x4*)(xc_out + (size_t)(r - ML) * D) + F.lane;
#pragma unroll
            for (int j = 0; j < 4; ++j) o4[64 * j] = v[j];
        }
#pragma unroll
        for (int j = 0; j < 4; ++j) ss += (v[j].x * v[j].x + v[j].y * v[j].y) + (v[j].z * v[j].z + v[j].w * v[j].w);
        const float rstd = 1.0f / sqrtf(wave_sum(ss) * (1.0f / D) + EPS);
        u32x2* o8 = (u32x2*)(XN + (size_t)r * D) + F.lane;
#pragma unroll
        for (int j = 0; j < 4; ++j) { const f32x4 y = v[j] * rstd * g4[64 * j] * (sc4[64 * j] + 1.0f) + sh4[64 * j]; u32x2 w; w.x = pk2(y.x, y.y); w.y = pk2(y.z, y.w); o8[64 * j] = w; }
    }
}
__device__ __forceinline__ void p_final(const Frame& F, float* x, const float* g) {
    const int gw = F.vcu * NWAVES + F.wave, NGW = F.G * NWAVES;
    for (int r = gw; r < ML; r += NGW) {
        f32x4* x4 = (f32x4*)(x + (size_t)r * D) + F.lane; const f32x4* g4 = (const f32x4*)g + F.lane;
        f32x4 v[4]; float ss = 0.f;
#pragma unroll
        for (int j = 0; j < 4; ++j) { v[j] = x4[64 * j]; ss += (v[j].x * v[j].x + v[j].y * v[j].y) + (v[j].z * v[j].z + v[j].w * v[j].w); }
        const float rstd = 1.0f / sqrtf(wave_sum(ss) * (1.0f / D) + EPS);
#pragma unroll
        for (int j = 0; j < 4; ++j) x4[64 * j] = v[j] * rstd * g4[64 * j];
    }
}
__device__ __forceinline__ void p_lru_conv(const Frame& F, const bf16_t* UP, const float* cw, const float* cb, bf16_t* U) {
    const size_t gt = (size_t)F.vcu * (NWAVES * 64) + F.tid, GT = (size_t)F.G * NWAVES * 64;
    for (size_t idx = gt; idx < (size_t)MT * 128; idx += GT) {
        const int r = (int)(idx >> 7), c8 = (int)(idx & 127) * 8;
        int pos, len; if (r < ML) { pos = r & (SEQ - 1); len = SEQ; } else { pos = (r - ML) & (CTXL - 1); len = CTXL; }
        float o[8];
#pragma unroll
        for (int i = 0; i < 8; ++i) o[i] = cb[c8 + i];
#pragma unroll
        for (int j = 0; j < 4; ++j) { const int p = pos + j - 2; if (p < 0 || p >= len) continue;
            const u32x4 w = *(const u32x4*)(UP + (size_t)(r + j - 2) * D + c8); const float* cwj = cw + j * D + c8;
            o[0] += bflo(w.x) * cwj[0]; o[1] += bfhi(w.x) * cwj[1]; o[2] += bflo(w.y) * cwj[2]; o[3] += bfhi(w.y) * cwj[3];
            o[4] += bflo(w.z) * cwj[4]; o[5] += bfhi(w.z) * cwj[5]; o[6] += bflo(w.w) * cwj[6]; o[7] += bfhi(w.w) * cwj[7]; }
        u32x4 ov; ov.x = pk2(o[0], o[1]); ov.y = pk2(o[2], o[3]); ov.z = pk2(o[4], o[5]); ov.w = pk2(o[6], o[7]);
        *(u32x4*)(U + (size_t)r * D + c8) = ov;
    }
}
__device__ __forceinline__ void p_lru_carry(const Frame& F, const float* agga, const float* aggb, float* carry) {
    const int idx = F.vcu * (NWAVES * 64) + F.tid;
    if (idx >= NB * 2 * D) return;
    const int ch = idx & (D - 1), dir = (idx >> 10) & 1, b = idx >> 11;
    float st = 0.f;
    for (int n = 0; n < 68; ++n) {
        int q; if (n < 4) q = 256 + 4 * b + (dir == 0 ? n : 3 - n); else q = 64 * b + (dir == 0 ? n - 4 : 63 - (n - 4));
        const size_t o = ((size_t)dir * NQ + q) * D + ch;
        carry[o] = st; st = agga[o] * st + aggb[o];
    }
}
typedef float f32x16 __attribute__((ext_vector_type(16)));
__device__ __forceinline__ int kperm(int s, int hh, int j) { return 16 * s + 8 * (j >> 2) + 4 * hh + (j & 3); }
__device__ __forceinline__ int crow(int reg, int hh) { return (reg & 3) + 8 * (reg >> 2) + 4 * hh; }
__device__ __forceinline__ size_t dn_frag_off(int q, int h, int seg, int f, int l) {
    return ((size_t)(64 * q + 4 * f + (l >> 4)) * 3072 + seg * 1024 + h * 128) * 2 + (size_t)(l & 15) * 16;
}
__device__ __forceinline__ bf16x8 pack8(const f32x16& v, int s) {
    u32x4 w; w.x = pg8::cvt_pk_bf16(v[8 * s + 0], v[8 * s + 1]); w.y = pg8::cvt_pk_bf16(v[8 * s + 2], v[8 * s + 3]); w.z = pg8::cvt_pk_bf16(v[8 * s + 4], v[8 * s + 5]); w.w = pg8::cvt_pk_bf16(v[8 * s + 6], v[8 * s + 7]);
    return __builtin_bit_cast(bf16x8, w);
}
#define MFMA32(a, b, c) __builtin_amdgcn_mfma_f32_32x32x16_bf16((a), (b), (c), 0, 0, 0)

constexpr int PL_KS = 0, PL_QS = 17408, PL_VS = 34816, PL_AP = 0, PL_RAW = 52224, PL_KK = 52224, PL_QK = 68864, PL_GC = 103936, PL_BETA = 104448, PL_G = 104960, PL_TS = 105472;
template <int PV> __device__ __forceinline__ void p_dn_prep(const Frame& F, unsigned char* ws, const float* cw, const float* a_log, const float* dt_bias) {
    bf16_t* QKV = (bf16_t*)(ws + WS_QKV); const bf16_t* HALO = (const bf16_t*)(ws + WS_HALO); const float* AB = (const float*)(ws + WS_AB);
    const int tid = F.tid, lane = F.lane, wave = F.wave;
    LAS bf16_t* Ks = (LAS bf16_t*)(F.lds + PL_KS); LAS bf16_t* Qs = (LAS bf16_t*)(F.lds + PL_QS); LAS bf16_t* Vs = (LAS bf16_t*)(F.lds + PL_VS);
    LAS float* Ap = (LAS float*)(F.lds + PL_AP); LAS float* KKs = (LAS float*)(F.lds + PL_KK); LAS float* QKs = (LAS float*)(F.lds + PL_QK);
    LAS bf16_t* Ts = (LAS bf16_t*)(F.lds + PL_TS); LAS float* gcb = (LAS float*)(F.lds + PL_GC); LAS float* betab = (LAS float*)(F.lds + PL_BETA); LAS float* Gs = (LAS float*)(F.lds + PL_G);
#define PREP_DMA(itn) do { const int qn_ = (itn) >> 3, hn_ = (itn) & 7; int cp_, nc_; if (qn_ < 256) { cp_ = qn_ & 63; nc_ = 64; } else { cp_ = (qn_ - 256) & 3; nc_ = 4; } \
        for (int pc_ = wave * 64; pc_ < 3216; pc_ += 512) { const int p_ = pc_ + lane; if (p_ < 3216) { const int rr_ = p_ / 48, wi_ = (p_ % 48) * 16, sg_ = wi_ >> 8, of_ = wi_ & 255, tt_ = rr_ - 2; const unsigned char* src_ = nullptr; \
            if (tt_ >= 0 && tt_ < 64) src_ = (const unsigned char*)QKV + ((size_t)(64 * qn_ + tt_) * 3072 + sg_ * 1024 + hn_ * 128) * 2 + of_; \
            else if (tt_ < 0) { if (cp_ > 0) src_ = (const unsigned char*)HALO + (((size_t)(qn_ - 1) * 3 + (tt_ + 3)) * 3072 + sg_ * 1024 + hn_ * 128) * 2 + of_; } \
            else { if (cp_ + 1 < nc_) src_ = (const unsigned char*)HALO + (((size_t)(qn_ + 1) * 3) * 3072 + sg_ * 1024 + hn_ * 128) * 2 + of_; } \
            if (src_) __builtin_amdgcn_global_load_lds((const unsigned*)src_, (LAS unsigned*)(F.lds + PL_RAW + pc_ * 16), 16, 0, 0); } } } while (0)
    if (F.vcu < NQ * 8) PREP_DMA(F.vcu);
    for (int it = F.vcu; it < NQ * 8; it += F.G) {
        const int q = it >> 3, h = it & 7;
        int cpos, nch; if (q < 256) { cpos = q & 63; nch = 64; } else { cpos = (q - 256) & 3; nch = 4; }
        asm volatile("s_waitcnt vmcnt(0)" ::: "memory");
        __syncthreads();
        if (!(PV & 1)) {
            const int tok = tid >> 3, c0 = (tid & 7) * 16;
            const LAS unsigned char* raw = F.lds + PL_RAW;
#pragma unroll
            for (int seg = 0; seg < 3; ++seg) {
                float x[16];
#pragma unroll
                for (int i = 0; i < 16; ++i) x[i] = 0.f;
#pragma unroll
                for (int j = 0; j < 4; ++j) {
                    const int rr = tok + j;
                    const bool ok = !((cpos == 0 && rr < 2) || (cpos + 1 == nch && rr == 66));
                    if (ok) { const u32x4 w0 = *(const LAS u32x4*)(raw + rr * 768 + seg * 256 + c0 * 2), w1 = *(const LAS u32x4*)(raw + rr * 768 + seg * 256 + c0 * 2 + 16);
                        const float* cwj = cw + j * 3072 + seg * 1024 + h * 128 + c0;
                        x[0] += bflo(w0.x) * cwj[0]; x[1] += bfhi(w0.x) * cwj[1]; x[2] += bflo(w0.y) * cwj[2]; x[3] += bfhi(w0.y) * cwj[3];
                        x[4] += bflo(w0.z) * cwj[4]; x[5] += bfhi(w0.z) * cwj[5]; x[6] += bflo(w0.w) * cwj[6]; x[7] += bfhi(w0.w) * cwj[7];
                        x[8] += bflo(w1.x) * cwj[8]; x[9] += bfhi(w1.x) * cwj[9]; x[10] += bflo(w1.y) * cwj[10]; x[11] += bfhi(w1.y) * cwj[11];
                        x[12] += bflo(w1.z) * cwj[12]; x[13] += bfhi(w1.z) * cwj[13]; x[14] += bflo(w1.w) * cwj[14]; x[15] += bfhi(w1.w) * cwj[15]; }
                }
                float ss = 0.f;
#pragma unroll
                for (int i = 0; i < 16; ++i) { x[i] = x[i] * fsigmoid_(x[i]); ss += x[i] * x[i]; }
                float sc = 1.0f;
                if (seg < 2) { ss += __shfl_xor(ss, 1); ss += __shfl_xor(ss, 2); ss += __shfl_xor(ss, 4); sc = (seg == 0 ? 0.08838834764831845f : 1.0f) / sqrtf(ss + EPS); }
                u32x4 o0, o1;
                o0.x = pk2(x[0] * sc, x[1] * sc); o0.y = pk2(x[2] * sc, x[3] * sc); o0.z = pk2(x[4] * sc, x[5] * sc); o0.w = pk2(x[6] * sc, x[7] * sc);
                o1.x = pk2(x[8] * sc, x[9] * sc); o1.y = pk2(x[10] * sc, x[11] * sc); o1.z = pk2(x[12] * sc, x[13] * sc); o1.w = pk2(x[14] * sc, x[15] * sc);
                LAS bf16_t* dst = (seg == 0 ? Qs : (seg == 1 ? Ks : Vs)) + tok * 136 + c0;
                *(LAS u32x4*)dst = o0; *(LAS u32x4*)(dst + 8) = o1;
            }
            if (tid < 128) {
                const int dir = tid >> 6, n = tid & 63; const float* abr = AB + (size_t)(64 * q + n) * 32;
                const float g = -expf(a_log[dir * 8 + h]) * softplusf_(abr[dir * 8 + h] + dt_bias[dir * 8 + h]);
                const float bet = sigmoidf_(abr[16 + dir * 8 + h]);
                float c = g;
#pragma unroll
                for (int d = 1; d < 64; d <<= 1) { const float o = dir == 0 ? __shfl_up(c, d, 64) : __shfl_down(c, d, 64); if (dir == 0 ? (n >= d) : (n + d < 64)) c += o; }
                gcb[dir * 64 + n] = c; betab[dir * 64 + n] = bet;
                if (n == (dir == 0 ? 63 : 0)) Gs[dir] = c;
            }
        }
        __syncthreads();
        if (!(PV & 2)) {
            const int r = lane & 31, hh = lane >> 5, mi = (wave >> 1) & 1, mj = wave & 1;
            const LAS bf16_t* Xa = (wave < 4 ? Ks : Qs) + (32 * mi + r) * 136 + 8 * hh; const LAS bf16_t* Xb = Ks + (32 * mj + r) * 136 + 8 * hh;
            f32x16 acc;
#pragma unroll
            for (int i = 0; i < 16; ++i) acc[i] = 0.f;
#pragma unroll
            for (int ks = 0; ks < 8; ++ks) { const bf16x8 a = *(const LAS bf16x8*)(Xa + 16 * ks), b = *(const LAS bf16x8*)(Xb + 16 * ks); acc = MFMA32(a, b, acc); }
            LAS float* dst = (wave < 4 ? KKs : QKs) + 32 * mj + r;
#pragma unroll
            for (int reg = 0; reg < 16; ++reg) dst[(32 * mi + crow(reg, hh)) * 65] = acc[reg];
#pragma unroll 1
            for (int e = 0; e < 6; ++e) {
                const int idx = tid + 512 * e, f = idx >> 6, l = idx & 63, fr_ = l & 31, fh = l >> 5; u32x4 w; int seg, ff;
                if (f < 32) { ff = f & 15; seg = f < 16 ? 1 : 0; const int mt = ff >> 3, t = (ff >> 1) & 3, s2 = ff & 1;
                    const LAS bf16_t* src = (f < 16 ? Ks : Qs) + (32 * mt + fr_) * 136 + 32 * t + 16 * s2 + 4 * fh;
                    const u32x2 lo = *(const LAS u32x2*)src, hi = *(const LAS u32x2*)(src + 8); w.x = lo.x; w.y = lo.y; w.z = hi.x; w.w = hi.y; }
                else { ff = f - 32; seg = 2; const int t = ff >> 2, mt = (ff >> 1) & 1, s2 = ff & 1; unsigned short v8[8];
#pragma unroll
                    for (int j = 0; j < 8; ++j) v8[j] = Ks[(32 * mt + kperm(s2, fh, j)) * 136 + 32 * t + fr_];
                    w.x = v8[0] | ((unsigned)v8[1] << 16); w.y = v8[2] | ((unsigned)v8[3] << 16); w.z = v8[4] | ((unsigned)v8[5] << 16); w.w = v8[6] | ((unsigned)v8[7] << 16); }
                if (!(PV & 16)) *(u32x4*)((unsigned char*)QKV + dn_frag_off(q, h, seg, ff, l)) = w;
            }
            { const int blk = wave, dvq = blk >> 1, mt = blk & 1, c = lane & 31; unsigned short v16[16];
#pragma unroll
                for (int reg = 0; reg < 16; ++reg) v16[reg] = Vs[(32 * mt + crow(reg, hh)) * 136 + 32 * dvq + c];
                u32x4 w0, w1; w0.x = v16[0] | ((unsigned)v16[1] << 16); w0.y = v16[2] | ((unsigned)v16[3] << 16); w0.z = v16[4] | ((unsigned)v16[5] << 16); w0.w = v16[6] | ((unsigned)v16[7] << 16);
                w1.x = v16[8] | ((unsigned)v16[9] << 16); w1.y = v16[10] | ((unsigned)v16[11] << 16); w1.z = v16[12] | ((unsigned)v16[13] << 16); w1.w = v16[14] | ((unsigned)v16[15] << 16);
                u32x4* vp = (u32x4*)(ws + WS_VC + ((size_t)(it * 4 + dvq) * 2 + mt) * 2048 + lane * 32); if (!(PV & 16)) { vp[0] = w0; vp[1] = w1; } }
        }
        __syncthreads();
        if (!(PV & 4)) {
#pragma unroll 2
            for (int e = 0; e < 16; ++e) { const int idx = tid + 512 * e, dir = idx >> 12, ip = (idx >> 6) & 63, jp = idx & 63, n = dir ? 63 - ip : ip, m = dir ? 63 - jp : jp;
                Ap[dir * 4096 + jp * 64 + ip] = jp < ip ? betab[dir * 64 + n] * KKs[n * 65 + m] * fexp_(gcb[dir * 64 + n] - gcb[dir * 64 + m]) : 0.f; }
#pragma unroll 1
            for (int e = 0; e < 2; ++e) { const int idx = tid + 512 * e; if (idx < 768) { const int dir = idx / 384, rem = idx % 384, fb = rem >> 6, l = rem & 63, blk = fb >> 1, s2 = fb & 1, fr_ = l & 31, fh = l >> 5;
                const int mi = blk == 0 ? 0 : (blk == 1 ? 1 : (dir == 0 ? 1 : 0)), mj = blk == 0 ? 0 : (blk == 1 ? 1 : (dir == 0 ? 0 : 1));
                const int n = 32 * mi + fr_; float pv[8];
#pragma unroll
                for (int j = 0; j < 8; ++j) { const int m = 32 * mj + kperm(s2, fh, j); const bool ok = dir == 0 ? (m <= n) : (m >= n);
                    pv[j] = ok ? QKs[n * 65 + m] * fexp_(gcb[dir * 64 + n] - gcb[dir * 64 + m]) : 0.f; }
                u32x4 w; w.x = pk2(pv[0], pv[1]); w.y = pk2(pv[2], pv[3]); w.z = pk2(pv[4], pv[5]); w.w = pk2(pv[6], pv[7]);
                if (!(PV & 16)) *(u32x4*)(ws + WS_P + ((size_t)(it * 2 + dir) * 6 + fb) * 1024 + l * 16) = w; } }
            if (tid < 128 && !(PV & 16)) { const int dir = tid >> 6, n = tid & 63; float* rec = (float*)(ws + WS_GC + (size_t)(it * 2 + dir) * 1024);
                rec[n] = fexp_(gcb[dir * 64 + n]); rec[64 + n] = fexp_(Gs[dir] - gcb[dir * 64 + n]); if (n == 0) rec[128] = fexp_(Gs[dir]); }
        }
        __syncthreads();
        if (it + F.G < NQ * 8) PREP_DMA(it + F.G);
        if (!(PV & 8) && wave < 2) {
            const LAS float* Acol = Ap + wave * 4096; float Tc[64];
#pragma unroll
            for (int i = 0; i < 64; ++i) Tc[i] = (i == lane) ? 1.f : 0.f;
            f32x4 hb[2][8];
#define PREP_HLOAD(k, bi) do { const int col_ = (k) >> 1, hf_ = (k) & 1; if (col_ < 63) { _Pragma("unroll") for (int g = 0; g < 8; ++g) { const int gg = hf_ * 8 + g; \
                if (gg >= (col_ + 1) / 4) hb[bi][g] = *(const LAS f32x4*)(Acol + col_ * 64 + 4 * gg); } } } while (0)
#define PREP_HFMA(k, bi) do { const int col_ = (k) >> 1, hf_ = (k) & 1; const float tj_ = Tc[col_]; _Pragma("unroll") for (int g = 0; g < 8; ++g) { const int gg = hf_ * 8 + g; \
                if (gg >= (col_ + 1) / 4) { _Pragma("unroll") for (int ii = 0; ii < 4; ++ii) if (4 * gg + ii > col_) Tc[4 * gg + ii] -= hb[bi][g][ii] * tj_; } } } while (0)
            PREP_HLOAD(0, 0);
#pragma clang loop unroll(full)
            for (int j = 0; j < 63; ++j) { PREP_HLOAD(2 * j + 1, 1); PREP_HFMA(2 * j, 0); PREP_HLOAD(2 * j + 2, 0); PREP_HFMA(2 * j + 1, 1); }
#undef PREP_HLOAD
#undef PREP_HFMA
            const int m = wave ? 63 - lane : lane; const float bm = betab[wave * 64 + m];
#pragma unroll
            for (int i = 0; i < 64; ++i) { const int n = wave ? 63 - i : i; Ts[(wave * 64 + n) * 72 + m] = (bf16_t)f2bf(Tc[i] * bm); }
        }
        __syncthreads();
        {
#pragma unroll 1
            for (int e = 0; e < 2; ++e) { const int idx = tid + 512 * e; if (idx < 768) { const int dir = idx / 384, rem = idx % 384, fb = rem >> 6, l = rem & 63, blk = fb >> 1, s2 = fb & 1, fr_ = l & 31, fh = l >> 5;
                const int mi = blk == 0 ? 0 : (blk == 1 ? 1 : (dir == 0 ? 1 : 0)), mj = blk == 0 ? 0 : (blk == 1 ? 1 : (dir == 0 ? 0 : 1));
                const LAS bf16_t* src = Ts + (dir * 64 + 32 * mi + fr_) * 72 + 32 * mj + 16 * s2 + 4 * fh;
                const u32x2 lo = *(const LAS u32x2*)src, hi = *(const LAS u32x2*)(src + 8); u32x4 w; w.x = lo.x; w.y = lo.y; w.z = hi.x; w.w = hi.y;
                if (!(PV & 16)) *(u32x4*)(ws + WS_T + ((size_t)(it * 2 + dir) * 6 + fb) * 1024 + l * 16) = w; } }
        }
        __syncthreads();
    }
}

constexpr int CH_BUF = 62464;
template <int VAR> __device__ __forceinline__ void p_dn_chain(const Frame& F, const unsigned char* ws, bf16_t* O) {
    const int lane = F.lane, wave = F.wave, hh = lane >> 5;
    for (int item = blockIdx.x; item < 64; item += F.G) {
        const int b = item >> 4, h = (item >> 1) & 7, dir = item & 1, dvq = wave & 3;
        f32x16 S[4];
#pragma unroll
        for (int t = 0; t < 4; ++t)
#pragma unroll
            for (int i = 0; i < 16; ++i) S[t][i] = 0.f;
        u32x4 Vn_[2][2], Vc_[2][2];
#define CH_Q(n) ((n) < 4 ? 256 + 4 * b + (dir ? 3 - (n) : (n)) : 64 * b + (dir ? 63 - ((n) - 4) : (n) - 4))
#define CH_ISSUE(n, bufi) do { const int q_ = (VAR & 8) ? CH_Q(0) : CH_Q(n); const size_t it2_ = (size_t)(q_ * 8 + h) * 2 + dir; \
            if (wave >= 4) for (int f = wave - 4; f < 61; f += 4) { const unsigned char* srcu_; unsigned lo_; \
                if (f < 48) { const int seg_ = f < 16 ? 1 : (f < 32 ? 0 : 2); srcu_ = ws + WS_QKV + ((size_t)(64 * q_ + 4 * (f & 15)) * 3072 + seg_ * 1024 + h * 128) * 2; lo_ = lane_qkv; } \
                else if (f < 54) { srcu_ = ws + WS_T + (it2_ * 6 + (f - 48)) * 1024; lo_ = lane16; } \
                else if (f < 60) { srcu_ = ws + WS_P + (it2_ * 6 + (f - 54)) * 1024; lo_ = lane16; } \
                else { srcu_ = ws + WS_GC + it2_ * 1024; lo_ = lane16; } \
                __builtin_amdgcn_global_load_lds((const unsigned*)(srcu_ + lo_), (LAS unsigned*)(F.lds + (bufi) * CH_BUF + f * 1024), 16, 0, 0); } \
            if (wave < 4) { const unsigned char* vu_ = ws + WS_VC + ((size_t)((q_ * 8 + h) * 4 + dvq) * 2) * 2048; \
                Vn_[0][0] = *(const u32x4*)(vu_ + lane32); Vn_[0][1] = *(const u32x4*)(vu_ + lane32 + 16); Vn_[1][0] = *(const u32x4*)(vu_ + lane32 + 2048); Vn_[1][1] = *(const u32x4*)(vu_ + lane32 + 2064); } } while (0)
        const unsigned lane_qkv = (unsigned)((lane >> 4) * 6144 + (lane & 15) * 16), lane16 = (unsigned)lane * 16u, lane32 = (unsigned)lane * 32u;
#define CH_FLUSH(np) do { const LAS bf16_t* ot_ = (const LAS bf16_t*)(F.lds + 2 * CH_BUF + wave * 4096); const int c_ = dir ? 63 - ((np) - 4) : (np) - 4; \
            unsigned char* obu_ = (unsigned char*)(O + (size_t)dir * ML * D + ((size_t)b * SEQ + c_) * D + h * 128 + dvq * 32); const unsigned ol_ = (unsigned)((lane & 3) * 16 + (lane >> 2) * (64 * D * 2)); \
            _Pragma("unroll") for (int k = 0; k < 4; ++k) { const u32x4 w_ = *(const LAS u32x4*)(ot_ + ((lane >> 2) + 16 * k) * 32 + (lane & 3) * 8); *(u32x4*)(obu_ + ol_ + (unsigned)k * (16u * 64u * D * 2u)) = w_; } } while (0)
        CH_ISSUE(0, 0);
        for (int n = 0; n < 68; ++n) {
            const int buf = n & 1;
            asm volatile("s_waitcnt vmcnt(0)" ::: "memory");
            __syncthreads();
            Vc_[0][0] = Vn_[0][0]; Vc_[0][1] = Vn_[0][1]; Vc_[1][0] = Vn_[1][0]; Vc_[1][1] = Vn_[1][1];
            if (n + 1 < 68 && !(VAR & 2)) CH_ISSUE(n + 1, buf ^ 1);
            if (wave < 4 && n >= 5 && !(VAR & 1)) CH_FLUSH(n - 1);
            if (wave < 4 && !(VAR & 4)) {
                const LAS unsigned char* B = F.lds + buf * CH_BUF;
#define CH_FRAG(f) (*(const LAS bf16x8*)(B + (f) * 1024 + lane * 16))
#define CH_EA(i) ((((((i) >> 2) & 1) * 4 + ((i) >> 3)) * 2 + (((i) >> 1) & 1)) + (((i) & 1) ? 16 : 0))
#define CH_E(i) ((i) < 32 ? CH_EA(i) : ((i) < 44 ? 48 + ((i) - 32) : 32 + ((i) - 44)))
#define CH_LD(i) do { if ((i) < 60) ring[(i) % 4] = CH_FRAG(CH_E(i)); } while (0)
                bf16x8 ring[4];
#pragma unroll
                for (int i = 0; i < 4; ++i) CH_LD(i);
                const LAS float* gcp = (const LAS float*)(B + 60 * 1024); const float eG = gcp[128];
                f32x16 KS[2], QS[2];
#pragma unroll
                for (int mt = 0; mt < 2; ++mt)
#pragma unroll
                    for (int i = 0; i < 16; ++i) { KS[mt][i] = 0.f; QS[mt][i] = 0.f; }
#pragma unroll
                for (int t = 0; t < 4; ++t) {
                    bf16x8 Sb[2]; Sb[0] = pack8(S[t], 0); Sb[1] = pack8(S[t], 1);
#pragma unroll
                    for (int k = 0; k < 8; ++k) { const int i = 8 * t + k, mt = (k >> 2) & 1, s = (k >> 1) & 1;
                        if (k & 1) QS[mt] = MFMA32(ring[i % 4], Sb[s], QS[mt]); else KS[mt] = MFMA32(ring[i % 4], Sb[s], KS[mt]);
                        CH_LD(i + 4); __builtin_amdgcn_sched_barrier(0); }
                }
#pragma unroll
                for (int mt = 0; mt < 2; ++mt)
#pragma unroll
                    for (int g4 = 0; g4 < 4; ++g4) { const f32x4 ev = *(const LAS f32x4*)(gcp + 32 * mt + 8 * g4 + 4 * hh);
                        const unsigned w0 = Vc_[mt][g4 >> 1][(g4 & 1) * 2], w1 = Vc_[mt][g4 >> 1][(g4 & 1) * 2 + 1]; const float vv[4] = {bflo(w0), bfhi(w0), bflo(w1), bfhi(w1)};
#pragma unroll
                        for (int i = 0; i < 4; ++i) { KS[mt][4 * g4 + i] = vv[i] - ev[i] * KS[mt][4 * g4 + i]; QS[mt][4 * g4 + i] *= ev[i]; } }
                f32x16 VN[2];
#pragma unroll
                for (int mt = 0; mt < 2; ++mt)
#pragma unroll
                    for (int i = 0; i < 16; ++i) VN[mt][i] = 0.f;
                {
                    bf16x8 Rb[2][2];
#pragma unroll
                    for (int mt = 0; mt < 2; ++mt) { Rb[mt][0] = pack8(KS[mt], 0); Rb[mt][1] = pack8(KS[mt], 1); }
#pragma unroll
                    for (int i = 32; i < 38; ++i) { const int blk = (i - 32) >> 1, s = (i - 32) & 1;
                        if (blk == 0) VN[0] = MFMA32(ring[i % 4], Rb[0][s], VN[0]);
                        else if (blk == 1) VN[1] = MFMA32(ring[i % 4], Rb[1][s], VN[1]);
                        else { if (dir == 0) VN[1] = MFMA32(ring[i % 4], Rb[0][s], VN[1]); else VN[0] = MFMA32(ring[i % 4], Rb[1][s], VN[0]); }
                        CH_LD(i + 4); __builtin_amdgcn_sched_barrier(0); }
                }
                {
                    bf16x8 Vb[2][2];
#pragma unroll
                    for (int mt = 0; mt < 2; ++mt) { Vb[mt][0] = pack8(VN[mt], 0); Vb[mt][1] = pack8(VN[mt], 1); }
#pragma unroll
                    for (int i = 38; i < 44; ++i) { const int blk = (i - 38) >> 1, s = (i - 38) & 1;
                        if (blk == 0) QS[0] = MFMA32(ring[i % 4], Vb[0][s], QS[0]);
                        else if (blk == 1) QS[1] = MFMA32(ring[i % 4], Vb[1][s], QS[1]);
                        else { if (dir == 0) QS[1] = MFMA32(ring[i % 4], Vb[0][s], QS[1]); else QS[0] = MFMA32(ring[i % 4], Vb[1][s], QS[0]); }
                        CH_LD(i + 4); __builtin_amdgcn_sched_barrier(0); }
                }
                bf16x8 Wb[2][2];
#pragma unroll
                for (int mt = 0; mt < 2; ++mt) {
#pragma unroll
                    for (int g4 = 0; g4 < 4; ++g4) { const f32x4 wv = *(const LAS f32x4*)(gcp + 64 + 32 * mt + 8 * g4 + 4 * hh);
#pragma unroll
                        for (int i = 0; i < 4; ++i) VN[mt][4 * g4 + i] *= wv[i]; }
                    Wb[mt][0] = pack8(VN[mt], 0); Wb[mt][1] = pack8(VN[mt], 1); }
                {
#pragma unroll
                    for (int t = 0; t < 4; ++t)
#pragma unroll
                        for (int i = 0; i < 16; ++i) S[t][i] *= eG;
#pragma unroll
                    for (int i = 44; i < 60; ++i) { const int j = i - 44, t = j >> 2, mt = (j >> 1) & 1, s = j & 1;
                        S[t] = MFMA32(ring[i % 4], Wb[mt][s], S[t]);
                        CH_LD(i + 4); __builtin_amdgcn_sched_barrier(0); }
                }
                if (n >= 4 && !(VAR & 1)) {
                    LAS bf16_t* ot = (LAS bf16_t*)(F.lds + 2 * CH_BUF + wave * 4096);
#pragma unroll
                    for (int mt = 0; mt < 2; ++mt)
#pragma unroll
                        for (int reg = 0; reg < 16; ++reg) ot[(32 * mt + crow(reg, hh)) * 32 + (lane & 31)] = (bf16_t)f2bf(QS[mt][reg]);
                }
#undef CH_LD
#undef CH_E
#undef CH_EA
#undef CH_FRAG
            }
        }
        if (wave < 4 && !(VAR & 1)) CH_FLUSH(67);
#undef CH_FLUSH
#undef CH_ISSUE
#undef CH_Q
        asm volatile("s_waitcnt vmcnt(0)" ::: "memory");
        __syncthreads();
    }
}
__device__ __forceinline__ void p_dn_ro(const Frame& F, const bf16_t* O, const bf16_t* Z, const float* gn, bf16_t* RO) {
    const int gw = F.vcu * NWAVES + F.wave, NGW = F.G * NWAVES;
    for (int r = gw; r < ML; r += NGW) {
        const int s = r & (SEQ - 1), sr = (r & ~(SEQ - 1)) + ((s & 63) << 6) + (s >> 6);
        const u32x4* of4 = (const u32x4*)(O + (size_t)r * D + F.lane * 16); const u32x4* ob4 = (const u32x4*)(O + (size_t)ML * D + (size_t)r * D + F.lane * 16);
        float v[16]; float ss = 0.f;
#pragma unroll
        for (int j = 0; j < 2; ++j) { const u32x4 a = of4[j], b = ob4[j];
            v[8 * j + 0] = bflo(a.x) + bflo(b.x); v[8 * j + 1] = bfhi(a.x) + bfhi(b.x); v[8 * j + 2] = bflo(a.y) + bflo(b.y); v[8 * j + 3] = bfhi(a.y) + bfhi(b.y);
            v[8 * j + 4] = bflo(a.z) + bflo(b.z); v[8 * j + 5] = bfhi(a.z) + bfhi(b.z); v[8 * j + 6] = bflo(a.w) + bflo(b.w); v[8 * j + 7] = bfhi(a.w) + bfhi(b.w); }
#pragma unroll
        for (int i = 0; i < 16; ++i) ss += v[i] * v[i];
        ss += __shfl_xor(ss, 1); ss += __shfl_xor(ss, 2); ss += __shfl_xor(ss, 4);
        const float rstd = 1.0f / sqrtf(ss * (1.0f / 128.0f) + EPS);
        const u32x4* z4 = (const u32x4*)(Z + (size_t)sr * D + F.lane * 16);
        const float* g1 = gn + (F.lane & 7) * 16;
        u32x4 ov[2];
#pragma unroll
        for (int hh = 0; hh < 2; ++hh) { const u32x4 zw = z4[hh]; const float* vv = v + 8 * hh; const float* gg = g1 + 8 * hh;
            ov[hh].x = pk2(vv[0] * rstd * gg[0] * siluf_(bflo(zw.x)), vv[1] * rstd * gg[1] * siluf_(bfhi(zw.x))); ov[hh].y = pk2(vv[2] * rstd * gg[2] * siluf_(bflo(zw.y)), vv[3] * rstd * gg[3] * siluf_(bfhi(zw.y)));
            ov[hh].z = pk2(vv[4] * rstd * gg[4] * siluf_(bflo(zw.z)), vv[5] * rstd * gg[5] * siluf_(bfhi(zw.z))); ov[hh].w = pk2(vv[6] * rstd * gg[6] * siluf_(bflo(zw.w)), vv[7] * rstd * gg[7] * siluf_(bfhi(zw.w))); }
        u32x4* op = (u32x4*)(RO + (size_t)r * D + F.lane * 16); op[0] = ov[0]; op[1] = ov[1];
    }
}

constexpr int N_PHASES = 27;
__global__ void __launch_bounds__(NWAVES * 64, 2) trunk_fwd(Args args) {
    extern __shared__ __attribute__((aligned(16))) unsigned char lds_raw[];
    Frame F;
    F.lds = (LAS unsigned char*)lds_raw;
    F.tid = threadIdx.x; F.lane = F.tid & 63; F.wave = __builtin_amdgcn_readfirstlane(F.tid >> 6);
    F.G = gridDim.x; { const int bx = blockIdx.x; F.vcu = (F.G % 8 == 0) ? (bx % 8) * (F.G / 8) + bx / 8 : bx; }
    unsigned char* ws = args.ws;
    unsigned* ctl = (unsigned*)(ws + WS_CTL);
    for (int u = F.tid; u < (LDS_BYTES - LDSCTL_OFF) / 4; u += NWAVES * 64) ((LAS unsigned*)(F.lds + LDSCTL_OFF))[u] = 0u;
    __syncthreads();
    XcdBarrier bar; bar.bar = ctl + CW_BAR; bar.x = 0; bar.st = nullptr;
    if (!MK_PER_PHASE) bar = xcd_barrier_post(ctl + CW_BAR, (volatile LAS unsigned*)(F.lds + MISC_OFF) + 8);
    const int lo = args.ph_lo, hi = args.ph_hi;
#ifndef MK_PHMASK
#define MK_PHMASK 0xffffffffu
#endif
#define IN(k) ((((unsigned)MK_PHMASK >> (k)) & 1u) && lo <= (k) && (k) < hi)
#ifndef MK_REPMASK
#define MK_REPMASK 0u
#endif
#define REP(k) ((((unsigned)MK_REPMASK >> (k)) & 1u) ? 2 : 1)
#ifndef MK_BARREP
#define MK_BARREP 1
#endif
#define SEAM(k) do { if (IN(k) && IN((k) + 1)) { for (int br_ = 0; br_ < MK_BARREP; ++br_) xcd_barrier(bar); } } while (0)

    float* MOD = (float*)(ws + WS_MOD);
    float* XL = args.out; float* XC = (float*)(ws + WS_XC);
    bf16_t* XN = (bf16_t*)(ws + WS_XN); bf16_t* HB = (bf16_t*)(ws + WS_H);
    const float* g_sub = args.in[6];
    const int bid = (int)blockIdx.x;

#define PH_FFN1(k, w, MROWS) if (IN(k)) { pg8::Gemm g{XN, (const bf16_t*)(ws + WS_W1 + (((w) + 1) & 3) * W1_SZ), MROWS, 2 * DFF, D, D, 0, D}; pg8::StaticOrder S; S.init(MROWS, 2 * DFF, F.G, bid, REP(k)); \
        pg8::EpiSwiglu E{HB}; pg8::gemm_phase<pg8::EpiSwiglu, pg8::StaticOrder>(F.lds, g, S, E); } SEAM(k);
#define PH_FFN2(k, w, MROWS, BL, BC, GATE) if (IN(k)) { pg8::Gemm g{HB, (const bf16_t*)(ws + WS_W2 + (w) * W2_SZ), MROWS, D, DFF, DFF, 0, DFF}; pg8::ResidOrder S; S.init(MROWS, DFF, F.G, bid, REP(k)); \
        pg8::EpiResid E{BL, BC, XL, XC, GATE, 0.5f, (float*)(ws + WS_PART)}; pg8::gemm_phase<pg8::EpiResid, pg8::ResidOrder>(F.lds, g, S, E); } SEAM(k);
#define PH_NORM(k, SRCL, SRCC, NROWS, l, sub, NPARTS) if (IN(k)) { for (int rp = 0; rp < REP(k); ++rp) p_norm(F, SRCL, SRCC, NROWS, g_sub + ((l) * 3 + (sub)) * D, MOD + (size_t)(l) * MODL + (sub) * 3 * D, XN, (const float*)(ws + WS_PART), rp ? 0 : (NPARTS), XC); } SEAM(k);

    if (IN(0)) { p_prologue(F, args, REP(0)); } SEAM(0);
    PH_NORM(1, args.in[0], args.in[2], MT, 0, 0, 0)
    PH_FFN1(2, 0, MT)
    PH_FFN2(3, 0, MT, args.in[0], args.in[2], MOD + 0 * MODL + 2 * D)
    PH_NORM(4, XL, args.in[2], MT, 0, 1, 11)
    if (IN(5)) { pg8::Gemm g{XN, (const bf16_t*)(ws + WS_WLIN), MT, 2048, D, D, 0, D}; pg8::StaticOrder S; S.init(MT, 2048, F.G, bid, REP(5));
        pg8::EpiBf16 E{(bf16_t*)(ws + WS_Y), D, D, (size_t)(WS_UP - WS_Y) / 2}; pg8::gemm_phase<pg8::EpiBf16, pg8::StaticOrder>(F.lds, g, S, E); } SEAM(5);
    if (IN(6)) { for (int rp = 0; rp < REP(6); ++rp) p_lru_conv(F, (const bf16_t*)(ws + WS_UP), args.in[10], args.in[11], (bf16_t*)(ws + WS_U)); } SEAM(6);
    if (IN(7)) { pg8::Gemm g{(const bf16_t*)(ws + WS_U), (const bf16_t*)(ws + WS_WLG), MT, 4096, 256, D, 4, 256}; pg8::StaticOrder S; S.init(MT, 4096, F.G, bid, REP(7));
        pg8::EpiGates<0> E{(const bf16_t*)(ws + WS_U), (const bf16_t*)(ws + WS_Y), XN, args.in[13], (const float*)(ws + WS_SP8), (float*)(ws + WS_AGGA), (float*)(ws + WS_AGGB), (const float*)(ws + WS_CARRY)};
        pg8::gemm_phase<pg8::EpiGates<0>, pg8::StaticOrder>(F.lds, g, S, E); } SEAM(7);
    if (IN(8)) { for (int rp = 0; rp < REP(8); ++rp) p_lru_carry(F, (const float*)(ws + WS_AGGA), (const float*)(ws + WS_AGGB), (float*)(ws + WS_CARRY)); } SEAM(8);
    if (IN(9)) { pg8::Gemm g{(const bf16_t*)(ws + WS_U), (const bf16_t*)(ws + WS_WLG), MT, 4096, 256, D, 4, 256}; pg8::StaticOrder S; S.init(MT, 4096, F.G, bid, REP(9));
        pg8::EpiGates<1> E{(const bf16_t*)(ws + WS_U), (const bf16_t*)(ws + WS_Y), XN, args.in[13], (const float*)(ws + WS_SP8), (float*)(ws + WS_AGGA), (float*)(ws + WS_AGGB), (const float*)(ws + WS_CARRY)};
        pg8::gemm_phase<pg8::EpiGates<1>, pg8::StaticOrder>(F.lds, g, S, E); } SEAM(9);
    if (IN(10)) { pg8::Gemm g{XN, (const bf16_t*)(ws + WS_WLO), MT, D, D, D, 0, D}; pg8::ResidOrder S; S.init(MT, D, F.G, bid, REP(10));
        pg8::EpiResid E{XL, XC, XL, XC, MOD + 0 * MODL + 5 * D, 1.0f, (float*)(ws + WS_PART)}; pg8::gemm_phase<pg8::EpiResid, pg8::ResidOrder>(F.lds, g, S, E); } SEAM(10);
    PH_NORM(11, XL, XC, MT, 0, 2, 4)
    PH_FFN1(12, 1, MT)
    PH_FFN2(13, 1, MT, XL, XC, MOD + 0 * MODL + 8 * D)
    PH_NORM(14, XL, XC, MT, 1, 0, 11)
    PH_FFN1(15, 2, MT)
    PH_FFN2(16, 2, MT, XL, XC, MOD + 1 * MODL + 2 * D)
    PH_NORM(17, XL, XC, MT, 1, 1, 11)
    if (IN(18)) { pg8::Gemm g{XN, (const bf16_t*)(ws + WS_WDIN), MT, DNPP, D, D, 0, D}; pg8::StaticOrder S; S.init(MT, DNPP, F.G, bid, REP(18));
        pg8::EpiDnIn E{(bf16_t*)(ws + WS_QKV), (bf16_t*)(ws + WS_Z), (float*)(ws + WS_AB), (bf16_t*)(ws + WS_HALO)}; pg8::gemm_phase<pg8::EpiDnIn, pg8::StaticOrder>(F.lds, g, S, E); } SEAM(18);
    #ifndef MK_PVAR
#define MK_PVAR 0
#endif
    if (IN(19)) { p_dn_prep<0>(F, ws, args.in[17], args.in[18], args.in[19]); if (REP(19) > 1) p_dn_prep<16 | MK_PVAR>(F, ws, args.in[17], args.in[18], args.in[19]); } SEAM(19);
    #ifndef MK_CHVAR
#define MK_CHVAR 0
#endif
    if (IN(20)) { p_dn_chain<0>(F, ws, (bf16_t*)(ws + WS_O)); if (REP(20) > 1) p_dn_chain<MK_CHVAR>(F, ws, (bf16_t*)(ws + WS_O)); } SEAM(20);
    if (IN(21)) { for (int rp = 0; rp < REP(21); ++rp) p_dn_ro(F, (const bf16_t*)(ws + WS_O), (const bf16_t*)(ws + WS_Z), args.in[20], (bf16_t*)(ws + WS_RO2)); } SEAM(21);
    if (IN(22)) { pg8::Gemm g{(const bf16_t*)(ws + WS_RO2), (const bf16_t*)(ws + WS_WDO), ML, D, D, D, 0, D}; pg8::StaticOrder S; S.init(ML, D, F.G, bid, REP(22));
        pg8::EpiResid E{XL, XC, XL, XC, MOD + 1 * MODL + 5 * D, 1.0f, (float*)(ws + WS_PART)}; pg8::gemm_phase<pg8::EpiResid, pg8::StaticOrder>(F.lds, g, S, E); } SEAM(22);
    PH_NORM(23, XL, XC, ML, 1, 2, 0)
    PH_FFN1(24, 3, ML)
    PH_FFN2(25, 3, ML, XL, XC, MOD + 1 * MODL + 8 * D)
    if (IN(26)) { p_final(F, XL, args.in[22]); }
#undef IN
#undef SEAM
#undef PH_FFN1
#undef PH_FFN2
#undef PH_NORM
}

extern "C" void kernel_launch(void* const* d_in, const int* in_sizes, int n_in, void* d_out, int out_size, void* d_ws, size_t ws_size, hipStream_t stream) {
    static int grid = 0;
    if (grid == 0) {
        if (n_in != 23 || in_sizes[0] != ML * D || out_size != ML * D || ws_size < WS_END) { fprintf(stderr, "kernel_launch: unexpected problem shape (n_in %d, in0 %d, out %d, ws %zu); nothing launched\n", n_in, n_in > 0 ? in_sizes[0] : -1, out_size, ws_size); grid = -1; return; }
        int dev = 0, cus = 0;
        if (hipGetDevice(&dev) != hipSuccess || hipDeviceGetAttribute(&cus, hipDeviceAttributeMultiprocessorCount, dev) != hipSuccess) { grid = -1; return; }
        if (hipFuncSetAttribute((const void*)trunk_fwd, hipFuncAttributeMaxDynamicSharedMemorySize, LDS_BYTES) != hipSuccess) { fprintf(stderr, "kernel_launch: hipFuncSetAttribute failed\n"); grid = -1; return; }
        (void)hipGetLastError();
        grid = cus;
    }
    if (grid < 0) return;
    if (hipMemsetAsync((char*)d_ws + WS_CTL, 0, CTL_ZERO_BYTES, stream) != hipSuccess) return;
    Args a{};
    for (int i = 0; i < 23; ++i) a.in[i] = (const float*)d_in[i];
    a.out = (float*)d_out; a.ws = (unsigned char*)d_ws;
#if MK_PER_PHASE
    for (int p = 0; p < N_PHASES; ++p) { a.ph_lo = p; a.ph_hi = p + 1; hipLaunchKernelGGL(trunk_fwd, dim3(grid), dim3(NWAVES * 64), LDS_BYTES, stream, a); }
#else
    a.ph_lo = 0; a.ph_hi = N_PHASES;
    hipLaunchKernelGGL(trunk_fwd, dim3(grid), dim3(NWAVES * 64), LDS_BYTES, stream, a);
#endif
}
```

```cpp
#include <hip/hip_runtime.h>
#include <cstdio>
#include <cstdint>

#ifndef MK_PER_PHASE
#define MK_PER_PHASE 0
#endif

#define LAS __attribute__((address_space(3)))
typedef unsigned short bf16_t;
typedef short bf16x8 __attribute__((ext_vector_type(8)));
typedef float f32x4 __attribute__((ext_vector_type(4)));
typedef float f32x2 __attribute__((ext_vector_type(2)));
typedef unsigned u32x4 __attribute__((ext_vector_type(4)));
typedef unsigned u32x2 __attribute__((ext_vector_type(2)));

constexpr int D = 1024, NB = 4, SEQ = 4096, CTXL = 256, DFF = 2816;
constexpr int ML = NB * SEQ, MC = NB * CTXL, MT = ML + MC;
constexpr int NQ = MT / 64;
constexpr int MODL = 5 * 9 * D;
constexpr int DNP = 4128, DNPP = 4352;
constexpr float EPS = 1e-6f;

constexpr size_t MiB = 1u << 20;
constexpr size_t WS_CTL = 0, CTL_ZERO_BYTES = 2 * MiB;
constexpr size_t WS_MOD = 1 * MiB;
constexpr size_t WS_W1 = 2 * MiB, W1_SZ = (size_t)2 * DFF * D * 2;
constexpr size_t WS_W2 = 46 * MiB, W2_SZ = (size_t)D * DFF * 2;
constexpr size_t WS_WLIN = 68 * MiB, WS_WLG = 72 * MiB, WS_WLO = 74 * MiB, WS_WDIN = 76 * MiB, WS_WDO = 85 * MiB;
constexpr size_t WS_SP8 = 84 * MiB + 768 * 1024;
constexpr size_t WS_XC = 87 * MiB;
constexpr size_t WS_XN = 91 * MiB;
constexpr size_t WS_H = 125 * MiB;
constexpr size_t WS_PART = 240 * MiB;
constexpr size_t WS_Y = 125 * MiB, WS_UP = 159 * MiB, WS_U = 193 * MiB, WS_AGGA = 227 * MiB, WS_AGGB = 230 * MiB, WS_CARRY = 233 * MiB;
constexpr size_t WS_Z = 13 * MiB;
constexpr size_t WS_GC = 48 * MiB;
constexpr size_t WS_HALO = 53 * MiB;
constexpr size_t WS_O = 91 * MiB;
constexpr size_t WS_QKV = 155 * MiB;
constexpr size_t WS_VC = 257 * MiB;
constexpr size_t WS_T = 291 * MiB, WS_P = 317 * MiB;
constexpr size_t WS_AB = 343 * MiB, WS_END = 346 * MiB;
constexpr size_t WS_RO2 = WS_QKV;
static_assert(WS_W1 + 4 * W1_SZ <= WS_W2 && WS_W2 + 4 * W2_SZ <= WS_WLIN && WS_WDIN + (size_t)DNPP * D * 2 <= WS_WDO, "weights map");
static_assert(WS_XN + (size_t)MT * D * 2 <= WS_H && WS_H + (size_t)MT * DFF * 2 <= WS_AGGA, "activation map");
static_assert(WS_Z >= WS_W1 + W1_SZ && WS_Z + (size_t)MT * D * 2 <= WS_GC && WS_GC + (size_t)4352 * 1024 <= WS_HALO && WS_HALO + (size_t)NQ * 3 * 3072 * 2 <= WS_W2 + 3 * W2_SZ, "DeltaNet records over dead weights");
static_assert(WS_O + (size_t)2 * ML * D * 2 <= WS_QKV && WS_QKV + (size_t)MT * 3072 * 2 <= WS_VC && WS_VC + (size_t)2176 * 16384 <= WS_T && WS_T + (size_t)4352 * 6144 <= WS_P && WS_P + (size_t)4352 * 6144 <= WS_AB && WS_AB + (size_t)MT * 32 * 4 <= WS_END, "DeltaNet map");
constexpr int CW_BAR = 4096;

constexpr int RING_BYTES = 131072, LDS_BYTES = 147456, LDSCTL_OFF = LDS_BYTES - 1024, MISC_OFF = LDSCTL_OFF + 320;
constexpr int NWAVES = 8;

#define RLX_AGENT __ATOMIC_RELAXED, __HIP_MEMORY_SCOPE_AGENT
#define LDS_WAIT() asm volatile("s_waitcnt lgkmcnt(0)" ::: "memory")
__device__ __forceinline__ unsigned f2bf(float f) { unsigned u = __builtin_bit_cast(unsigned, f); return (u + 0x7fffu + ((u >> 16) & 1u)) >> 16; }
__device__ __forceinline__ unsigned pk2(float lo, float hi) { return f2bf(lo) | (f2bf(hi) << 16); }
__device__ __forceinline__ float bflo(unsigned w) { return __builtin_bit_cast(float, w << 16); }
__device__ __forceinline__ float bfhi(unsigned w) { return __builtin_bit_cast(float, w & 0xffff0000u); }
__device__ __forceinline__ float sigmoidf_(float x) { return 1.0f / (1.0f + expf(-x)); }
__device__ __forceinline__ float siluf_(float x) { return x / (1.0f + expf(-x)); }
__device__ __forceinline__ float softplusf_(float x) { return fmaxf(x, 0.f) + log1pf(expf(-fabsf(x))); }
__device__ __forceinline__ float fexp_(float x) { return __builtin_amdgcn_exp2f(x * 1.4426950408889634f); }
__device__ __forceinline__ float fsigmoid_(float x) { return __builtin_amdgcn_rcpf(1.0f + fexp_(-x)); }
__device__ __forceinline__ float fgelu_tanh(float x) { const float z = 0.7978845608028654f * (x + 0.044715f * x * x * x); const float t = 1.0f - 2.0f * __builtin_amdgcn_rcpf(1.0f + fexp_(2.0f * z)); return 0.5f * x * (1.0f + t); }
__device__ __forceinline__ float gelu_tanh(float x) { const float t = tanhf(0.7978845608028654f * (x + 0.044715f * x * x * x)); return 0.5f * x * (1.0f + t); }
template <int CTRL> __device__ __forceinline__ float dpp_keep(float v, float keep) { return __builtin_bit_cast(float, __builtin_amdgcn_update_dpp(__builtin_bit_cast(int, keep), __builtin_bit_cast(int, v), CTRL, 0xf, 0xf, false)); }
__device__ __forceinline__ float wave_sum(float v) {
#pragma unroll
    for (int o = 1; o < 64; o <<= 1) v += __shfl_xor(v, o);
    return v;
}

namespace pg8 {
constexpr int BM = 256, BK = 64, HALF = 128, HTB = HALF * BK * 2, STAGE_BYTES = 8 * HTB, NXCD = 8, WGM = 8;
__host__ __device__ __forceinline__ int lds_byte(int r, int c) { const int st = (r >> 4) * 2 + (c >> 5), rr = r & 15, cc = c & 31, ob = rr * 64 + cc * 2; return st * 1024 + (ob ^ (((ob >> 9) & 1) << 5)); }
__host__ __device__ __forceinline__ void stage_rc(int b, int& R, int& C) { const int st = b / 1024, sb = b % 1024, swz = sb ^ (((sb >> 9) & 1) << 5); R = (st >> 1) * 16 + swz / 64; C = (st & 1) * 32 + (swz % 64) / 2; }
__host__ __device__ __forceinline__ int perm32(int rho) { const int n = rho >> 4, i = rho & 15; return 8 * (i >> 2) + 4 * n + (i & 3); }

struct Unit { int pm, pn, r, kb, nt, at; };
struct Gemm { const bf16_t* A; const bf16_t* Bt; int M, N, K, lda, hdiv, ldb; };

struct StaticOrder {
    int nM, nN, nwg, G, c, rep;
    __host__ __device__ void init(int M, int N, int G_, int c_, int rep_ = 1) { nM = M / BM; nN = N / BM; nwg = nM * nN; G = G_; c = c_; rep = rep_; }
    __host__ __device__ bool next(int i, Unit& u) const {
        const int nc = c < nwg ? (nwg - c + G - 1) / G : 0;
        if (i >= nc * rep) return false;
        u.r = i / nc; u.kb = 0; u.nt = 0; u.at = 0; const long L = (long)(i % nc) * G + c;
        int wgid = (int)L; { const int q = nwg / NXCD, r = nwg % NXCD, xcd = wgid % NXCD, off = wgid / NXCD; wgid = (xcd < r ? xcd * (q + 1) : r * (q + 1) + (xcd - r) * q) + off; }
        const int nig = WGM * nN, gid = wgid / nig, fm = gid * WGM, gsz = (nM - fm) < WGM ? (nM - fm) : WGM;
        u.pm = fm + ((wgid % nig) % gsz); u.pn = (wgid % nig) / gsz; return true;
    }
    __device__ __forceinline__ void a_ready(const Unit&) const {}
    __device__ __forceinline__ void done(const Unit&) const {}
};

struct ResidOrder {
    int nlat, nsub, sk, G, c, rep;
    __host__ __device__ void init(int M, int K, int G_, int c_, int rep_ = 1) { nlat = (ML / BM) * (D / BM); sk = K / 256; nsub = M > ML ? 16 * sk : 0; G = G_; c = c_; rep = rep_; }
    __host__ __device__ bool next(int i, Unit& u) const {
        const int tot = nlat + nsub, nc = c < tot ? (tot - c + G - 1) / G : 0;
        if (i >= nc * rep) return false;
        const int L = (i % nc) * G + c;
        if (L < nlat) { int wgid = L; { const int q = nlat / NXCD, r = nlat % NXCD, xcd = wgid % NXCD, off = wgid / NXCD; wgid = (xcd < r ? xcd * (q + 1) : r * (q + 1) + (xcd - r) * q) + off; }
            const int nM = ML / BM, nN = D / BM, nig = WGM * nN, gid = wgid / nig, fm = gid * WGM, gsz = (nM - fm) < WGM ? (nM - fm) : WGM;
            u.pm = fm + ((wgid % nig) % gsz); u.pn = (wgid % nig) / gsz; u.r = i / nc; u.kb = 0; u.nt = 0; u.at = 0; return true; }
        const int j = L - nlat, tile = j / sk, sl = j % sk;
        u.pm = ML / BM + (tile >> 2); u.pn = tile & 3; u.r = i / nc; u.kb = sl * 256; u.nt = 4; u.at = 1; return true;
    }
    __device__ __forceinline__ void a_ready(const Unit&) const {}
    __device__ __forceinline__ void done(const Unit&) const {}
};

__device__ __forceinline__ unsigned cvt_pk_bf16(float lo, float hi) { unsigned r; asm volatile("v_cvt_pk_bf16_f32 %0, %1, %2" : "=v"(r) : "v"(lo), "v"(hi)); return r; }

template <class Epi, class Sched, bool ALIGN_EPI = true, bool SP2 = true>
__device__ __forceinline__ void gemm_phase(LAS unsigned char* lds, const Gemm g, const Sched& S, const Epi& E) {
    const int tid = threadIdx.x, wid = __builtin_amdgcn_readfirstlane(tid >> 6), lane = tid & 63, wr = wid >> 2, wc = wid & 3, fr = lane & 15, fq = lane >> 4;
    const int K = g.K, lda = g.lda, ldb = g.ldb;
    unsigned voffA[2], voffB[2];
#pragma unroll
    for (int i = 0; i < 2; ++i) { int R, C; stage_rc(tid * 16 + i * 8192, R, C); const int Rb = Epi::PERM ? ((R & ~31) + perm32(R & 31)) : R;
        voffA[i] = (unsigned)(R * lda + C) * 2u; voffB[i] = (unsigned)(Rb * ldb + C) * 2u; }
    const size_t kstep = (size_t)(BK * 2);
    const size_t hstepA = (size_t)HALF * lda * 2, hstepB = (size_t)HALF * ldb * 2;
    const size_t tstepA = 2 * hstepA, tstepB = 2 * hstepB;
    const unsigned ldsw = (unsigned)wid * 1024u;
    const int aoff = lds_byte(wr * 64 + fr, fq * 8), boff = lds_byte(wc * 32 + fr, fq * 8);
#define PG8_SA(b, h) (((b) * 2 + (h)) * HTB)
#define PG8_SB(b, h) ((4 + (b) * 2 + (h)) * HTB)
#define PG8_STAGE(bufoff, gbase, voff) do { _Pragma("unroll") for (int _i = 0; _i < 2; ++_i) \
        __builtin_amdgcn_global_load_lds((const unsigned*)((const char*)(gbase) + (voff)[_i]), (LAS unsigned*)(lds + (bufoff) + ldsw + _i * 8192), 16, 0, 0); } while (0)
#define PG8_LDA(dst, b, h) do { _Pragma("unroll") for (int m = 0; m < 4; ++m) _Pragma("unroll") for (int k = 0; k < 2; ++k) dst[m][k] = *(const LAS bf16x8*)(lds + PG8_SA(b, h) + aoff + m * 2048 + k * 1024); } while (0)
#define PG8_LDB(dst, b, h) do { _Pragma("unroll") for (int n = 0; n < 2; ++n) _Pragma("unroll") for (int k = 0; k < 2; ++k) dst[n][k] = *(const LAS bf16x8*)(lds + PG8_SB(b, h) + boff + n * 2048 + k * 1024); } while (0)
#define PG8_MMA(ai, bj, At, Bt) do { __builtin_amdgcn_s_setprio(1); _Pragma("unroll") for (int m = 0; m < 4; ++m) _Pragma("unroll") for (int n = 0; n < 2; ++n) _Pragma("unroll") for (int k = 0; k < 2; ++k) \
        acc[ai][bj][m][n] = __builtin_amdgcn_mfma_f32_16x16x32_bf16(Bt[n][k], At[m][k], acc[ai][bj][m][n], 0, 0, 0); __builtin_amdgcn_s_setprio(0); } while (0)
#define PG8_WAIT_V(n) asm volatile("s_waitcnt vmcnt(" #n ")" ::: "memory")
#define PG8_WAIT_L(n) asm volatile("s_waitcnt lgkmcnt(" #n ")" ::: "memory")
#define PG8_BAR __builtin_amdgcn_s_barrier()
#define PG8_SCHED __builtin_amdgcn_sched_barrier(0)
#define PG8_ABASE(u) ((const char*)g.A + (size_t)(u).pm * tstepA + (g.hdiv ? (size_t)((u).pn / g.hdiv) * (size_t)K * 2 : (size_t)0) + (size_t)(u).kb * 2)
#define PG8_BBASE(u) ((const char*)g.Bt + (size_t)(u).pn * tstepB + (size_t)(u).kb * 2)
    Unit cur, nxt; int ui = 0;
    if (!S.next(0, cur)) return;
    f32x4 acc[2][2][4][2];
#pragma unroll
    for (int a = 0; a < 2; ++a)
#pragma unroll
        for (int b = 0; b < 2; ++b)
#pragma unroll
            for (int m = 0; m < 4; ++m)
#pragma unroll
                for (int n = 0; n < 2; ++n) acc[a][b][m][n] = (f32x4){0.f, 0.f, 0.f, 0.f};
    bf16x8 At[4][2], B0[2][2], B1[2][2];
    const char* cA = PG8_ABASE(cur); const char* cB = PG8_BBASE(cur); int nt = cur.nt ? cur.nt : K / BK;
    S.a_ready(cur);
    if constexpr (SP2) {
        PG8_STAGE(PG8_SB(0, 0), cB, voffB); PG8_STAGE(PG8_SB(0, 1), cB + hstepB, voffB); PG8_STAGE(PG8_SA(0, 0), cA, voffA); PG8_STAGE(PG8_SA(0, 1), cA + hstepA, voffA);
        if (wr == 1) PG8_BAR;
        PG8_WAIT_V(2); PG8_BAR;
        PG8_STAGE(PG8_SB(1, 0), cB + kstep, voffB); PG8_STAGE(PG8_SA(1, 0), cA + kstep, voffA); PG8_STAGE(PG8_SB(1, 1), cB + hstepB + kstep, voffB);
        PG8_WAIT_V(6); PG8_BAR;
    } else {
        PG8_STAGE(PG8_SB(0, 0), cB, voffB); PG8_STAGE(PG8_SA(0, 0), cA, voffA); PG8_STAGE(PG8_SB(0, 1), cB + hstepB, voffB); PG8_STAGE(PG8_SA(0, 1), cA + hstepA, voffA);
        if (wr == 1) PG8_BAR;
        PG8_WAIT_V(4); PG8_BAR;
        PG8_STAGE(PG8_SB(1, 0), cB + kstep, voffB); PG8_STAGE(PG8_SA(1, 0), cA + kstep, voffA); PG8_STAGE(PG8_SB(1, 1), cB + hstepB + kstep, voffB);
        PG8_WAIT_V(6); PG8_BAR;
    }
    for (;;) {
        const bool has_next = S.next(ui + 1, nxt);
        const char* nA = has_next ? PG8_ABASE(nxt) : cA; const char* nB = has_next ? PG8_BBASE(nxt) : cB;
        for (int t = 0; t < nt; t += 2) {
            const bool last = (t == nt - 2);
            const char* a1 = cA + (size_t)(t + 1) * kstep;
            const char* a2 = last ? nA : cA + (size_t)(t + 2) * kstep; const char* b2 = last ? nB : cB + (size_t)(t + 2) * kstep;
            const char* a3 = a2 + kstep; const char* b3 = b2 + kstep;
            if (last && has_next) S.a_ready(nxt);
            if constexpr (SP2) {
            PG8_LDB(B0, 0, 0); PG8_LDB(B1, 0, 1); PG8_SCHED; PG8_LDA(At, 0, 0); PG8_STAGE(PG8_SA(1, 1), a1 + hstepA, voffA);
            PG8_WAIT_V(8); PG8_WAIT_L(0); PG8_BAR; PG8_MMA(0, 0, At, B0); PG8_MMA(0, 1, At, B1); PG8_BAR; PG8_SCHED;
            PG8_LDA(At, 0, 1); PG8_STAGE(PG8_SB(0, 0), b2, voffB); PG8_STAGE(PG8_SB(0, 1), b2 + hstepB, voffB); PG8_STAGE(PG8_SA(0, 0), a2, voffA);
            PG8_WAIT_V(8); PG8_WAIT_L(0); PG8_BAR; PG8_MMA(1, 0, At, B0); PG8_MMA(1, 1, At, B1); PG8_BAR; PG8_SCHED;
            PG8_LDB(B0, 1, 0); PG8_LDB(B1, 1, 1); PG8_SCHED; PG8_LDA(At, 1, 0); PG8_STAGE(PG8_SA(0, 1), a2 + hstepA, voffA);
            PG8_WAIT_V(8); PG8_WAIT_L(0); PG8_BAR; PG8_MMA(0, 0, At, B0); PG8_MMA(0, 1, At, B1); PG8_BAR; PG8_SCHED;
            PG8_LDA(At, 1, 1); PG8_STAGE(PG8_SB(1, 0), b3, voffB); PG8_STAGE(PG8_SB(1, 1), b3 + hstepB, voffB); PG8_STAGE(PG8_SA(1, 0), a3, voffA);
            PG8_WAIT_V(8); PG8_WAIT_L(0); PG8_BAR; PG8_MMA(1, 0, At, B0); PG8_MMA(1, 1, At, B1); PG8_BAR; PG8_SCHED;
            } else {
            PG8_LDB(B0, 0, 0); PG8_SCHED; PG8_LDA(At, 0, 0); PG8_STAGE(PG8_SA(1, 1), a1 + hstepA, voffA);
            PG8_WAIT_L(8); PG8_BAR; PG8_WAIT_L(0); PG8_MMA(0, 0, At, B0); PG8_BAR; PG8_SCHED;
            PG8_LDB(B1, 0, 1); PG8_STAGE(PG8_SB(0, 0), b2, voffB);
            PG8_BAR; PG8_WAIT_L(0); PG8_MMA(0, 1, At, B1); PG8_BAR;
            PG8_LDA(At, 0, 1); PG8_STAGE(PG8_SA(0, 0), a2, voffA);
            PG8_BAR; PG8_WAIT_L(0); PG8_MMA(1, 0, At, B0); PG8_BAR; PG8_SCHED;
            PG8_STAGE(PG8_SB(0, 1), b2 + hstepB, voffB);
            PG8_WAIT_V(6); PG8_BAR; PG8_MMA(1, 1, At, B1); PG8_BAR;
            PG8_LDB(B0, 1, 0); PG8_SCHED; PG8_LDA(At, 1, 0); PG8_STAGE(PG8_SA(0, 1), a2 + hstepA, voffA);
            PG8_WAIT_L(8); PG8_BAR; PG8_WAIT_L(0); PG8_MMA(0, 0, At, B0); PG8_BAR; PG8_SCHED;
            PG8_LDB(B1, 1, 1); PG8_STAGE(PG8_SB(1, 0), b3, voffB);
            PG8_BAR; PG8_WAIT_L(0); PG8_MMA(0, 1, At, B1); PG8_BAR;
            PG8_LDA(At, 1, 1); PG8_STAGE(PG8_SA(1, 0), a3, voffA);
            PG8_BAR; PG8_WAIT_L(0); PG8_MMA(1, 0, At, B0); PG8_BAR; PG8_SCHED;
            PG8_STAGE(PG8_SB(1, 1), b3 + hstepB, voffB);
            PG8_WAIT_V(6); PG8_BAR; PG8_MMA(1, 1, At, B1); PG8_BAR;
            }
        }
        if constexpr (ALIGN_EPI) { if (wr == 0) PG8_BAR; }
        E(acc, cur, wr, wc, fr, fq); S.done(cur);
        if (!has_next) break;
#pragma unroll
        for (int a = 0; a < 2; ++a)
#pragma unroll
            for (int b = 0; b < 2; ++b)
#pragma unroll
                for (int m = 0; m < 4; ++m)
#pragma unroll
                    for (int n = 0; n < 2; ++n) acc[a][b][m][n] = (f32x4){0.f, 0.f, 0.f, 0.f};
        cur = nxt; cA = nA; cB = nB; ++ui; nt = cur.nt ? cur.nt : K / BK;
        if constexpr (ALIGN_EPI) { if (wr == 1) PG8_BAR; }
    }
    PG8_WAIT_V(0);
    if constexpr (!ALIGN_EPI) { if (wr == 0) PG8_BAR; }
    PG8_BAR;
#undef PG8_SA
#undef PG8_SB
#undef PG8_STAGE
#undef PG8_LDA
#undef PG8_LDB
#undef PG8_MMA
#undef PG8_WAIT_V
#undef PG8_WAIT_L
#undef PG8_BAR
#undef PG8_SCHED
#undef PG8_ABASE
#undef PG8_BBASE
}

struct EpiBf16 {
    static constexpr bool PERM = true;
    bf16_t* O; int ldc; int split_cols; size_t split_stride;
    __device__ __forceinline__ void operator()(const f32x4 (&acc)[2][2][4][2], const Unit& u, int wr, int wc, int fr, int fq) const {
        const int row0 = u.pm * BM + wr * 64 + fr; int colt = u.pn * BM; bf16_t* base = O;
        if (split_cols) { const int t = colt / split_cols; base += (size_t)t * split_stride; colt -= t * split_cols; }
        const int col0 = colt + wc * 32 + 8 * fq;
#pragma unroll
        for (int ai = 0; ai < 2; ++ai)
#pragma unroll
            for (int m = 0; m < 4; ++m) { bf16_t* rowp = base + (size_t)(row0 + ai * HALF + m * 16) * ldc + col0;
#pragma unroll
                for (int bj = 0; bj < 2; ++bj) { const f32x4 v0 = acc[ai][bj][m][0], v1 = acc[ai][bj][m][1];
                    u32x4 w; w.x = cvt_pk_bf16(v0[0], v0[1]); w.y = cvt_pk_bf16(v0[2], v0[3]); w.z = cvt_pk_bf16(v1[0], v1[1]); w.w = cvt_pk_bf16(v1[2], v1[3]);
                    *(u32x4*)(rowp + bj * HALF) = w; } }
    }
};
struct EpiSwiglu {
    static constexpr bool PERM = false;
    bf16_t* Hout;
    __device__ __forceinline__ void operator()(const f32x4 (&acc)[2][2][4][2], const Unit& u, int wr, int wc, int fr, int fq) const {
        const int row0 = u.pm * BM + wr * 64 + fr, col0 = u.pn * 128 + wc * 16 + 4 * fq;
#pragma unroll
        for (int ai = 0; ai < 2; ++ai)
#pragma unroll
            for (int m = 0; m < 4; ++m) { bf16_t* rowp = Hout + (size_t)(row0 + ai * HALF + m * 16) * DFF + col0;
#pragma unroll
                for (int bj = 0; bj < 2; ++bj) { const f32x4 gt = acc[ai][bj][m][0], up = acc[ai][bj][m][1]; float h[4];
#pragma unroll
                    for (int i = 0; i < 4; ++i) h[i] = gt[i] / (1.0f + __expf(-gt[i])) * up[i];
                    u32x2 w; w.x = cvt_pk_bf16(h[0], h[1]); w.y = cvt_pk_bf16(h[2], h[3]);
                    *(u32x2*)(rowp + bj * 64) = w; } }
    }
};
struct EpiResid {
    static constexpr bool PERM = false;
    const float* base_lat; const float* base_ctx; float* out_lat; float* out_ctx; const float* gate; float gs; float* part;
    __device__ __forceinline__ void operator()(const f32x4 (&acc)[2][2][4][2], const Unit& u, int wr, int wc, int fr, int fq) const {
        const bool lat = u.pm < ML / BM; const int set = lat ? (u.pm >> 4) : 4;
        const float* bp = lat ? base_lat + (size_t)u.pm * BM * D : base_ctx + (size_t)(u.pm - ML / BM) * BM * D;
        float* op = lat ? out_lat + (size_t)u.pm * BM * D : out_ctx + (size_t)(u.pm - ML / BM) * BM * D;
        const int col0 = u.pn * BM + wc * 32 + 4 * fq;
        f32x4 gv[2][2];
#pragma unroll
        for (int bj = 0; bj < 2; ++bj)
#pragma unroll
            for (int n = 0; n < 2; ++n) gv[bj][n] = *(const f32x4*)(gate + (size_t)set * 9 * D + col0 + bj * HALF + n * 16) * ((u.r && !u.at) ? 0.f : gs);
#pragma unroll
        for (int ai = 0; ai < 2; ++ai)
#pragma unroll
            for (int m = 0; m < 4; ++m) { const size_t off = (size_t)(wr * 64 + fr + ai * HALF + m * 16) * D + col0;
#pragma unroll
                for (int bj = 0; bj < 2; ++bj)
#pragma unroll
                    for (int n = 0; n < 2; ++n) {
                        if (u.at) { *(f32x4*)(part + (size_t)(u.kb >> 8) * MC * D + (size_t)(u.pm - ML / BM) * BM * D + off + bj * HALF + n * 16) = gv[bj][n] * acc[ai][bj][m][n]; }
                        else { const f32x4 bs = *(const f32x4*)(bp + off + bj * HALF + n * 16); *(f32x4*)(op + off + bj * HALF + n * 16) = bs + gv[bj][n] * acc[ai][bj][m][n]; } }
                if (m & 1) asm volatile("" ::: "memory"); }
    }
};
struct EpiDnIn {
    static constexpr bool PERM = true;
    bf16_t* QKVP; bf16_t* Z; float* AB; bf16_t* HALO;
    __device__ __forceinline__ void operator()(const f32x4 (&acc)[2][2][4][2], const Unit& u, int wr, int wc, int fr, int fq) const {
#pragma unroll
        for (int ai = 0; ai < 2; ++ai)
#pragma unroll
            for (int m = 0; m < 4; ++m) {
                const int r = u.pm * BM + ai * HALF + wr * 64 + m * 16 + fr; int sr = r;
                if (r < ML) { const int s = r & (SEQ - 1); sr = (r & ~(SEQ - 1)) + ((s & 63) << 6) + (s >> 6); }
                if (u.pn < 16) {
                    bf16_t* rowp = (u.pn < 12) ? QKVP + (size_t)sr * 3072 + u.pn * BM : Z + (size_t)sr * D + (u.pn - 12) * BM;
                    rowp += wc * 32 + 8 * fq;
#pragma unroll
                    for (int bj = 0; bj < 2; ++bj) { const f32x4 v0 = acc[ai][bj][m][0], v1 = acc[ai][bj][m][1];
                        u32x4 w; w.x = cvt_pk_bf16(v0[0], v0[1]); w.y = cvt_pk_bf16(v0[2], v0[3]); w.z = cvt_pk_bf16(v1[0], v1[1]); w.w = cvt_pk_bf16(v1[2], v1[3]);
                        *(u32x4*)(rowp + bj * HALF) = w;
                        if (u.pn < 12) { const int p63 = sr & 63; if (p63 == 0 || p63 >= 62) *(u32x4*)(HALO + ((size_t)(sr >> 6) * 3 + (p63 == 0 ? 0 : p63 - 61)) * 3072 + u.pn * BM + wc * 32 + 8 * fq + bj * HALF) = w; } }
                } else if (wc == 0) {
                    float* rowp = AB + (size_t)sr * 32 + 8 * fq;
                    *(f32x4*)(rowp) = acc[ai][0][m][0]; *(f32x4*)(rowp + 4) = acc[ai][0][m][1];
                }
            }
    }
};
template <int PASS> struct EpiGates {
    static constexpr bool PERM = false;
    const bf16_t* U; const bf16_t* Y; bf16_t* RO; const float* bgate; const float* lam; float* agga; float* aggb; const float* carry;
    __device__ __forceinline__ void operator()(const f32x4 (&acc)[2][2][4][2], const Unit& u, int wr, int wc, int fr, int fq) const {
        const int ch0 = (u.pn >> 2) * 256 + (u.pn & 3) * 64 + wc * 16 + fq * 4;
#pragma unroll
        for (int ai = 0; ai < 2; ++ai) {
            const int q = u.pm * 4 + ai * 2 + wr;
            f32x4 hsum[4];
#pragma unroll
            for (int dir = 0; dir < 2; ++dir) {
                const f32x4 br = *(const f32x4*)(bgate + (dir * 2 + 0) * D + ch0), bi = *(const f32x4*)(bgate + (dir * 2 + 1) * D + ch0);
                const f32x4 sp8 = *(const f32x4*)(lam + dir * D + ch0);
                const size_t qo = ((size_t)dir * NQ + q) * D + ch0;
                f32x4 hin, Ac = {1.f, 1.f, 1.f, 1.f};
                if (PASS == 0) hin = (f32x4){0.f, 0.f, 0.f, 0.f}; else hin = *(const f32x4*)(carry + qo);
#pragma unroll
                for (int mm = 0; mm < 4; ++mm) {
                    const int m = dir == 0 ? mm : 3 - mm;
                    const u32x2 w = *(const u32x2*)(U + (size_t)(q * 64 + m * 16 + fr) * D + ch0);
                    const f32x4 uv = {bflo(w.x), bfhi(w.x), bflo(w.y), bfhi(w.y)};
                    const f32x4 pr = acc[ai][dir][m][0] + br, pi = acc[ai][dir][m][1] + bi;
                    f32x4 a, b;
#pragma unroll
                    for (int i = 0; i < 4; ++i) { const float rg = fsigmoid_(pr[i]), ig = fsigmoid_(pi[i]); const float la = -sp8[i] * rg;
                        a[i] = fexp_(la); b[i] = __builtin_amdgcn_sqrtf(fmaxf(1.0f - a[i] * a[i], 0.f)) * ig * uv[i]; }
#define GS_STEP(dd) do { f32x4 ap, bp; _Pragma("unroll") for (int i = 0; i < 4; ++i) { \
                        if (dir == 0) { ap[i] = dpp_keep<0x110 + (dd)>(a[i], 1.0f); bp[i] = dpp_keep<0x110 + (dd)>(b[i], 0.0f); } \
                        else          { ap[i] = dpp_keep<0x100 + (dd)>(a[i], 1.0f); bp[i] = dpp_keep<0x100 + (dd)>(b[i], 0.0f); } } \
                        b = a * bp + b; a = a * ap; } while (0)
                    GS_STEP(1); GS_STEP(2); GS_STEP(4); GS_STEP(8);
#undef GS_STEP
                    f32x4 at, bt;
#pragma unroll
                    for (int i = 0; i < 4; ++i) { at[i] = __shfl(a[i], dir == 0 ? 15 : 0, 16); bt[i] = __shfl(b[i], dir == 0 ? 15 : 0, 16); }
                    if (PASS == 1) { const f32x4 h = a * hin + b; if (dir == 0) hsum[m] = h; else hsum[m] = hsum[m] + h; }
                    hin = at * hin + bt; Ac = Ac * at;
                    asm volatile("" ::: "memory");
                }
                if (PASS == 0) { if (fr == 0) { *(f32x4*)(agga + qo) = Ac; *(f32x4*)(aggb + qo) = hin; } }
            }
            if (PASS == 1) {
#pragma unroll
                for (int m = 0; m < 4; ++m) { const size_t off = (size_t)(q * 64 + m * 16 + fr) * D + ch0; const u32x2 w = *(const u32x2*)(Y + off);
                    const float y0 = bflo(w.x), y1 = bfhi(w.x), y2 = bflo(w.y), y3 = bfhi(w.y);
                    u32x2 o; o.x = cvt_pk_bf16(fgelu_tanh(y0) * hsum[m][0], fgelu_tanh(y1) * hsum[m][1]); o.y = cvt_pk_bf16(fgelu_tanh(y2) * hsum[m][2], fgelu_tanh(y3) * hsum[m][3]);
                    *(u32x2*)(RO + off) = o; }
            }
        }
    }
};
}

#define XB_TMO      128
#define XB_XCNT(j)  (256  + 64 * (j))
#define XB_XSUB(j)  (1280 + 64 * (j))
#define XB_XGEN(j)  (2304 + 64 * (j))
#define XB_TOP      3328
#define XB_TOPGEN   3392
#define XCD_BAR_WORDS 3456
#define XB_SPIN_CAP (1u << 18)
__device__ __forceinline__ unsigned xb_ld(unsigned* p)              { return __hip_atomic_load(p, __ATOMIC_RELAXED, __HIP_MEMORY_SCOPE_AGENT); }
__device__ __forceinline__ unsigned xb_add(unsigned* p, unsigned v) { return __hip_atomic_fetch_add(p, v, __ATOMIC_RELAXED, __HIP_MEMORY_SCOPE_AGENT); }
__device__ __forceinline__ unsigned xb_xcc_id() { return (unsigned)__builtin_amdgcn_s_getreg((3 << 11) | 20) & 0xFu; }
#define XB_SPIN(cond, bar) do { unsigned _sp = 0; while (cond) { __builtin_amdgcn_s_sleep(1); \
    if ((++_sp & 255u) == 0u) { if (xb_ld(&(bar)[XB_TMO])) break; if (_sp > XB_SPIN_CAP) { atomicAdd(&(bar)[XB_TMO], 1u); break; } } } } while (0)
struct XcdBarrier { unsigned* bar; unsigned x; volatile LAS unsigned* st; };
__device__ __forceinline__ XcdBarrier xcd_barrier_post(unsigned* bar, volatile LAS unsigned* st) {
    XcdBarrier b; b.bar = bar; b.x = xb_xcc_id(); b.st = st;
    if (threadIdx.x == 0) (void)xb_add(&bar[XB_XCNT(b.x)], 1u);
    return b;
}
__device__ __forceinline__ void xcd_barrier_complete(unsigned* bar, unsigned x, unsigned& nloc, unsigned& nx) {
    const unsigned G = gridDim.x * gridDim.y * gridDim.z;
    unsigned sum, cnt, mine, sp = 0u;
    for (;;) {
        sum = 0u; cnt = 0u; mine = 0u;
#pragma unroll
        for (unsigned j = 0; j < 16; ++j) { const unsigned c = xb_ld(&bar[XB_XCNT(j)]); sum += c; cnt += (c > 0u) ? 1u : 0u; mine = (j == x) ? c : mine; }
        if (sum == G) break;
        __builtin_amdgcn_s_sleep(1);
        if ((++sp & 255u) == 0u) { if (xb_ld(&bar[XB_TMO])) break; if (sp > XB_SPIN_CAP) { atomicAdd(&bar[XB_TMO], 1u); break; } }
    }
    nloc = mine > 0u ? mine : 1u; nx = cnt > 0u ? cnt : 1u;
}
__device__ __forceinline__ void xcd_barrier(const XcdBarrier& b) {
    asm volatile("s_waitcnt vmcnt(0)" ::: "memory");
    __syncthreads();
    if (threadIdx.x == 0) {
        unsigned* bar = b.bar;
        __builtin_amdgcn_s_waitcnt(0);
        unsigned nloc = b.st[0], nx = b.st[1];
        if (nloc == 0u) { xcd_barrier_complete(bar, b.x, nloc, nx); b.st[0] = nloc; b.st[1] = nx; }
        const unsigned old = xb_add(&bar[XB_XSUB(b.x)], 1u);
        const unsigned gen = old / nloc;
        if (old + 1u == (gen + 1u) * nloc) {
            __builtin_amdgcn_fence(__ATOMIC_RELEASE, "agent");
            asm volatile("s_waitcnt vmcnt(0)" ::: "memory");
            const unsigned og = xb_add(&bar[XB_TOP], 1u);
            const unsigned tg = og / nx;
            if (og + 1u == (tg + 1u) * nx) xb_add(&bar[XB_TOPGEN], 1u);
            else XB_SPIN(xb_ld(&bar[XB_TOPGEN]) == tg, bar);
            __builtin_amdgcn_fence(__ATOMIC_ACQUIRE, "agent");
            xb_add(&bar[XB_XGEN(b.x)], 1u);
            asm volatile("s_waitcnt vmcnt(0)" ::: "memory");
        } else {
            XB_SPIN(xb_ld(&bar[XB_XGEN(b.x)]) == gen, bar);
            __builtin_amdgcn_fence(__ATOMIC_ACQUIRE, "agent");
            asm volatile("s_waitcnt vmcnt(0)" ::: "memory");
        }
    }
    __syncthreads();
}

struct Args { const float* in[23]; float* out; unsigned char* ws; int ph_lo, ph_hi; };
struct Frame { LAS unsigned char* lds; int tid, lane, wave, vcu, G; };

struct MapId { __device__ __forceinline__ int operator()(int s) const { return s; } };
struct MapW1 { __device__ __forceinline__ int operator()(int s) const { const int n = s >= DFF ? 1 : 0, hid = s - n * DFF, rem = hid & 127; return (hid >> 7) * 256 + (rem >> 6) * 128 + ((rem >> 4) & 3) * 32 + n * 16 + (rem & 15); } };
struct MapWG { int dir, gate; __device__ __forceinline__ int operator()(int ch) const { return (ch >> 6) * 256 + dir * 128 + ((ch >> 4) & 3) * 32 + gate * 16 + (ch & 15); } };
template <class RowMap>
__device__ __forceinline__ void transpose_item(const float* src, int ld, int item, int nblk, bf16_t* dst, int Kd, LAS float* scr, int lane, const RowMap rm) {
    const int kb = item / nblk, nb = item % nblk, k0 = 64 * kb, n0 = 32 * nb;
#pragma unroll 8
    for (int i = 0; i < 32; ++i) { const int kk = 2 * i + (lane >> 5); scr[kk * 33 + (lane & 31)] = src[(size_t)(k0 + kk) * ld + n0 + (lane & 31)]; }
    LDS_WAIT(); asm volatile("" ::: "memory");
    const int c = lane & 7;
#pragma unroll
    for (int j = 0; j < 4; ++j) { const int n = (lane >> 3) + 8 * j; const LAS float* s = scr + (8 * c) * 33 + n;
        u32x4 o; o.x = pk2(s[0 * 33], s[1 * 33]); o.y = pk2(s[2 * 33], s[3 * 33]); o.z = pk2(s[4 * 33], s[5 * 33]); o.w = pk2(s[6 * 33], s[7 * 33]);
        *(u32x4*)(dst + (size_t)rm(n0 + n) * Kd + k0 + 8 * c) = o; }
    LDS_WAIT(); asm volatile("" ::: "memory");
}

__device__ __forceinline__ void p_prologue(const Frame& F, const Args& a, int reps) {
    unsigned char* ws = a.ws;
    LAS float* scr = (LAS float*)(F.lds + F.wave * 16384);
    const int gw = F.vcu * NWAVES + F.wave, NGW = F.G * NWAVES;
    constexpr int I_W1 = (D / 64) * (2 * DFF / 32), I_W2 = (DFF / 64) * (D / 32), I_LIN = (D / 64) * (2048 / 32), I_LG = (256 / 64) * (256 / 32), I_SQ = (D / 64) * (D / 32), I_DIN = (D / 64) * (DNP / 32);
    constexpr int NITEMS = 4 * I_W1 + 4 * I_W2 + I_LIN + 16 * I_LG + I_SQ + I_DIN + I_SQ;
    for (int rp_ = 0; rp_ < reps; ++rp_)
    for (int it = gw; it < NITEMS; it += NGW) {
        int r = it;
        if (r < 4 * I_W1) { const int w = r / I_W1; transpose_item(a.in[7] + (size_t)w * D * 2 * DFF, 2 * DFF, r % I_W1, 2 * DFF / 32, (bf16_t*)(ws + WS_W1 + ((w + 1) & 3) * W1_SZ), D, scr, F.lane, MapW1()); continue; } r -= 4 * I_W1;
        if (r < 4 * I_W2) { const int w = r / I_W2; transpose_item(a.in[8] + (size_t)w * DFF * D, D, r % I_W2, D / 32, (bf16_t*)(ws + WS_W2 + w * W2_SZ), DFF, scr, F.lane, MapId()); continue; } r -= 4 * I_W2;
        if (r < I_LIN) { transpose_item(a.in[9], 2048, r, 2048 / 32, (bf16_t*)(ws + WS_WLIN), D, scr, F.lane, MapId()); continue; } r -= I_LIN;
        if (r < 16 * I_LG) { const int j = r / I_LG, dir = j >> 3, gate = (j >> 2) & 1, head = j & 3;
            transpose_item(a.in[12] + (size_t)j * 256 * 256, 256, r % I_LG, 256 / 32, (bf16_t*)(ws + WS_WLG) + (size_t)head * 1024 * 256, 256, scr, F.lane, MapWG{dir, gate}); continue; } r -= 16 * I_LG;
        if (r < I_SQ) { transpose_item(a.in[15], D, r, D / 32, (bf16_t*)(ws + WS_WLO), D, scr, F.lane, MapId()); continue; } r -= I_SQ;
        if (r < I_DIN) { transpose_item(a.in[16], DNP, r, DNP / 32, (bf16_t*)(ws + WS_WDIN), D, scr, F.lane, MapId()); continue; } r -= I_DIN;
        transpose_item(a.in[21], D, r, D / 32, (bf16_t*)(ws + WS_WDO), D, scr, F.lane, MapId());
    }
    const size_t gt = (size_t)F.vcu * (NWAVES * 64) + F.tid, GT = (size_t)F.G * NWAVES * 64;
    { u32x4* p = (u32x4*)(ws + WS_WDIN + (size_t)DNP * D * 2); const size_t n = (size_t)(DNPP - DNP) * D * 2 / 16; for (size_t i = gt; i < n; i += GT) p[i] = (u32x4){0u, 0u, 0u, 0u}; }
    if (gt < 2 * D) ((float*)(ws + WS_SP8))[gt] = 8.0f * softplusf_(-a.in[14][gt]);
    float* MOD = (float*)(ws + WS_MOD);
    for (int it = F.vcu; it < 2 * 18 * 32; it += F.G) {
        const int l = it / (18 * 32), rem = it % (18 * 32), cb = rem >> 5, kc = rem & 31, col = cb * 512 + F.tid;
        const float* w = a.in[4] + (size_t)l * D * 9 * D + (size_t)(kc * 32) * 9 * D + col;
        float s[5] = {0.f, 0.f, 0.f, 0.f, 0.f};
#pragma unroll 4
        for (int k = 0; k < 32; ++k) { const float wv = w[(size_t)k * 9 * D]; const int kk = kc * 32 + k;
#pragma unroll
            for (int st = 0; st < 5; ++st) { const float cv = st < 4 ? a.in[1][st * D + kk] : a.in[3][kk]; s[st] += siluf_(cv) * wv; } }
        const float bias = kc == 0 ? a.in[5][l * 9 * D + col] : 0.f;
#pragma unroll
        for (int st = 0; st < 5; ++st) atomicAdd(MOD + (size_t)l * MODL + st * 9 * D + col, s[st] + bias);
    }
}

__device__ __forceinline__ void p_norm(const Frame& F, const float* xl, const float* xc, int nrows, const float* g, const float* mod, bf16_t* XN, const float* part, int nparts, float* xc_out) {
    const int gw = F.vcu * NWAVES + F.wave, NGW = F.G * NWAVES;
    for (int r = gw; r < nrows; r += NGW) {
        const float* src = r < ML ? xl + (size_t)r * D : xc + (size_t)(r - ML) * D; const int set = r < ML ? (r >> 12) : 4;
        const f32x4* x4 = (const f32x4*)src + F.lane; const f32x4* g4 = (const f32x4*)g + F.lane;
        const f32x4* sh4 = (const f32x4*)(mod + (size_t)set * 9 * D) + F.lane; const f32x4* sc4 = (const f32x4*)(mod + (size_t)set * 9 * D + D) + F.lane;
        f32x4 v[4]; float ss = 0.f;
#pragma unroll
        for (int j = 0; j < 4; ++j) v[j] = x4[64 * j];
        if (r >= ML && nparts > 0) {
            for (int p = 0; p < nparts; ++p) { const f32x4* p4 = (const f32x4*)(part + (size_t)p * MC * D + (size_t)(r - ML) * D) + F.lane;
#pragma unroll
                for (int j = 0; j < 4; ++j) v[j] = v[j] + p4[64 * j]; }
            f32x4* o4 = (f32x4*)(xc_out + (size_t)(r - ML) * D) + F.lane;
#pragma unroll
            for (int j = 0; j < 4; ++j) o4[64 * j] = v[j];
        }
#pragma unroll
        for (int j = 0; j < 4; ++j) ss += (v[j].x * v[j].x + v[j].y * v[j].y) + (v[j].z * v[j].z + v[j].w * v[j].w);
        const float rstd = 1.0f / sqrtf(wave_sum(ss) * (1.0f / D) + EPS);
        u32x2* o8 = (u32x2*)(XN + (size_t)r * D) + F.lane;
#pragma unroll
        for (int j = 0; j < 4; ++j) { const f32x4 y = v[j] * rstd * g4[64 * j] * (sc4[64 * j] + 1.0f) + sh4[64 * j]; u32x2 w; w.x = pk2(y.x, y.y); w.y = pk2(y.z, y.w); o8[64 * j] = w; }
    }
}
__device__ __forceinline__ void p_final(const Frame& F, float* x, const float* g) {
    const int gw = F.vcu * NWAVES + F.wave, NGW = F.G * NWAVES;
    for (int r = gw; r < ML; r += NGW) {
        f32x4* x4 = (f32x4*)(x + (size_t)r * D) + F.lane; const f32x4* g4 = (const f32x4*)g + F.lane;
        f32x4 v[4]; float ss = 0.f;
#pragma unroll
        for (int j = 0; j < 4; ++j) { v[j] = x4[64 * j]; ss += (v[j].x * v[j].x + v[j].y * v[j].y) + (v[j].z * v[j].z + v[j].w * v[j].w); }
        const float rstd = 1.0f / sqrtf(wave_sum(ss) * (1.0f / D) + EPS);
#pragma unroll
        for (int j = 0; j < 4; ++j) x4[64 * j] = v[j] * rstd * g4[64 * j];
    }
}
__device__ __forceinline__ void p_lru_conv(const Frame& F, const bf16_t* UP, const float* cw, const float* cb, bf16_t* U) {
    const size_t gt = (size_t)F.vcu * (NWAVES * 64) + F.tid, GT = (size_t)F.G * NWAVES * 64;
    for (size_t idx = gt; idx < (size_t)MT * 128; idx += GT) {
        const int r = (int)(idx >> 7), c8 = (int)(idx & 127) * 8;
        int pos, len; if (r < ML) { pos = r & (SEQ - 1); len = SEQ; } else { pos = (r - ML) & (CTXL - 1); len = CTXL; }
        float o[8];
#pragma unroll
        for (int i = 0; i < 8; ++i) o[i] = cb[c8 + i];
#pragma unroll
        for (int j = 0; j < 4; ++j) { const int p = pos + j - 2; if (p < 0 || p >= len) continue;
            const u32x4 w = *(const u32x4*)(UP + (size_t)(r + j - 2) * D + c8); const float* cwj = cw + j * D + c8;
            o[0] += bflo(w.x) * cwj[0]; o[1] += bfhi(w.x) * cwj[1]; o[2] += bflo(w.y) * cwj[2]; o[3] += bfhi(w.y) * cwj[3];
            o[4] += bflo(w.z) * cwj[4]; o[5] += bfhi(w.z) * cwj[5]; o[6] += bflo(w.w) * cwj[6]; o[7] += bfhi(w.w) * cwj[7]; }
        u32x4 ov; ov.x = pk2(o[0], o[1]); ov.y = pk2(o[2], o[3]); ov.z = pk2(o[4], o[5]); ov.w = pk2(o[6], o[7]);
        *(u32x4*)(U + (size_t)r * D + c8) = ov;
    }
}
__device__ __forceinline__ void p_lru_carry(const Frame& F, const float* agga, const float* aggb, float* carry) {
    const int idx = F.vcu * (NWAVES * 64) + F.tid;
    if (idx >= NB * 2 * D) return;
    const int ch = idx & (D - 1), dir = (idx >> 10) & 1, b = idx >> 11;
    float st = 0.f;
    for (int n = 0; n < 68; ++n) {
        int q; if (n < 4) q = 256 + 4 * b + (dir == 0 ? n : 3 - n); else q = 64 * b + (dir == 0 ? n - 4 : 63 - (n - 4));
        const size_t o = ((size_t)dir * NQ + q) * D + ch;
        carry[o] = st; st = agga[o] * st + aggb[o];
    }
}
typedef float f32x16 __attribute__((ext_vector_type(16)));
__device__ __forceinline__ int kperm(int s, int hh, int j) { return 16 * s + 8 * (j >> 2) + 4 * hh + (j & 3); }
__device__ __forceinline__ int crow(int reg, int hh) { return (reg & 3) + 8 * (reg >> 2) + 4 * hh; }
__device__ __forceinline__ size_t dn_frag_off(int q, int h, int seg, int f, int l) {
    return ((size_t)(64 * q + 4 * f + (l >> 4)) * 3072 + seg * 1024 + h * 128) * 2 + (size_t)(l & 15) * 16;
}
__device__ __forceinline__ bf16x8 pack8(const f32x16& v, int s) {
    u32x4 w; w.x = pg8::cvt_pk_bf16(v[8 * s + 0], v[8 * s + 1]); w.y = pg8::cvt_pk_bf16(v[8 * s + 2], v[8 * s + 3]); w.z = pg8::cvt_pk_bf16(v[8 * s + 4], v[8 * s + 5]); w.w = pg8::cvt_pk_bf16(v[8 * s + 6], v[8 * s + 7]);
    return __builtin_bit_cast(bf16x8, w);
}
#define MFMA32(a, b, c) __builtin_amdgcn_mfma_f32_32x32x16_bf16((a), (b), (c), 0, 0, 0)

constexpr int PL_KS = 0, PL_QS = 17408, PL_VS = 34816, PL_AP = 0, PL_RAW = 52224, PL_KK = 52224, PL_QK = 68864, PL_GC = 103936, PL_BETA = 104448, PL_G = 104960, PL_TS = 105472, PL_CW = 124416;
template <int PV> __device__ __forceinline__ void p_dn_prep(const Frame& F, unsigned char* ws, const float* cw, const float* a_log, const float* dt_bias) {
    bf16_t* QKV = (bf16_t*)(ws + WS_QKV); const bf16_t* HALO = (const bf16_t*)(ws + WS_HALO); const float* AB = (const float*)(ws + WS_AB);
    const int tid = F.tid, lane = F.lane, wave = F.wave;
    LAS bf16_t* Ks = (LAS bf16_t*)(F.lds + PL_KS); LAS bf16_t* Qs = (LAS bf16_t*)(F.lds + PL_QS); LAS bf16_t* Vs = (LAS bf16_t*)(F.lds + PL_VS);
    LAS float* Ap = (LAS float*)(F.lds + PL_AP); LAS float* KKs = (LAS float*)(F.lds + PL_KK); LAS float* QKs = (LAS float*)(F.lds + PL_QK);
    LAS bf16_t* Ts = (LAS bf16_t*)(F.lds + PL_TS); LAS float* gcb = (LAS float*)(F.lds + PL_GC); LAS float* betab = (LAS float*)(F.lds + PL_BETA); LAS float* Gs = (LAS float*)(F.lds + PL_G);
#define PREP_DMA(itn) do { const int qn_ = (itn) >> 3, hn_ = (itn) & 7; int cp_, nc_; if (qn_ < 256) { cp_ = qn_ & 63; nc_ = 64; } else { cp_ = (qn_ - 256) & 3; nc_ = 4; } \
        for (int pc_ = wave * 64; pc_ < 3216; pc_ += 512) { const int p_ = pc_ + lane; if (p_ < 3216) { const int rr_ = p_ / 48, wi_ = (p_ % 48) * 16, sg_ = wi_ >> 8, of_ = wi_ & 255, tt_ = rr_ - 2; const unsigned char* src_ = nullptr; \
            if (tt_ >= 0 && tt_ < 64) src_ = (const unsigned char*)QKV + ((size_t)(64 * qn_ + tt_) * 3072 + sg_ * 1024 + hn_ * 128) * 2 + of_; \
            else if (tt_ < 0) { if (cp_ > 0) src_ = (const unsigned char*)HALO + (((size_t)(qn_ - 1) * 3 + (tt_ + 3)) * 3072 + sg_ * 1024 + hn_ * 128) * 2 + of_; } \
            else { if (cp_ + 1 < nc_) src_ = (const unsigned char*)HALO + (((size_t)(qn_ + 1) * 3) * 3072 + sg_ * 1024 + hn_ * 128) * 2 + of_; } \
            if (src_) __builtin_amdgcn_global_load_lds((const unsigned*)src_, (LAS unsigned*)(F.lds + PL_RAW + pc_ * 16), 16, 0, 0); } } } while (0)
    if (F.vcu < NQ * 8) PREP_DMA(F.vcu);
    LAS float* cwl = (LAS float*)(F.lds + PL_CW); int hcw = -1;
    for (int it = F.vcu; it < NQ * 8; it += F.G) {
        const int q = it >> 3, h = it & 7;
        if (h != hcw) { hcw = h; for (int i = tid; i < 4 * 3 * 128; i += NWAVES * 64) cwl[i] = cw[(i >> 7) / 3 * 3072 + ((i >> 7) % 3) * 1024 + h * 128 + (i & 127)]; }
        int cpos, nch; if (q < 256) { cpos = q & 63; nch = 64; } else { cpos = (q - 256) & 3; nch = 4; }
        asm volatile("s_waitcnt vmcnt(0)" ::: "memory");
        __syncthreads();
        if (!(PV & 1)) {
            const int tok = tid >> 3, c0 = (tid & 7) * 16;
            const LAS unsigned char* raw = F.lds + PL_RAW;
#pragma unroll
            for (int seg = 0; seg < 3; ++seg) {
                float x[16];
#pragma unroll
                for (int i = 0; i < 16; ++i) x[i] = 0.f;
#pragma unroll
                for (int j = 0; j < 4; ++j) {
                    const int rr = tok + j;
                    const bool ok = !((cpos == 0 && rr < 2) || (cpos + 1 == nch && rr == 66));
                    if (ok) { const u32x4 w0 = *(const LAS u32x4*)(raw + rr * 768 + seg * 256 + c0 * 2), w1 = *(const LAS u32x4*)(raw + rr * 768 + seg * 256 + c0 * 2 + 16);
                        const LAS float* cwj = cwl + (j * 3 + seg) * 128 + c0;
                        x[0] += bflo(w0.x) * cwj[0]; x[1] += bfhi(w0.x) * cwj[1]; x[2] += bflo(w0.y) * cwj[2]; x[3] += bfhi(w0.y) * cwj[3];
                        x[4] += bflo(w0.z) * cwj[4]; x[5] += bfhi(w0.z) * cwj[5]; x[6] += bflo(w0.w) * cwj[6]; x[7] += bfhi(w0.w) * cwj[7];
                        x[8] += bflo(w1.x) * cwj[8]; x[9] += bfhi(w1.x) * cwj[9]; x[10] += bflo(w1.y) * cwj[10]; x[11] += bfhi(w1.y) * cwj[11];
                        x[12] += bflo(w1.z) * cwj[12]; x[13] += bfhi(w1.z) * cwj[13]; x[14] += bflo(w1.w) * cwj[14]; x[15] += bfhi(w1.w) * cwj[15]; }
                }
                float ss = 0.f;
#pragma unroll
                for (int i = 0; i < 16; ++i) { x[i] = x[i] * fsigmoid_(x[i]); ss += x[i] * x[i]; }
                float sc = 1.0f;
                if (seg < 2) { ss += __shfl_xor(ss, 1); ss += __shfl_xor(ss, 2); ss += __shfl_xor(ss, 4); sc = (seg == 0 ? 0.08838834764831845f : 1.0f) / sqrtf(ss + EPS); }
                u32x4 o0, o1;
                o0.x = pk2(x[0] * sc, x[1] * sc); o0.y = pk2(x[2] * sc, x[3] * sc); o0.z = pk2(x[4] * sc, x[5] * sc); o0.w = pk2(x[6] * sc, x[7] * sc);
                o1.x = pk2(x[8] * sc, x[9] * sc); o1.y = pk2(x[10] * sc, x[11] * sc); o1.z = pk2(x[12] * sc, x[13] * sc); o1.w = pk2(x[14] * sc, x[15] * sc);
                LAS bf16_t* dst = (seg == 0 ? Qs : (seg == 1 ? Ks : Vs)) + tok * 136 + c0;
                *(LAS u32x4*)dst = o0; *(LAS u32x4*)(dst + 8) = o1;
            }
            if (tid < 128) {
                const int dir = tid >> 6, n = tid & 63; const float* abr = AB + (size_t)(64 * q + n) * 32;
                const float g = -expf(a_log[dir * 8 + h]) * softplusf_(abr[dir * 8 + h] + dt_bias[dir * 8 + h]);
                const float bet = sigmoidf_(abr[16 + dir * 8 + h]);
                float c = g;
#pragma unroll
                for (int d = 1; d < 64; d <<= 1) { const float o = dir == 0 ? __shfl_up(c, d, 64) : __shfl_down(c, d, 64); if (dir == 0 ? (n >= d) : (n + d < 64)) c += o; }
                gcb[dir * 64 + n] = c; betab[dir * 64 + n] = bet;
                if (n == (dir == 0 ? 63 : 0)) Gs[dir] = c;
            }
        }
        __syncthreads();
        if (!(PV & 2)) {
            const int r = lane & 31, hh = lane >> 5, mi = (wave >> 1) & 1, mj = wave & 1;
            const LAS bf16_t* Xa = (wave < 4 ? Ks : Qs) + (32 * mi + r) * 136 + 8 * hh; const LAS bf16_t* Xb = Ks + (32 * mj + r) * 136 + 8 * hh;
            f32x16 acc;
#pragma unroll
            for (int i = 0; i < 16; ++i) acc[i] = 0.f;
#pragma unroll
            for (int ks = 0; ks < 8; ++ks) { const bf16x8 a = *(const LAS bf16x8*)(Xa + 16 * ks), b = *(const LAS bf16x8*)(Xb + 16 * ks); acc = MFMA32(a, b, acc); }
            LAS float* dst = (wave < 4 ? KKs : QKs) + 32 * mj + r;
#pragma unroll
            for (int reg = 0; reg < 16; ++reg) dst[(32 * mi + crow(reg, hh)) * 65] = acc[reg];
#pragma unroll 1
            for (int e = 0; e < 6; ++e) {
                const int idx = tid + 512 * e, f = idx >> 6, l = idx & 63, fr_ = l & 31, fh = l >> 5; u32x4 w; int seg, ff;
                if (f < 32) { ff = f & 15; seg = f < 16 ? 1 : 0; const int mt = ff >> 3, t = (ff >> 1) & 3, s2 = ff & 1;
                    const LAS bf16_t* src = (f < 16 ? Ks : Qs) + (32 * mt + fr_) * 136 + 32 * t + 16 * s2 + 4 * fh;
                    const u32x2 lo = *(const LAS u32x2*)src, hi = *(const LAS u32x2*)(src + 8); w.x = lo.x; w.y = lo.y; w.z = hi.x; w.w = hi.y; }
                else { ff = f - 32; seg = 2; const int t = ff >> 2, mt = (ff >> 1) & 1, s2 = ff & 1; unsigned short v8[8];
#pragma unroll
                    for (int j = 0; j < 8; ++j) v8[j] = Ks[(32 * mt + kperm(s2, fh, j)) * 136 + 32 * t + fr_];
                    w.x = v8[0] | ((unsigned)v8[1] << 16); w.y = v8[2] | ((unsigned)v8[3] << 16); w.z = v8[4] | ((unsigned)v8[5] << 16); w.w = v8[6] | ((unsigned)v8[7] << 16); }
                if (!(PV & 16)) *(u32x4*)((unsigned char*)QKV + dn_frag_off(q, h, seg, ff, l)) = w;
            }
            { const int blk = wave, dvq = blk >> 1, mt = blk & 1, c = lane & 31; unsigned short v16[16];
#pragma unroll
                for (int reg = 0; reg < 16; ++reg) v16[reg] = Vs[(32 * mt + crow(reg, hh)) * 136 + 32 * dvq + c];
                u32x4 w0, w1; w0.x = v16[0] | ((unsigned)v16[1] << 16); w0.y = v16[2] | ((unsigned)v16[3] << 16); w0.z = v16[4] | ((unsigned)v16[5] << 16); w0.w = v16[6] | ((unsigned)v16[7] << 16);
                w1.x = v16[8] | ((unsigned)v16[9] << 16); w1.y = v16[10] | ((unsigned)v16[11] << 16); w1.z = v16[12] | ((unsigned)v16[13] << 16); w1.w = v16[14] | ((unsigned)v16[15] << 16);
                u32x4* vp = (u32x4*)(ws + WS_VC + ((size_t)(it * 4 + dvq) * 2 + mt) * 2048 + lane * 32); if (!(PV & 16)) { vp[0] = w0; vp[1] = w1; } }
        }
        __syncthreads();
        if (!(PV & 4)) {
#pragma unroll 2
            for (int e = 0; e < 16; ++e) { const int idx = tid + 512 * e, dir = idx >> 12, ip = (idx >> 6) & 63, jp = idx & 63, n = dir ? 63 - ip : ip, m = dir ? 63 - jp : jp;
                Ap[dir * 4096 + jp * 64 + ip] = jp < ip ? betab[dir * 64 + n] * KKs[n * 65 + m] * fexp_(gcb[dir * 64 + n] - gcb[dir * 64 + m]) : 0.f; }
#pragma unroll 1
            for (int e = 0; e < 2; ++e) { const int idx = tid + 512 * e; if (idx < 768) { const int dir = idx / 384, rem = idx % 384, fb = rem >> 6, l = rem & 63, blk = fb >> 1, s2 = fb & 1, fr_ = l & 31, fh = l >> 5;
                const int mi = blk == 0 ? 0 : (blk == 1 ? 1 : (dir == 0 ? 1 : 0)), mj = blk == 0 ? 0 : (blk == 1 ? 1 : (dir == 0 ? 0 : 1));
                const int n = 32 * mi + fr_; float pv[8];
#pragma unroll
                for (int j = 0; j < 8; ++j) { const int m = 32 * mj + kperm(s2, fh, j); const bool ok = dir == 0 ? (m <= n) : (m >= n);
                    pv[j] = ok ? QKs[n * 65 + m] * fexp_(gcb[dir * 64 + n] - gcb[dir * 64 + m]) : 0.f; }
                u32x4 w; w.x = pk2(pv[0], pv[1]); w.y = pk2(pv[2], pv[3]); w.z = pk2(pv[4], pv[5]); w.w = pk2(pv[6], pv[7]);
                if (!(PV & 16)) *(u32x4*)(ws + WS_P + ((size_t)(it * 2 + dir) * 6 + fb) * 1024 + l * 16) = w; } }
            if (tid < 128 && !(PV & 16)) { const int dir = tid >> 6, n = tid & 63; float* rec = (float*)(ws + WS_GC + (size_t)(it * 2 + dir) * 1024);
                rec[n] = fexp_(gcb[dir * 64 + n]); rec[64 + n] = fexp_(Gs[dir] - gcb[dir * 64 + n]); if (n == 0) rec[128] = fexp_(Gs[dir]); }
        }
        __syncthreads();
        if (it + F.G < NQ * 8) PREP_DMA(it + F.G);
        if (!(PV & 8) && wave < 2) {
            const LAS float* Acol = Ap + wave * 4096; float Tc[64];
#pragma unroll
            for (int i = 0; i < 64; ++i) Tc[i] = (i == lane) ? 1.f : 0.f;
            f32x4 hb[2][8];
#define PREP_HLOAD(col_, hf_, bi) do { if ((col_) < 63) { _Pragma("unroll") for (int g = 0; g < 8; ++g) { const int gg = (hf_) * 8 + g; \
                if (gg >= ((col_) + 1) / 4) hb[bi][g] = *(const LAS f32x4*)(Acol + (col_) * 64 + 4 * gg); } } } while (0)
#define PREP_HFMA(col_, hf_, bi) do { const float tj_ = Tc[col_]; _Pragma("unroll") for (int g = 0; g < 8; ++g) { const int gg = (hf_) * 8 + g; \
                if (gg >= ((col_) + 1) / 4) { _Pragma("unroll") for (int ii = 0; ii < 4; ++ii) if (4 * gg + ii > (col_)) Tc[4 * gg + ii] -= hb[bi][g][ii] * tj_; } } } while (0)
#define PREP_SB __builtin_amdgcn_sched_barrier(0)
            PREP_HLOAD(0, 0, 0);
#pragma clang loop unroll(full)
            for (int j = 0; j < 32; ++j) {
                PREP_HLOAD(j, 1, 1); PREP_SB; PREP_HFMA(j, 0, 0); PREP_SB;
                if (j + 1 < 32) PREP_HLOAD(j + 1, 0, 0); else PREP_HLOAD(32, 1, 0);
                PREP_SB; PREP_HFMA(j, 1, 1); PREP_SB; }
#pragma clang loop unroll(full)
            for (int j = 32; j < 63; ++j) {
                PREP_HLOAD(j + 1, 1, (j + 1) & 1); PREP_SB; PREP_HFMA(j, 1, j & 1); PREP_SB; }
#undef PREP_SB
#undef PREP_HLOAD
#undef PREP_HFMA
            const int m = wave ? 63 - lane : lane; const float bm = betab[wave * 64 + m];
#pragma unroll
            for (int i = 0; i < 64; ++i) { const int n = wave ? 63 - i : i; Ts[(wave * 64 + n) * 72 + m] = (bf16_t)f2bf(Tc[i] * bm); }
        }
        __syncthreads();
        {
#pragma unroll 1
            for (int e = 0; e < 2; ++e) { const int idx = tid + 512 * e; if (idx < 768) { const int dir = idx / 384, rem = idx % 384, fb = rem >> 6, l = rem & 63, blk = fb >> 1, s2 = fb & 1, fr_ = l & 31, fh = l >> 5;
                const int mi = blk == 0 ? 0 : (blk == 1 ? 1 : (dir == 0 ? 1 : 0)), mj = blk == 0 ? 0 : (blk == 1 ? 1 : (dir == 0 ? 0 : 1));
                const LAS bf16_t* src = Ts + (dir * 64 + 32 * mi + fr_) * 72 + 32 * mj + 16 * s2 + 4 * fh;
                const u32x2 lo = *(const LAS u32x2*)src, hi = *(const LAS u32x2*)(src + 8); u32x4 w; w.x = lo.x; w.y = lo.y; w.z = hi.x; w.w = hi.y;
                if (!(PV & 16)) *(u32x4*)(ws + WS_T + ((size_t)(it * 2 + dir) * 6 + fb) * 1024 + l * 16) = w; } }
        }
        __syncthreads();
    }
}

constexpr int CH_BUF = 62464;
template <int VAR> __device__ __forceinline__ void p_dn_chain(const Frame& F, const unsigned char* ws, bf16_t* O) {
    const int lane = F.lane, wave = F.wave, hh = lane >> 5;
    for (int item = blockIdx.x; item < 64; item += F.G) {
        const int b = item >> 4, h = (item >> 1) & 7, dir = item & 1, dvq = wave & 3;
        f32x16 S[4];
#pragma unroll
        for (int t = 0; t < 4; ++t)
#pragma unroll
            for (int i = 0; i < 16; ++i) S[t][i] = 0.f;
        u32x4 Vn_[2][2], Vc_[2][2];
#define CH_Q(n) ((n) < 4 ? 256 + 4 * b + (dir ? 3 - (n) : (n)) : 64 * b + (dir ? 63 - ((n) - 4) : (n) - 4))
#define CH_ISSUE(n, bufi) do { const int q_ = (VAR & 8) ? CH_Q(0) : CH_Q(n); const size_t it2_ = (size_t)(q_ * 8 + h) * 2 + dir; \
            if (wave >= 4) for (int f = wave - 4; f < 61; f += 4) { const unsigned char* srcu_; unsigned lo_; \
                if (f < 48) { const int seg_ = f < 16 ? 1 : (f < 32 ? 0 : 2); srcu_ = ws + WS_QKV + ((size_t)(64 * q_ + 4 * (f & 15)) * 3072 + seg_ * 1024 + h * 128) * 2; lo_ = lane_qkv; } \
                else if (f < 54) { srcu_ = ws + WS_T + (it2_ * 6 + (f - 48)) * 1024; lo_ = lane16; } \
                else if (f < 60) { srcu_ = ws + WS_P + (it2_ * 6 + (f - 54)) * 1024; lo_ = lane16; } \
                else { srcu_ = ws + WS_GC + it2_ * 1024; lo_ = lane16; } \
                __builtin_amdgcn_global_load_lds((const unsigned*)(srcu_ + lo_), (LAS unsigned*)(F.lds + (bufi) * CH_BUF + f * 1024), 16, 0, 0); } \
            if (wave < 4) { const unsigned char* vu_ = ws + WS_VC + ((size_t)((q_ * 8 + h) * 4 + dvq) * 2) * 2048; \
                Vn_[0][0] = *(const u32x4*)(vu_ + lane32); Vn_[0][1] = *(const u32x4*)(vu_ + lane32 + 16); Vn_[1][0] = *(const u32x4*)(vu_ + lane32 + 2048); Vn_[1][1] = *(const u32x4*)(vu_ + lane32 + 2064); } } while (0)
        const unsigned lane_qkv = (unsigned)((lane >> 4) * 6144 + (lane & 15) * 16), lane16 = (unsigned)lane * 16u, lane32 = (unsigned)lane * 32u;
#define CH_FLUSH(np) do { const LAS bf16_t* ot_ = (const LAS bf16_t*)(F.lds + 2 * CH_BUF + wave * 4096); const int c_ = dir ? 63 - ((np) - 4) : (np) - 4; \
            unsigned char* obu_ = (unsigned char*)(O + (size_t)dir * ML * D + ((size_t)b * SEQ + c_) * D + h * 128 + dvq * 32); const unsigned ol_ = (unsigned)((lane & 3) * 16 + (lane >> 2) * (64 * D * 2)); \
            _Pragma("unroll") for (int k = 0; k < 4; ++k) { const u32x4 w_ = *(const LAS u32x4*)(ot_ + ((lane >> 2) + 16 * k) * 32 + (lane & 3) * 8); *(u32x4*)(obu_ + ol_ + (unsigned)k * (16u * 64u * D * 2u)) = w_; } } while (0)
        CH_ISSUE(0, 0);
        for (int n = 0; n < 68; ++n) {
            const int buf = n & 1;
            asm volatile("s_waitcnt vmcnt(0)" ::: "memory");
            __syncthreads();
            Vc_[0][0] = Vn_[0][0]; Vc_[0][1] = Vn_[0][1]; Vc_[1][0] = Vn_[1][0]; Vc_[1][1] = Vn_[1][1];
            if (n + 1 < 68 && !(VAR & 2)) CH_ISSUE(n + 1, buf ^ 1);
            if (wave < 4 && n >= 5 && !(VAR & 1)) CH_FLUSH(n - 1);
            if (wave < 4 && !(VAR & 4)) {
                const LAS unsigned char* B = F.lds + buf * CH_BUF;
#define CH_FRAG(f) (*(const LAS bf16x8*)(B + (f) * 1024 + lane * 16))
#define CH_EA(i) ((((((i) >> 1) & 1) * 4 + ((i) >> 3)) * 2 + (((i) >> 2) & 1)) + (((i) & 1) ? 16 : 0))
#define CH_ET(k) ((k) < 4 ? (((k) & 1) * 2 + ((k) >> 1)) : (k))
#define CH_EE(j) ((((j) & 3) * 2 + ((j) >> 3)) * 2 + (((j) >> 2) & 1))
#define CH_E(i) ((i) < 32 ? CH_EA(i) : ((i) < 38 ? 48 + CH_ET((i) - 32) : ((i) < 44 ? 54 + CH_ET((i) - 38) : 32 + CH_EE((i) - 44))))
#define CH_LD(i) do { if ((i) < 60) ring[(i) % 4] = CH_FRAG(CH_E(i)); } while (0)
                bf16x8 ring[4];
#pragma unroll
                for (int i = 0; i < 4; ++i) CH_LD(i);
                const LAS float* gcp = (const LAS float*)(B + 60 * 1024); const float eG = gcp[128];
                f32x16 KS[2], QS[2];
#pragma unroll
                for (int mt = 0; mt < 2; ++mt)
#pragma unroll
                    for (int i = 0; i < 16; ++i) { KS[mt][i] = 0.f; QS[mt][i] = 0.f; }
#pragma unroll
                for (int t = 0; t < 4; ++t) {
                    bf16x8 Sb[2]; Sb[0] = pack8(S[t], 0); Sb[1] = pack8(S[t], 1);
#pragma unroll
                    for (int k = 0; k < 8; ++k) { const int i = 8 * t + k, s = (k >> 2) & 1, mt = (k >> 1) & 1;
                        if (k & 1) QS[mt] = MFMA32(ring[i % 4], Sb[s], QS[mt]); else KS[mt] = MFMA32(ring[i % 4], Sb[s], KS[mt]);
                        CH_LD(i + 4); __builtin_amdgcn_sched_barrier(0); }
                }
#pragma unroll
                for (int mt = 0; mt < 2; ++mt)
#pragma unroll
                    for (int g4 = 0; g4 < 4; ++g4) { const f32x4 ev = *(const LAS f32x4*)(gcp + 32 * mt + 8 * g4 + 4 * hh);
                        const unsigned w0 = Vc_[mt][g4 >> 1][(g4 & 1) * 2], w1 = Vc_[mt][g4 >> 1][(g4 & 1) * 2 + 1]; const float vv[4] = {bflo(w0), bfhi(w0), bflo(w1), bfhi(w1)};
#pragma unroll
                        for (int i = 0; i < 4; ++i) { KS[mt][4 * g4 + i] = vv[i] - ev[i] * KS[mt][4 * g4 + i]; QS[mt][4 * g4 + i] *= ev[i]; } }
                f32x16 VN[2];
#pragma unroll
                for (int mt = 0; mt < 2; ++mt)
#pragma unroll
                    for (int i = 0; i < 16; ++i) VN[mt][i] = 0.f;
                {
                    bf16x8 Rb[2][2];
#pragma unroll
                    for (int mt = 0; mt < 2; ++mt) { Rb[mt][0] = pack8(KS[mt], 0); Rb[mt][1] = pack8(KS[mt], 1); }
#pragma unroll
                    for (int i = 32; i < 38; ++i) { const int fi = CH_ET(i - 32), blk = fi >> 1, s = fi & 1;
                        if (blk == 0) VN[0] = MFMA32(ring[i % 4], Rb[0][s], VN[0]);
                        else if (blk == 1) VN[1] = MFMA32(ring[i % 4], Rb[1][s], VN[1]);
                        else { if (dir == 0) VN[1] = MFMA32(ring[i % 4], Rb[0][s], VN[1]); else VN[0] = MFMA32(ring[i % 4], Rb[1][s], VN[0]); }
                        CH_LD(i + 4); __builtin_amdgcn_sched_barrier(0); }
                }
                {
                    bf16x8 Vb[2][2];
#pragma unroll
                    for (int mt = 0; mt < 2; ++mt) { Vb[mt][0] = pack8(VN[mt], 0); Vb[mt][1] = pack8(VN[mt], 1); }
#pragma unroll
                    for (int i = 38; i < 44; ++i) { const int fi = CH_ET(i - 38), blk = fi >> 1, s = fi & 1;
                        if (blk == 0) QS[0] = MFMA32(ring[i % 4], Vb[0][s], QS[0]);
                        else if (blk == 1) QS[1] = MFMA32(ring[i % 4], Vb[1][s], QS[1]);
                        else { if (dir == 0) QS[1] = MFMA32(ring[i % 4], Vb[0][s], QS[1]); else QS[0] = MFMA32(ring[i % 4], Vb[1][s], QS[0]); }
                        CH_LD(i + 4); __builtin_amdgcn_sched_barrier(0); }
                }
                bf16x8 Wb[2][2];
#pragma unroll
                for (int mt = 0; mt < 2; ++mt) {
#pragma unroll
                    for (int g4 = 0; g4 < 4; ++g4) { const f32x4 wv = *(const LAS f32x4*)(gcp + 64 + 32 * mt + 8 * g4 + 4 * hh);
#pragma unroll
                        for (int i = 0; i < 4; ++i) VN[mt][4 * g4 + i] *= wv[i]; }
                    Wb[mt][0] = pack8(VN[mt], 0); Wb[mt][1] = pack8(VN[mt], 1); }
                {
#pragma unroll
                    for (int t = 0; t < 4; ++t)
#pragma unroll
                        for (int i = 0; i < 16; ++i) S[t][i] *= eG;
#pragma unroll
                    for (int i = 44; i < 60; ++i) { const int j = i - 44, t = j & 3, mt = j >> 3, s = (j >> 2) & 1;
                        S[t] = MFMA32(ring[i % 4], Wb[mt][s], S[t]);
                        CH_LD(i + 4); __builtin_amdgcn_sched_barrier(0); }
                }
                if (n >= 4 && !(VAR & 1)) {
                    LAS bf16_t* ot = (LAS bf16_t*)(F.lds + 2 * CH_BUF + wave * 4096);
#pragma unroll
                    for (int mt = 0; mt < 2; ++mt)
#pragma unroll
                        for (int reg = 0; reg < 16; ++reg) ot[(32 * mt + crow(reg, hh)) * 32 + (lane & 31)] = (bf16_t)f2bf(QS[mt][reg]);
                }
#undef CH_LD
#undef CH_E
#undef CH_EA
#undef CH_ET
#undef CH_EE
#undef CH_FRAG
            }
        }
        if (wave < 4 && !(VAR & 1)) CH_FLUSH(67);
#undef CH_FLUSH
#undef CH_ISSUE
#undef CH_Q
        asm volatile("s_waitcnt vmcnt(0)" ::: "memory");
        __syncthreads();
    }
}
__device__ __forceinline__ void p_dn_ro(const Frame& F, const bf16_t* O, const bf16_t* Z, const float* gn, bf16_t* RO) {
    const int gw = F.vcu * NWAVES + F.wave, NGW = F.G * NWAVES;
    for (int r = gw; r < ML; r += NGW) {
        const int s = r & (SEQ - 1), sr = (r & ~(SEQ - 1)) + ((s & 63) << 6) + (s >> 6);
        const u32x4* of4 = (const u32x4*)(O + (size_t)r * D + F.lane * 16); const u32x4* ob4 = (const u32x4*)(O + (size_t)ML * D + (size_t)r * D + F.lane * 16);
        float v[16]; float ss = 0.f;
#pragma unroll
        for (int j = 0; j < 2; ++j) { const u32x4 a = of4[j], b = ob4[j];
            v[8 * j + 0] = bflo(a.x) + bflo(b.x); v[8 * j + 1] = bfhi(a.x) + bfhi(b.x); v[8 * j + 2] = bflo(a.y) + bflo(b.y); v[8 * j + 3] = bfhi(a.y) + bfhi(b.y);
            v[8 * j + 4] = bflo(a.z) + bflo(b.z); v[8 * j + 5] = bfhi(a.z) + bfhi(b.z); v[8 * j + 6] = bflo(a.w) + bflo(b.w); v[8 * j + 7] = bfhi(a.w) + bfhi(b.w); }
#pragma unroll
        for (int i = 0; i < 16; ++i) ss += v[i] * v[i];
        ss += __shfl_xor(ss, 1); ss += __shfl_xor(ss, 2); ss += __shfl_xor(ss, 4);
        const float rstd = 1.0f / sqrtf(ss * (1.0f / 128.0f) + EPS);
        const u32x4* z4 = (const u32x4*)(Z + (size_t)sr * D + F.lane * 16);
        const float* g1 = gn + (F.lane & 7) * 16;
        u32x4 ov[2];
#pragma unroll
        for (int hh = 0; hh < 2; ++hh) { const u32x4 zw = z4[hh]; const float* vv = v + 8 * hh; const float* gg = g1 + 8 * hh;
            ov[hh].x = pk2(vv[0] * rstd * gg[0] * siluf_(bflo(zw.x)), vv[1] * rstd * gg[1] * siluf_(bfhi(zw.x))); ov[hh].y = pk2(vv[2] * rstd * gg[2] * siluf_(bflo(zw.y)), vv[3] * rstd * gg[3] * siluf_(bfhi(zw.y)));
            ov[hh].z = pk2(vv[4] * rstd * gg[4] * siluf_(bflo(zw.z)), vv[5] * rstd * gg[5] * siluf_(bfhi(zw.z))); ov[hh].w = pk2(vv[6] * rstd * gg[6] * siluf_(bflo(zw.w)), vv[7] * rstd * gg[7] * siluf_(bfhi(zw.w))); }
        u32x4* op = (u32x4*)(RO + (size_t)r * D + F.lane * 16); op[0] = ov[0]; op[1] = ov[1];
    }
}

constexpr int N_PHASES = 27;
__global__ void __launch_bounds__(NWAVES * 64, 2) trunk_fwd(Args args) {
    extern __shared__ __attribute__((aligned(16))) unsigned char lds_raw[];
    Frame F;
    F.lds = (LAS unsigned char*)lds_raw;
    F.tid = threadIdx.x; F.lane = F.tid & 63; F.wave = __builtin_amdgcn_readfirstlane(F.tid >> 6);
    F.G = gridDim.x; { const int bx = blockIdx.x; F.vcu = (F.G % 8 == 0) ? (bx % 8) * (F.G / 8) + bx / 8 : bx; }
    unsigned char* ws = args.ws;
    unsigned* ctl = (unsigned*)(ws + WS_CTL);
    for (int u = F.tid; u < (LDS_BYTES - LDSCTL_OFF) / 4; u += NWAVES * 64) ((LAS unsigned*)(F.lds + LDSCTL_OFF))[u] = 0u;
    __syncthreads();
    XcdBarrier bar; bar.bar = ctl + CW_BAR; bar.x = 0; bar.st = nullptr;
    if (!MK_PER_PHASE) bar = xcd_barrier_post(ctl + CW_BAR, (volatile LAS unsigned*)(F.lds + MISC_OFF) + 8);
    const int lo = args.ph_lo, hi = args.ph_hi;
#ifndef MK_PHMASK
#define MK_PHMASK 0xffffffffu
#endif
#define IN(k) ((((unsigned)MK_PHMASK >> (k)) & 1u) && lo <= (k) && (k) < hi)
#ifndef MK_REPMASK
#define MK_REPMASK 0u
#endif
#define REP(k) ((((unsigned)MK_REPMASK >> (k)) & 1u) ? 2 : 1)
#ifndef MK_BARREP
#define MK_BARREP 1
#endif
#define SEAM(k) do { if (IN(k) && IN((k) + 1)) { for (int br_ = 0; br_ < MK_BARREP; ++br_) xcd_barrier(bar); } } while (0)

    float* MOD = (float*)(ws + WS_MOD);
    float* XL = args.out; float* XC = (float*)(ws + WS_XC);
    bf16_t* XN = (bf16_t*)(ws + WS_XN); bf16_t* HB = (bf16_t*)(ws + WS_H);
    const float* g_sub = args.in[6];
    const int bid = (int)blockIdx.x;

#define PH_FFN1(k, w, MROWS) if (IN(k)) { pg8::Gemm g{XN, (const bf16_t*)(ws + WS_W1 + (((w) + 1) & 3) * W1_SZ), MROWS, 2 * DFF, D, D, 0, D}; pg8::StaticOrder S; S.init(MROWS, 2 * DFF, F.G, bid, REP(k)); \
        pg8::EpiSwiglu E{HB}; pg8::gemm_phase<pg8::EpiSwiglu, pg8::StaticOrder>(F.lds, g, S, E); } SEAM(k);
#define PH_FFN2(k, w, MROWS, BL, BC, GATE) if (IN(k)) { pg8::Gemm g{HB, (const bf16_t*)(ws + WS_W2 + (w) * W2_SZ), MROWS, D, DFF, DFF, 0, DFF}; pg8::ResidOrder S; S.init(MROWS, DFF, F.G, bid, REP(k)); \
        pg8::EpiResid E{BL, BC, XL, XC, GATE, 0.5f, (float*)(ws + WS_PART)}; pg8::gemm_phase<pg8::EpiResid, pg8::ResidOrder>(F.lds, g, S, E); } SEAM(k);
#define PH_NORM(k, SRCL, SRCC, NROWS, l, sub, NPARTS) if (IN(k)) { for (int rp = 0; rp < REP(k); ++rp) p_norm(F, SRCL, SRCC, NROWS, g_sub + ((l) * 3 + (sub)) * D, MOD + (size_t)(l) * MODL + (sub) * 3 * D, XN, (const float*)(ws + WS_PART), rp ? 0 : (NPARTS), XC); } SEAM(k);

    if (IN(0)) { p_prologue(F, args, REP(0)); } SEAM(0);
    PH_NORM(1, args.in[0], args.in[2], MT, 0, 0, 0)
    PH_FFN1(2, 0, MT)
    PH_FFN2(3, 0, MT, args.in[0], args.in[2], MOD + 0 * MODL + 2 * D)
    PH_NORM(4, XL, args.in[2], MT, 0, 1, 11)
    if (IN(5)) { pg8::Gemm g{XN, (const bf16_t*)(ws + WS_WLIN), MT, 2048, D, D, 0, D}; pg8::StaticOrder S; S.init(MT, 2048, F.G, bid, REP(5));
        pg8::EpiBf16 E{(bf16_t*)(ws + WS_Y), D, D, (size_t)(WS_UP - WS_Y) / 2}; pg8::gemm_phase<pg8::EpiBf16, pg8::StaticOrder>(F.lds, g, S, E); } SEAM(5);
    if (IN(6)) { for (int rp = 0; rp < REP(6); ++rp) p_lru_conv(F, (const bf16_t*)(ws + WS_UP), args.in[10], args.in[11], (bf16_t*)(ws + WS_U)); } SEAM(6);
    if (IN(7)) { pg8::Gemm g{(const bf16_t*)(ws + WS_U), (const bf16_t*)(ws + WS_WLG), MT, 4096, 256, D, 4, 256}; pg8::StaticOrder S; S.init(MT, 4096, F.G, bid, REP(7));
        pg8::EpiGates<0> E{(const bf16_t*)(ws + WS_U), (const bf16_t*)(ws + WS_Y), XN, args.in[13], (const float*)(ws + WS_SP8), (float*)(ws + WS_AGGA), (float*)(ws + WS_AGGB), (const float*)(ws + WS_CARRY)};
        pg8::gemm_phase<pg8::EpiGates<0>, pg8::StaticOrder>(F.lds, g, S, E); } SEAM(7);
    if (IN(8)) { for (int rp = 0; rp < REP(8); ++rp) p_lru_carry(F, (const float*)(ws + WS_AGGA), (const float*)(ws + WS_AGGB), (float*)(ws + WS_CARRY)); } SEAM(8);
    if (IN(9)) { pg8::Gemm g{(const bf16_t*)(ws + WS_U), (const bf16_t*)(ws + WS_WLG), MT, 4096, 256, D, 4, 256}; pg8::StaticOrder S; S.init(MT, 4096, F.G, bid, REP(9));
        pg8::EpiGates<1> E{(const bf16_t*)(ws + WS_U), (const bf16_t*)(ws + WS_Y), XN, args.in[13], (const float*)(ws + WS_SP8), (float*)(ws + WS_AGGA), (float*)(ws + WS_AGGB), (const float*)(ws + WS_CARRY)};
        pg8::gemm_phase<pg8::EpiGates<1>, pg8::StaticOrder>(F.lds, g, S, E); } SEAM(9);
    if (IN(10)) { pg8::Gemm g{XN, (const bf16_t*)(ws + WS_WLO), MT, D, D, D, 0, D}; pg8::ResidOrder S; S.init(MT, D, F.G, bid, REP(10));
        pg8::EpiResid E{XL, XC, XL, XC, MOD + 0 * MODL + 5 * D, 1.0f, (float*)(ws + WS_PART)}; pg8::gemm_phase<pg8::EpiResid, pg8::ResidOrder>(F.lds, g, S, E); } SEAM(10);
    PH_NORM(11, XL, XC, MT, 0, 2, 4)
    PH_FFN1(12, 1, MT)
    PH_FFN2(13, 1, MT, XL, XC, MOD + 0 * MODL + 8 * D)
    PH_NORM(14, XL, XC, MT, 1, 0, 11)
    PH_FFN1(15, 2, MT)
    PH_FFN2(16, 2, MT, XL, XC, MOD + 1 * MODL + 2 * D)
    PH_NORM(17, XL, XC, MT, 1, 1, 11)
    if (IN(18)) { pg8::Gemm g{XN, (const bf16_t*)(ws + WS_WDIN), MT, DNPP, D, D, 0, D}; pg8::StaticOrder S; S.init(MT, DNPP, F.G, bid, REP(18));
        pg8::EpiDnIn E{(bf16_t*)(ws + WS_QKV), (bf16_t*)(ws + WS_Z), (float*)(ws + WS_AB), (bf16_t*)(ws + WS_HALO)}; pg8::gemm_phase<pg8::EpiDnIn, pg8::StaticOrder>(F.lds, g, S, E); } SEAM(18);
    #ifndef MK_PVAR
#define MK_PVAR 0
#endif
    if (IN(19)) { p_dn_prep<0>(F, ws, args.in[17], args.in[18], args.in[19]); if (REP(19) > 1) p_dn_prep<16 | MK_PVAR>(F, ws, args.in[17], args.in[18], args.in[19]); } SEAM(19);
    #ifndef MK_CHVAR
#define MK_CHVAR 0
#endif
    if (IN(20)) { p_dn_chain<0>(F, ws, (bf16_t*)(ws + WS_O)); if (REP(20) > 1) p_dn_chain<MK_CHVAR>(F, ws, (bf16_t*)(ws + WS_O)); } SEAM(20);
    if (IN(21)) { for (int rp = 0; rp < REP(21); ++rp) p_dn_ro(F, (const bf16_t*)(ws + WS_O), (const bf16_t*)(ws + WS_Z), args.in[20], (bf16_t*)(ws + WS_RO2)); } SEAM(21);
    if (IN(22)) { pg8::Gemm g{(const bf16_t*)(ws + WS_RO2), (const bf16_t*)(ws + WS_WDO), ML, D, D, D, 0, D}; pg8::StaticOrder S; S.init(ML, D, F.G, bid, REP(22));
        pg8::EpiResid E{XL, XC, XL, XC, MOD + 1 * MODL + 5 * D, 1.0f, (float*)(ws + WS_PART)}; pg8::gemm_phase<pg8::EpiResid, pg8::StaticOrder>(F.lds, g, S, E); } SEAM(22);
    PH_NORM(23, XL, XC, ML, 1, 2, 0)
    PH_FFN1(24, 3, ML)
    PH_FFN2(25, 3, ML, XL, XC, MOD + 1 * MODL + 8 * D)
    if (IN(26)) { p_final(F, XL, args.in[22]); }
#undef IN
#undef SEAM
#undef PH_FFN1
#undef PH_FFN2
#undef PH_NORM
}

extern "C" void kernel_launch(void* const* d_in, const int* in_sizes, int n_in, void* d_out, int out_size, void* d_ws, size_t ws_size, hipStream_t stream) {
    static int grid = 0;
    if (grid == 0) {
        if (n_in != 23 || in_sizes[0] != ML * D || out_size != ML * D || ws_size < WS_END) { fprintf(stderr, "kernel_launch: unexpected problem shape (n_in %d, in0 %d, out %d, ws %zu); nothing launched\n", n_in, n_in > 0 ? in_sizes[0] : -1, out_size, ws_size); grid = -1; return; }
        int dev = 0, cus = 0;
        if (hipGetDevice(&dev) != hipSuccess || hipDeviceGetAttribute(&cus, hipDeviceAttributeMultiprocessorCount, dev) != hipSuccess) { grid = -1; return; }
        if (hipFuncSetAttribute((const void*)trunk_fwd, hipFuncAttributeMaxDynamicSharedMemorySize, LDS_BYTES) != hipSuccess) { fprintf(stderr, "kernel_launch: hipFuncSetAttribute failed\n"); grid = -1; return; }
        (void)hipGetLastError();
        grid = cus;
    }
    if (grid < 0) return;
    if (hipMemsetAsync((char*)d_ws + WS_CTL, 0, CTL_ZERO_BYTES, stream) != hipSuccess) return;
    Args a{};
    for (int i = 0; i < 23; ++i) a.in[i] = (const float*)d_in[i];
    a.out = (float*)d_out; a.ws = (unsigned char*)d_ws;
#if MK_PER_PHASE
    for (int p = 0; p < N_PHASES; ++p) { a.ph_lo = p; a.ph_hi = p + 1; hipLaunchKernelGGL(trunk_fwd, dim3(grid), dim3(NWAVES * 64), LDS_BYTES, stream, a); }
#else
    a.ph_lo = 0; a.ph_hi = N_PHASES;
    hipLaunchKernelGGL(trunk_fwd, dim3(grid), dim3(NWAVES * 64), LDS_BYTES, stream, a);
#endif
}
```
